# Optimizing an MI355X kernel written in HIP

```python
import math
import jax, jax.numpy as jnp
from jax import lax
import numpy as np

D_MODEL = 2048
BATCH = 4
SEQ = 2048
DEPTH = 1
DEC_BATCH = 8
DEC_SEQ = 1
PAST_LEN = 16384
PAGE_SIZE = 128

HEAD_DIM = 128
MIX_WIDTH = D_MODEL
NSA_WIDTH = MIX_WIDTH // 2
GDN_WIDTH = MIX_WIDTH - NSA_WIDTH
NSA_HEADS = NSA_WIDTH // HEAD_DIM
NSA_KV_HEADS = max(1, NSA_HEADS // 4)
NSA_GROUP = NSA_HEADS // NSA_KV_HEADS
KV_WIDTH = NSA_KV_HEADS * HEAD_DIM
CMP_BLOCK = 32
SEL_BLOCK = 64
CMP_PER_SEL = SEL_BLOCK // CMP_BLOCK
SEL_TOPN = 16
WINDOW = 512
NSA_Q_BLOCK = 64
CMP_HIDDEN = HEAD_DIM
GDN_HEADS = GDN_WIDTH // HEAD_DIM
CONV_WIDTH = 4
GDN_CHUNK = 64
PEER_HEADS = 8
PEER_NKEYS = 128
PEER_N_EXPERTS = PEER_NKEYS * PEER_NKEYS
PEER_QDIM = 256
PEER_TOPK = 16
PEER_BLOCK = 128
NORM_EPS = 1e-6
NEG_INF = -1e30
FORCE_SCORE = 1e4
IN_SPLITS = (NSA_WIDTH, 2 * KV_WIDTH, 2 * KV_WIDTH, 2 * KV_WIDTH, 3 * NSA_HEADS,
             3 * GDN_WIDTH, GDN_WIDTH, GDN_HEADS, GDN_HEADS)
IN_COLS = sum(IN_SPLITS)

kernel_name = 'hybrid_nsa_gdn_peer_adaln_step'


def rmsnorm(x, w):
    xf = x.astype(jnp.float32)
    y = xf * lax.rsqrt(jnp.mean(xf * xf, axis=-1, keepdims=True) + NORM_EPS)
    return (y * w.astype(jnp.float32)).astype(x.dtype)


def l2norm(x):
    return x * lax.rsqrt(jnp.sum(x * x, axis=-1, keepdims=True) + NORM_EPS)


def masked_softmax(s, mask, axis=-1):
    p = jax.nn.softmax(jnp.where(mask, s, NEG_INF), axis=axis)
    return jnp.where(mask, p, 0.0)


def alibi_slopes(n):
    return 2.0 ** (-8.0 * jnp.arange(1, n + 1, dtype=jnp.float32) / n)


def adaln(c, w, b):
    mod = jax.nn.silu(c) @ w + b
    return jnp.split(mod, 6, axis=-1)


def split_projection(p):
    B, T = p.shape[:2]
    offs = [int(o) for o in np.cumsum(IN_SPLITS)[:-1]]
    q, kvc, kvs, kvw, gts, qkv, z, bl, al = jnp.split(p, offs, axis=-1)
    kv_shape = (B, T, 2, NSA_KV_HEADS, HEAD_DIM)
    return (q.reshape(B, T, NSA_KV_HEADS, NSA_GROUP, HEAD_DIM), kvc.reshape(kv_shape),
            kvs.reshape(kv_shape), kvw.reshape(kv_shape),
            gts.reshape(B, T, NSA_KV_HEADS, NSA_GROUP, 3), qkv, z, bl, al)


def compress_blocks(kv, cmp_pe, cmp_w1, cmp_b1, cmp_w2):
    B, L = kv.shape[:2]
    nc = L // CMP_BLOCK
    blocks = kv[:, :nc * CMP_BLOCK].reshape(B, nc, CMP_BLOCK, 2, NSA_KV_HEADS, HEAD_DIM)
    blocks = blocks + jnp.transpose(cmp_pe, (1, 0, 2))[:, :, None, :]
    hid = jax.nn.gelu(jnp.einsum('bnlshd,slde->bnshe', blocks, cmp_w1) + cmp_b1[:, None, :])
    ckv = jnp.einsum('bnshe,sed->bnshd', hid, cmp_w2)
    cmp_end = jnp.arange(nc, dtype=jnp.int32) * CMP_BLOCK + (CMP_BLOCK - 1)
    return ckv, cmp_end


def selection_blocks(kv):
    B, L = kv.shape[:2]
    nsb = -(-L // SEL_BLOCK)
    kv = jnp.pad(kv, ((0, 0), (0, nsb * SEL_BLOCK - L), (0, 0), (0, 0), (0, 0)))
    kv = kv.reshape(B, nsb, SEL_BLOCK, 2, NSA_KV_HEADS, HEAD_DIM).transpose(3, 0, 4, 1, 2, 5)
    return kv[0], kv[1]


def nsa_attend(q, t_pos, gts, cmp_k, cmp_v, cmp_end, sel_k, sel_v, win_k, win_v, win_pos, slopes):
    f32 = jnp.float32
    B = q.shape[0]
    qf = q.astype(f32) * HEAD_DIM ** -0.5
    m = slopes[None, :, :, None, None]
    s = jnp.einsum('bqhgd,bnhd->bhgqn', qf, cmp_k.astype(f32))
    dist = (t_pos[:, None] - cmp_end[None, :]).astype(f32)
    p_cmp = masked_softmax(s - m * dist, cmp_end[None, :] <= t_pos[:, None])
    o_cmp = jnp.einsum('bhgqn,bnhd->bqhgd', p_cmp, cmp_v.astype(f32))
    nc = cmp_k.shape[1]
    nsb = sel_k.shape[2]
    imp = jnp.sum(p_cmp, axis=2)
    imp = jnp.pad(imp, ((0, 0), (0, 0), (0, 0), (0, nsb * CMP_PER_SEL - nc)))
    imp = imp.reshape(*imp.shape[:3], nsb, CMP_PER_SEL).sum(-1)
    blk = jnp.arange(nsb, dtype=jnp.int32)[None, :]
    cur = (t_pos // SEL_BLOCK)[:, None]
    forced = (blk == 0) | (blk == cur) | (blk == cur - 1)
    score = jnp.where(blk <= cur, jnp.where(forced, FORCE_SCORE, imp), NEG_INF)
    top_s, top_i = lax.top_k(score, min(SEL_TOPN, nsb))
    bi = jnp.arange(B)[:, None, None, None]
    hi = jnp.arange(NSA_KV_HEADS)[None, :, None, None]
    k_sel = sel_k[bi, hi, top_i].astype(f32)
    v_sel = sel_v[bi, hi, top_i].astype(f32)
    pos = top_i[..., None] * SEL_BLOCK + jnp.arange(SEL_BLOCK, dtype=jnp.int32)
    tq = t_pos[None, None, :, None, None]
    mask = ((top_s > 0.5 * NEG_INF)[..., None] & (pos <= tq))[:, :, None]
    dist = (tq - pos).astype(f32)[:, :, None]
    s = jnp.einsum('bqhgd,bhqnld->bhgqnl', qf, k_sel)
    p_sel = masked_softmax(s - m[..., None] * dist, mask, axis=(-2, -1))
    o_sel = jnp.einsum('bhgqnl,bhqnld->bqhgd', p_sel, v_sel)
    s = jnp.einsum('bqhgd,bkhd->bhgqk', qf, win_k.astype(f32))
    delta = t_pos[:, None] - win_pos[None, :]
    wmask = (delta >= 0) & (delta < WINDOW) & (win_pos[None, :] >= 0)
    p_win = masked_softmax(s - m * delta.astype(f32), wmask)
    o_win = jnp.einsum('bhgqk,bkhd->bqhgd', p_win, win_v.astype(f32))
    gate = jax.nn.sigmoid(gts.astype(f32))
    o = gate[..., 0:1] * o_cmp + gate[..., 1:2] * o_sel + gate[..., 2:3] * o_win
    return o.reshape(*q.shape[:2], NSA_WIDTH).astype(q.dtype)


def nsa_prompt(q, gts, kvc, kvs, kvw, cw, slopes):
    B, T = q.shape[:2]
    ckv, cmp_end = compress_blocks(kvc, *cw)
    sel_k, sel_v = selection_blocks(kvs)
    win = jnp.pad(kvw, ((0, 0), (WINDOW, 0), (0, 0), (0, 0), (0, 0)))
    nqb = T // NSA_Q_BLOCK
    qb = q.reshape(B, nqb, NSA_Q_BLOCK, *q.shape[2:]).swapaxes(0, 1)
    gb = gts.reshape(B, nqb, NSA_Q_BLOCK, *gts.shape[2:]).swapaxes(0, 1)

    def one_block(args):
        i, q_i, g_i = args
        start = i * NSA_Q_BLOCK
        t_pos = start + jnp.arange(NSA_Q_BLOCK, dtype=jnp.int32)
        w_i = lax.dynamic_slice_in_dim(win, start, WINDOW + NSA_Q_BLOCK, axis=1)
        w_pos = start - WINDOW + jnp.arange(WINDOW + NSA_Q_BLOCK, dtype=jnp.int32)
        return nsa_attend(q_i, t_pos, g_i, ckv[:, :, 0], ckv[:, :, 1], cmp_end, sel_k, sel_v,
                          w_i[:, :, 0], w_i[:, :, 1], w_pos, slopes)

    out = lax.map(one_block, (jnp.arange(nqb, dtype=jnp.int32), qb, gb))
    return out.swapaxes(0, 1).reshape(B, T, NSA_WIDTH)


def nsa_sample(q, gts, kvc, kvs, kvw, cache_cmp, cache_sel, page_table, win_buf, cw, slopes):
    Bd, Tn = q.shape[:2]
    past = page_table.shape[1] * PAGE_SIZE

    def with_past(cache, new):
        rows = cache[page_table].reshape(Bd, past, *cache.shape[2:])
        return jnp.concatenate([rows, new.astype(cache.dtype)], axis=1)

    ckv, cmp_end = compress_blocks(with_past(cache_cmp, kvc), *cw)
    sel_k, sel_v = selection_blocks(with_past(cache_sel, kvs))
    wkv = jnp.concatenate([win_buf, kvw.astype(win_buf.dtype)], axis=1)
    n_buf = win_buf.shape[1]
    t_pos = past + jnp.arange(Tn, dtype=jnp.int32)
    w_pos = past - n_buf + jnp.arange(n_buf + Tn, dtype=jnp.int32)
    o = nsa_attend(q, t_pos, gts, ckv[:, :, 0], ckv[:, :, 1], cmp_end, sel_k, sel_v,
                   wkv[:, :, 0], wkv[:, :, 1], w_pos, slopes)
    return o, wkv[:, Tn:]


def chunk_gated_delta(q, k, v, g, beta, s0):
    B, T, H, dk = q.shape
    dv = v.shape[-1]
    C = GDN_CHUNK
    n = -(-T // C)
    pad = n * C - T

    def chunks(a):
        a = jnp.pad(a, ((0, 0), (0, pad)) + ((0, 0),) * (a.ndim - 2))
        a = a.reshape(B, n, C, *a.shape[2:])
        return jnp.moveaxis(a, 3, 1)

    q, k, v, g, beta = (chunks(a) for a in (q, k, v, g, beta))
    G = jnp.cumsum(g, axis=-1)
    tri = jnp.tril(jnp.ones((C, C), bool))
    strict = jnp.tril(jnp.ones((C, C), bool), -1)
    diff = G[..., :, None] - G[..., None, :]
    decay = jnp.where(tri, jnp.exp(jnp.where(tri, diff, 0.0)), 0.0)
    kb = k * beta[..., None]
    A = jnp.einsum('bhncd,bhnmd->bhncm', kb, k) * jnp.where(strict, decay, 0.0)
    M = A + jnp.eye(C, dtype=A.dtype)
    rhs = jnp.concatenate([v * beta[..., None], kb * jnp.exp(G)[..., None]], axis=-1)
    sol = lax.linalg.triangular_solve(M, rhs, left_side=True, lower=True, unit_diagonal=True)
    U, W = sol[..., :dv], sol[..., dv:]
    qk = jnp.einsum('bhncd,bhnmd->bhncm', q, k) * decay
    qg = q * jnp.exp(G)[..., None]
    kd = k * jnp.exp(G[..., -1:] - G)[..., None]
    g_last = jnp.exp(G[..., -1])

    def step(S, xs):
        U_c, W_c, qk_c, qg_c, kd_c, gl_c = xs
        v_new = U_c - jnp.einsum('bhcd,bhde->bhce', W_c, S)
        o_c = jnp.einsum('bhcd,bhde->bhce', qg_c, S) + jnp.einsum('bhcm,bhme->bhce', qk_c, v_new)
        S = S * gl_c[..., None, None] + jnp.einsum('bhcd,bhce->bhde', kd_c, v_new)
        return S, o_c

    xs = tuple(jnp.moveaxis(a, 2, 0) for a in (U, W, qk, qg, kd, g_last))
    S, o = lax.scan(step, s0, xs)
    o = jnp.moveaxis(o, 0, 2).transpose(0, 2, 3, 1, 4).reshape(B, n * C, H, dv)[:, :T]
    return o, S


def gdn_mix(qkv, z, b_logit, a_logit, conv_buf, s0, conv_w, a_log, dt_bias, gn_w):
    f32 = jnp.float32
    B, T = qkv.shape[:2]
    xpad = jnp.concatenate([conv_buf.astype(qkv.dtype), qkv], axis=1)
    conv = sum(xpad[:, i:i + T] * conv_w[i] for i in range(CONV_WIDTH))
    conv = jax.nn.silu(conv.astype(f32))

    def heads(a):
        return a.reshape(B, T, GDN_HEADS, HEAD_DIM)

    q = l2norm(heads(conv[..., :GDN_WIDTH])) * HEAD_DIM ** -0.5
    k = l2norm(heads(conv[..., GDN_WIDTH:2 * GDN_WIDTH]))
    v = heads(conv[..., 2 * GDN_WIDTH:])
    beta = jax.nn.sigmoid(b_logit.astype(f32))
    g = -jnp.exp(a_log.astype(f32)) * jax.nn.softplus(a_logit.astype(f32) + dt_bias.astype(f32))
    o, s_new = chunk_gated_delta(q, k, v, g, beta, s0.astype(f32))
    o = rmsnorm(o, gn_w) * jax.nn.silu(heads(z).astype(f32))
    return o.reshape(B, T, GDN_WIDTH).astype(qkv.dtype), xpad[:, T:], s_new.astype(s0.dtype)


def peer_ffn(h, w_q, sub_keys, u_tab, v_tab):
    B, T, D = h.shape
    n = B * T
    nb = -(-n // PEER_BLOCK)
    flat = jnp.pad(h.reshape(n, D), ((0, nb * PEER_BLOCK - n), (0, 0))).reshape(nb, PEER_BLOCK, D)

    def one_block(hb):
        f32 = jnp.float32
        q = (hb @ w_q).astype(f32).reshape(PEER_BLOCK, PEER_HEADS, 2, PEER_QDIM // 2)
        s = jnp.einsum('nhpd,pkd->nhpk', q, sub_keys.astype(f32))
        s_half, i_half = lax.top_k(s, PEER_TOPK)
        cand = (s_half[:, :, 0, :, None] + s_half[:, :, 1, None, :]).reshape(PEER_BLOCK, PEER_HEADS, PEER_TOPK * PEER_TOPK)
        cid = (i_half[:, :, 0, :, None] * PEER_NKEYS + i_half[:, :, 1, None, :]).reshape(PEER_BLOCK, PEER_HEADS, PEER_TOPK * PEER_TOPK)
        best_s, best_j = lax.top_k(cand, PEER_TOPK)
        eid = jnp.take_along_axis(cid, best_j, axis=-1)
        gate = jax.nn.softmax(best_s, axis=-1)
        act = jax.nn.gelu(jnp.einsum('nd,nhkd->nhk', hb.astype(f32), u_tab[eid].astype(f32)))
        out = jnp.einsum('nhk,nhkd->nd', gate * act, v_tab[eid].astype(f32))
        return out.astype(hb.dtype)

    out = lax.map(one_block, flat)
    return out.reshape(nb * PEER_BLOCK, D)[:n].reshape(B, T, D)


def conditioned_layer(x, c, mixer, w_ada, b_ada, norm_mix, norm_ffn, w_in, w_out,
                      peer_wq, peer_keys, peer_u, peer_v):
    sh1, sc1, g1, sh2, sc2, g2 = adaln(c, w_ada, b_ada)
    h = rmsnorm(x, norm_mix) * (1.0 + sc1[:, None]) + sh1[:, None]
    mixed, states = mixer(split_projection(h @ w_in))
    x = x + g1[:, None] * (mixed @ w_out)
    h = rmsnorm(x, norm_ffn) * (1.0 + sc2[:, None]) + sh2[:, None]
    x = x + g2[:, None] * peer_ffn(h, peer_wq, peer_keys, peer_u, peer_v)
    return x, states


def stack_layers(per_layer, i):
    return jnp.stack([st[i] for st in per_layer])


def setup_inputs(seed: int = 0) -> dict:
    key = jax.random.key(seed)
    ks = iter(jax.random.split(key, 40))

    def nrm(shape, scale):
        return jax.random.normal(next(ks), shape, jnp.float32) * scale

    n_pages = PAST_LEN // PAGE_SIZE
    n_phys = (DEC_BATCH * n_pages * 5) // 4
    w_buf = min(WINDOW, PAST_LEN)
    row = (2, NSA_KV_HEADS, HEAD_DIM)
    page_table = jax.random.permutation(next(ks), n_phys)[:DEC_BATCH * n_pages].reshape(DEC_BATCH, n_pages).astype(jnp.int32)
    dt = jnp.exp(jax.random.uniform(next(ks), (DEPTH, GDN_HEADS), jnp.float32, minval=math.log(1e-3), maxval=math.log(1e-1)))
    a_init = jax.random.uniform(next(ks), (DEPTH, GDN_HEADS), jnp.float32, minval=1.0, maxval=16.0)
    return {
        'x_prompt': nrm((BATCH, SEQ, D_MODEL), 1.0),
        'x_sample': nrm((DEC_BATCH, DEC_SEQ, D_MODEL), 1.0),
        'cache_cmp_kv': nrm((DEPTH, n_phys, PAGE_SIZE) + row, 1.0),
        'cache_sel_kv': nrm((DEPTH, n_phys, PAGE_SIZE) + row, 1.0),
        'state_win_kv': nrm((DEPTH, DEC_BATCH, w_buf) + row, 1.0),
        'state_conv': nrm((DEPTH, DEC_BATCH, CONV_WIDTH - 1, 3 * GDN_WIDTH), 1.0),
        'state_gdn': nrm((DEPTH, DEC_BATCH, GDN_HEADS, HEAD_DIM, HEAD_DIM), 0.1),
        'page_table': page_table,
        'c_prompt': nrm((BATCH, D_MODEL), 1.0),
        'c_sample': nrm((DEC_BATCH, D_MODEL), 1.0),
        'w_ada': nrm((DEPTH, D_MODEL, 6 * D_MODEL), 0.5 * D_MODEL ** -0.5),
        'b_ada': nrm((DEPTH, 6 * D_MODEL), 0.01),
        'norm_mix': 1.0 + nrm((DEPTH, D_MODEL), 0.02),
        'norm_ffn': 1.0 + nrm((DEPTH, D_MODEL), 0.02),
        'w_in': nrm((DEPTH, D_MODEL, IN_COLS), D_MODEL ** -0.5),
        'cmp_pe': nrm((DEPTH, 2, CMP_BLOCK, HEAD_DIM), 0.02),
        'cmp_w1': nrm((DEPTH, 2, CMP_BLOCK, HEAD_DIM, CMP_HIDDEN), (CMP_BLOCK * HEAD_DIM) ** -0.5),
        'cmp_b1': nrm((DEPTH, 2, CMP_HIDDEN), 0.01),
        'cmp_w2': nrm((DEPTH, 2, CMP_HIDDEN, HEAD_DIM), CMP_HIDDEN ** -0.5),
        'conv_w': nrm((DEPTH, CONV_WIDTH, 3 * GDN_WIDTH), CONV_WIDTH ** -0.5),
        'gdn_a_log': jnp.log(a_init),
        'gdn_dt_bias': jnp.log(jnp.expm1(dt)),
        'gdn_norm': 1.0 + nrm((DEPTH, HEAD_DIM), 0.02),
        'w_out': nrm((DEPTH, D_MODEL, D_MODEL), D_MODEL ** -0.5),
        'peer_wq': nrm((DEPTH, D_MODEL, PEER_HEADS * PEER_QDIM), D_MODEL ** -0.5),
        'peer_keys': nrm((DEPTH, 2, PEER_NKEYS, PEER_QDIM // 2), (PEER_QDIM // 2) ** -0.5),
        'peer_u': nrm((DEPTH, PEER_N_EXPERTS, D_MODEL), D_MODEL ** -0.5),
        'peer_v': nrm((DEPTH, PEER_N_EXPERTS, D_MODEL), PEER_HEADS ** -0.5),
        'final_norm': 1.0 + nrm((D_MODEL,), 0.02),
    }


def reference(x_prompt, x_sample, cache_cmp_kv, cache_sel_kv, state_win_kv, state_conv, state_gdn,
              page_table, c_prompt, c_sample, w_ada, b_ada, norm_mix, norm_ffn, w_in, cmp_pe, cmp_w1,
              cmp_b1, cmp_w2, conv_w, gdn_a_log, gdn_dt_bias, gdn_norm, w_out, peer_wq, peer_keys,
              peer_u, peer_v, final_norm):
    slopes = alibi_slopes(NSA_HEADS).reshape(NSA_KV_HEADS, NSA_GROUP)
    xp, xs = x_prompt, x_sample
    prompt_states, sample_states = [], []
    for l in range(DEPTH):
        cw = (cmp_pe[l], cmp_w1[l], cmp_b1[l], cmp_w2[l])
        gw = (conv_w[l], gdn_a_log[l], gdn_dt_bias[l], gdn_norm[l])
        shared = (w_ada[l], b_ada[l], norm_mix[l], norm_ffn[l], w_in[l], w_out[l],
                  peer_wq[l], peer_keys[l], peer_u[l], peer_v[l])

        def prompt_mixer(parts):
            q, kvc, kvs, kvw, gts, qkv, z, bl, al = parts
            o_nsa = nsa_prompt(q, gts, kvc, kvs, kvw, cw, slopes)
            Bp, T = q.shape[:2]
            conv0 = jnp.zeros((Bp, CONV_WIDTH - 1, qkv.shape[-1]), qkv.dtype)
            s0 = jnp.zeros((Bp, GDN_HEADS, HEAD_DIM, HEAD_DIM), jnp.float32)
            o_gdn, conv_new, s_new = gdn_mix(qkv, z, bl, al, conv0, s0, *gw)
            keep = min(WINDOW, T)
            return jnp.concatenate([o_nsa, o_gdn], axis=-1), (kvc, kvs, kvw[:, T - keep:], conv_new, s_new)

        def sample_mixer(parts):
            q, kvc, kvs, kvw, gts, qkv, z, bl, al = parts
            o_nsa, win_new = nsa_sample(q, gts, kvc, kvs, kvw, cache_cmp_kv[l], cache_sel_kv[l],
                                        page_table, state_win_kv[l], cw, slopes)
            o_gdn, conv_new, s_new = gdn_mix(qkv, z, bl, al, state_conv[l], state_gdn[l], *gw)
            return jnp.concatenate([o_nsa, o_gdn], axis=-1), (kvc, kvs, win_new, conv_new, s_new)

        xp, st_p = conditioned_layer(xp, c_prompt, prompt_mixer, *shared)
        xs, st_s = conditioned_layer(xs, c_sample, sample_mixer, *shared)
        prompt_states.append(st_p)
        sample_states.append(st_s)
    y_prompt = rmsnorm(xp, final_norm)
    y_sample = rmsnorm(xs, final_norm)
    return (y_prompt, y_sample,
            stack_layers(prompt_states, 0), stack_layers(sample_states, 0),
            stack_layers(prompt_states, 1), stack_layers(sample_states, 1),
            stack_layers(prompt_states, 2), stack_layers(sample_states, 2),
            stack_layers(prompt_states, 3), stack_layers(sample_states, 3),
            stack_layers(prompt_states, 4), stack_layers(sample_states, 4))
```

```cpp
#include <hip/hip_runtime.h>
#include <stdint.h>
#include <stdio.h>

#ifndef N_LAUNCHES
#define N_LAUNCHES 10
#endif

typedef unsigned short bf16_t;
typedef short bf16x8 __attribute__((ext_vector_type(8)));
typedef float f32x4 __attribute__((ext_vector_type(4)));

constexpr int DM = 2048, SEQ = 2048, NB = 4, NSB = 8;
constexpr int NP = NB * SEQ;
constexpr int NTOK = NP + NSB;
constexpr int MPAD = 8448;
constexpr int INC = 6696, INCP = 6912;
constexpr int C_Q = 0, C_KVC = 1024, C_KVS = 1536, C_KVW = 2048, C_GTS = 2560, C_QKV = 2584, C_Z = 5656, C_BL = 6680, C_AL = 6688;
constexpr int PAST = 16384, NPAGES = 128;
constexpr int NPH = 10;
constexpr int LDS_BYTES = 147456;
constexpr int NTHR = 512;

struct Params {
    const float *x_prompt, *x_sample, *cache_cmp, *cache_sel, *state_win, *state_conv, *state_gdn;
    const int* page_table;
    const float *c_prompt, *c_sample, *w_ada, *b_ada, *norm_mix, *norm_ffn, *w_in, *cmp_pe, *cmp_w1, *cmp_b1, *cmp_w2,
        *conv_w, *a_log, *dt_bias, *gdn_norm, *w_out, *peer_wq, *peer_keys, *peer_u, *peer_v, *final_norm;
    float* out;
    unsigned* bar;
    float* mod;
    bf16_t* h1;
    bf16_t* wt_in;
    bf16_t* wt_out;
    bf16_t* wt_q;
    float* P;
    float* ckv_p;
    float* ckv_s;
    float* qkvn;
    float* gbeta;
    float* gg;
    float* ograw;
    bf16_t* amix;
    float* acc2;
    float* x1;
    float* h2f;
    bf16_t* h2;
    float* qp;
    int ph_lo, ph_hi;
};

constexpr size_t O_YP = 0, O_YS = O_YP + (size_t)NP * DM, O_CKP = O_YS + (size_t)NSB * DM, O_CKS = O_CKP + (size_t)NP * 512,
                 O_SKP = O_CKS + NSB * 512, O_SKS = O_SKP + (size_t)NP * 512, O_WKP = O_SKS + NSB * 512, O_WKS = O_WKP + (size_t)NB * 512 * 512,
                 O_CVP = O_WKS + (size_t)NSB * 512 * 512, O_CVS = O_CVP + NB * 3 * 3072, O_GP = O_CVS + NSB * 3 * 3072,
                 O_GS = O_GP + (size_t)NB * 8 * 128 * 128, O_END = O_GS + (size_t)NSB * 8 * 128 * 128;

__device__ __forceinline__ bf16_t f2bf(float f) { unsigned u = __float_as_uint(f); u += 0x7fffu + ((u >> 16) & 1u); return (bf16_t)(u >> 16); }
__device__ __forceinline__ float wave_sum(float v) { for (int o = 32; o > 0; o >>= 1) v += __shfl_xor(v, o); return v; }
__device__ __forceinline__ float wave_max(float v) { for (int o = 32; o > 0; o >>= 1) v = fmaxf(v, __shfl_xor(v, o)); return v; }
__device__ __forceinline__ float silu_f(float x) { return x / (1.f + __expf(-x)); }
__device__ __forceinline__ float sigmoid_f(float x) { return 1.f / (1.f + __expf(-x)); }
__device__ __forceinline__ float gelu_tanh(float x) { return 0.5f * x * (1.f + tanhf(0.7978845608028654f * (x + 0.044715f * x * x * x))); }
__device__ __forceinline__ float softplus_f(float x) { return x > 20.f ? x : log1pf(__expf(x)); }

#define XB_TMO      128
#define XB_XCNT(j)  (256  + 64 * (j))
#define XB_XSUB(j)  (1280 + 64 * (j))
#define XB_XGEN(j)  (2304 + 64 * (j))
#define XB_TOP      3328
#define XB_TOPGEN   3392
#define XCD_BAR_WORDS 3456
#define XB_SPIN_CAP (1u << 18)
#define LAS __attribute__((address_space(3)))
__device__ __forceinline__ unsigned xb_ld(unsigned* p)              { return __hip_atomic_load(p, __ATOMIC_RELAXED, __HIP_MEMORY_SCOPE_AGENT); }
__device__ __forceinline__ unsigned xb_add(unsigned* p, unsigned v) { return __hip_atomic_fetch_add(p, v, __ATOMIC_RELAXED, __HIP_MEMORY_SCOPE_AGENT); }
__device__ __forceinline__ unsigned xb_xcc_id() { return (unsigned)__builtin_amdgcn_s_getreg((3 << 11) | 20) & 0xFu; }
#define XB_SPIN(cond, bar) do { unsigned _sp = 0; while (cond) { __builtin_amdgcn_s_sleep(1); \
    if ((++_sp & 255u) == 0u) { if (xb_ld(&(bar)[XB_TMO])) break; if (_sp > XB_SPIN_CAP) { atomicAdd(&(bar)[XB_TMO], 1u); break; } } } } while (0)
struct XcdBarrier { unsigned* bar; unsigned x; volatile LAS unsigned* st; };
__device__ __forceinline__ XcdBarrier xcd_barrier_post(unsigned* bar, volatile LAS unsigned* st) {
    XcdBarrier b; b.bar = bar; b.x = xb_xcc_id(); b.st = st;
    if (threadIdx.x == 0) (void)xb_add(&bar[XB_XCNT(b.x)], 1u);
    return b;
}
__device__ __forceinline__ void xcd_barrier_complete(unsigned* bar, unsigned x, unsigned& nloc, unsigned& nx) {
    const unsigned G = gridDim.x * gridDim.y * gridDim.z;
    unsigned sum, cnt, mine, sp = 0u;
    for (;;) {
        sum = 0u; cnt = 0u; mine = 0u;
#pragma unroll
        for (unsigned j = 0; j < 16; ++j) { const unsigned c = xb_ld(&bar[XB_XCNT(j)]); sum += c; cnt += (c > 0u) ? 1u : 0u; mine = (j == x) ? c : mine; }
        if (sum == G) break;
        __builtin_amdgcn_s_sleep(1);
        if ((++sp & 255u) == 0u) { if (xb_ld(&bar[XB_TMO])) break; if (sp > XB_SPIN_CAP) { atomicAdd(&bar[XB_TMO], 1u); break; } }
    }
    nloc = mine > 0u ? mine : 1u; nx = cnt > 0u ? cnt : 1u;
}
__device__ __forceinline__ void xcd_barrier(const XcdBarrier& b) {
    asm volatile("s_waitcnt vmcnt(0)" ::: "memory");
    __syncthreads();
    if (threadIdx.x == 0) {
        unsigned* bar = b.bar;
        __builtin_amdgcn_s_waitcnt(0);
        unsigned nloc = b.st[0], nx = b.st[1];
        if (nloc == 0u) { xcd_barrier_complete(bar, b.x, nloc, nx); b.st[0] = nloc; b.st[1] = nx; }
        const unsigned old = xb_add(&bar[XB_XSUB(b.x)], 1u);
        const unsigned gen = old / nloc;
        if (old + 1u == (gen + 1u) * nloc) {
            __builtin_amdgcn_fence(__ATOMIC_RELEASE, "agent");
            asm volatile("s_waitcnt vmcnt(0)" ::: "memory");
            const unsigned og = xb_add(&bar[XB_TOP], 1u);
            const unsigned tg = og / nx;
            if (og + 1u == (tg + 1u) * nx) xb_add(&bar[XB_TOPGEN], 1u);
            else XB_SPIN(xb_ld(&bar[XB_TOPGEN]) == tg, bar);
            __builtin_amdgcn_fence(__ATOMIC_ACQUIRE, "agent");
            xb_add(&bar[XB_XGEN(b.x)], 1u);
            asm volatile("s_waitcnt vmcnt(0)" ::: "memory");
        } else {
            XB_SPIN(xb_ld(&bar[XB_XGEN(b.x)]) == gen, bar);
            __builtin_amdgcn_fence(__ATOMIC_ACQUIRE, "agent");
            asm volatile("s_waitcnt vmcnt(0)" ::: "memory");
        }
    }
    __syncthreads();
}

constexpr int BM = 256, BK = 64, HALF = 128, HT = HALF * BK;
__device__ __forceinline__ int lds_byte(int r, int c) { int st = (r >> 4) * 2 + (c >> 5), rr = r & 15, cc = c & 31, ob = rr * 64 + cc * 2; return st * 1024 + (ob ^ (((ob >> 9) & 1) << 5)); }
__device__ __forceinline__ void stage_rc(int b, int& R, int& C) { int st = b / 1024, sb = b % 1024, swz = sb ^ (((sb >> 9) & 1) << 5); R = (st >> 1) * 16 + swz / 64; C = (st & 1) * 32 + (swz % 64) / 2; }

template <class Epi>
__device__ __forceinline__ void gemm_tile(const bf16_t* __restrict__ A, const bf16_t* __restrict__ Bt, const int K, const int brow, const int bcol, bf16_t* shm, const Epi& epi) {
#define SA(b, h) (shm + ((b) * 2 + (h)) * HT)
#define SB(b, h) (shm + (4 + (b) * 2 + (h)) * HT)
#define STAGE_X(T, Pp, BASE, br, kt) do { long _g = (long)(br) * K + (long)(kt) * BK; \
    for (int _i = 0; _i < 2; ++_i) { int _b = (T) * 16 + _i * 8192; int _r, _c; stage_rc(_b, _r, _c); \
      __builtin_amdgcn_global_load_lds((const unsigned*)(BASE + _g + (long)_r * K + _c), (LAS unsigned*)((LAS char*)(Pp) + _b), 16, 0, 0); } } while (0)
#define STAGE(Pp, BASE, br, kt) STAGE_X(threadIdx.x, Pp, BASE, br, kt)
#define LDA(dst, b, h) for (int m = 0; m < 4; ++m) for (int k = 0; k < 2; ++k) \
    dst[m][k] = *reinterpret_cast<const bf16x8*>((char*)SA(b, h) + lds_byte(wr * 64 + m * 16 + fr, k * 32 + fq * 8))
#define LDB(dst, b, h) for (int n = 0; n < 2; ++n) for (int k = 0; k < 2; ++k) \
    dst[n][k] = *reinterpret_cast<const bf16x8*>((char*)SB(b, h) + lds_byte(wc * 32 + n * 16 + fr, k * 32 + fq * 8))
#define MMA(ai, bj, At, Bt_) do { __builtin_amdgcn_s_setprio(1); \
    for (int m = 0; m < 4; ++m) for (int n = 0; n < 2; ++n) for (int k = 0; k < 2; ++k) \
      acc[ai][bj][m][n] = __builtin_amdgcn_mfma_f32_16x16x32_bf16(At[m][k], Bt_[n][k], acc[ai][bj][m][n], 0, 0, 0); \
    __builtin_amdgcn_s_setprio(0); } while (0)
#define WAIT_V(n) asm volatile("s_waitcnt vmcnt(" #n ")" ::: "memory")
#define WAIT_L(n) asm volatile("s_waitcnt lgkmcnt(" #n ")" ::: "memory")
#define BAR __builtin_amdgcn_s_barrier()
#define SCHED __builtin_amdgcn_sched_barrier(0)
    int wid = threadIdx.x >> 6, lane = threadIdx.x & 63, wr = wid >> 2, wc = wid & 3, fr = lane & 15, fq = lane >> 4;
    f32x4 acc[2][2][4][2] = {};
    bf16x8 At[4][2], B0[2][2], B1[2][2];
    const int nt = K / BK;
    STAGE(SB(0, 0), Bt, bcol, 0); STAGE(SA(0, 0), A, brow, 0);
    STAGE(SB(0, 1), Bt, bcol + HALF, 0); STAGE(SA(0, 1), A, brow + HALF, 0);
    if (wr == 1) BAR;
    WAIT_V(4); BAR;
    STAGE(SB(1, 0), Bt, bcol, 1); STAGE(SA(1, 0), A, brow, 1); STAGE(SB(1, 1), Bt, bcol + HALF, 1);
    WAIT_V(6); BAR;
    for (int t = 0; t < nt - 2; t += 2) {
        LDB(B0, 0, 0); SCHED; LDA(At, 0, 0); STAGE(SA(1, 1), A, brow + HALF, t + 1);
        WAIT_L(8); BAR; WAIT_L(0); MMA(0, 0, At, B0); BAR; SCHED;
        LDB(B1, 0, 1); STAGE(SB(0, 0), Bt, bcol, t + 2);
        BAR; WAIT_L(0); MMA(0, 1, At, B1); BAR;
        LDA(At, 0, 1); STAGE(SA(0, 0), A, brow, t + 2);
        BAR; WAIT_L(0); MMA(1, 0, At, B0); BAR; SCHED;
        STAGE(SB(0, 1), Bt, bcol + HALF, t + 2);
        WAIT_V(6); BAR; MMA(1, 1, At, B1); BAR;
        LDB(B0, 1, 0); SCHED; LDA(At, 1, 0); STAGE(SA(0, 1), A, brow + HALF, t + 2);
        WAIT_L(8); BAR; WAIT_L(0); MMA(0, 0, At, B0); BAR; SCHED;
        LDB(B1, 1, 1); STAGE(SB(1, 0), Bt, bcol, t + 3);
        BAR; WAIT_L(0); MMA(0, 1, At, B1); BAR;
        LDA(At, 1, 1); STAGE(SA(1, 0), A, brow, t + 3);
        BAR; WAIT_L(0); MMA(1, 0, At, B0); BAR; SCHED;
        STAGE(SB(1, 1), Bt, bcol + HALF, t + 3);
        WAIT_V(6); BAR; MMA(1, 1, At, B1); BAR;
    }
    int tz = threadIdx.x; asm volatile("" : "+v"(tz)); wid = tz >> 6; lane = tz & 63; wr = wid >> 2; wc = wid & 3; fr = lane & 15; fq = lane >> 4;
    { LDB(B0, 0, 0); WAIT_V(0); LDA(At, 0, 0); STAGE_X(tz, SA(1, 1), A, brow + HALF, nt - 1);
      BAR; WAIT_L(0); MMA(0, 0, At, B0); BAR;
      LDB(B1, 0, 1); BAR; WAIT_L(0); MMA(0, 1, At, B1); BAR;
      LDA(At, 0, 1); WAIT_V(4); BAR; WAIT_L(0); MMA(1, 0, At, B0); MMA(1, 1, At, B1); BAR; }
    { LDB(B0, 1, 0); LDA(At, 1, 0); WAIT_V(2); BAR; WAIT_L(0); MMA(0, 0, At, B0); BAR;
      LDB(B1, 1, 1); WAIT_V(0); BAR; WAIT_L(0); MMA(0, 1, At, B1); BAR;
      LDA(At, 1, 1); BAR; WAIT_L(0); MMA(1, 0, At, B0); MMA(1, 1, At, B1); BAR; }
    if (wr == 0) BAR;
    for (int ai = 0; ai < 2; ++ai) for (int bj = 0; bj < 2; ++bj) for (int m = 0; m < 4; ++m) for (int n = 0; n < 2; ++n) for (int j = 0; j < 4; ++j)
        epi(brow + ai * HALF + wr * 64 + m * 16 + fq * 4 + j, bcol + bj * HALF + wc * 32 + n * 16 + fr, acc[ai][bj][m][n][j]);
    __syncthreads();
#undef SA
#undef SB
}

__device__ __forceinline__ void ph0_adaln(const Params& p, int u, float* smem) {
    float* sc = smem;
    float* red = smem + 12 * 2048;
    const int tid = threadIdx.x;
    for (int i = tid; i < 12 * 2048; i += NTHR) { const int r = i >> 11, k = i & 2047; const float c = r < 4 ? p.c_prompt[r * 2048 + k] : p.c_sample[(r - 4) * 2048 + k]; sc[i] = silu_f(c); }
    __syncthreads();
    const int col = u * 128 + (tid & 127), ks = tid >> 7;
    float a[12];
#pragma unroll
    for (int r = 0; r < 12; ++r) a[r] = 0.f;
    const float* w = p.w_ada + (size_t)(ks * 512) * 12288 + col;
    for (int k = 0; k < 512; ++k) {
        const float wv = w[(size_t)k * 12288];
#pragma unroll
        for (int r = 0; r < 12; ++r) a[r] += sc[r * 2048 + ks * 512 + k] * wv;
    }
#pragma unroll
    for (int r = 0; r < 12; ++r) red[(ks * 12 + r) * 128 + (tid & 127)] = a[r];
    __syncthreads();
    for (int i = tid; i < 12 * 128; i += NTHR) { const int r = i >> 7, c = i & 127; const int cc = u * 128 + c;
        p.mod[r * 12288 + cc] = red[(0 * 12 + r) * 128 + c] + red[(1 * 12 + r) * 128 + c] + red[(2 * 12 + r) * 128 + c] + red[(3 * 12 + r) * 128 + c] + p.b_ada[cc]; }
    __syncthreads();
}
__device__ __forceinline__ void ph0_transpose(const float* __restrict__ W, bf16_t* __restrict__ Wt, int Nreal, int ntn, int u, float* smem) {
    const int tk = u / ntn, tn = u % ntn, k0 = tk * 64, n0 = tn * 64, tid = threadIdx.x;
    for (int i = 0; i < 8; ++i) { const int idx = tid + NTHR * i, kk = idx >> 6, nn = idx & 63; smem[kk * 65 + nn] = (n0 + nn < Nreal) ? W[(size_t)(k0 + kk) * Nreal + n0 + nn] : 0.f; }
    __syncthreads();
    for (int i = 0; i < 8; ++i) { const int idx = tid + NTHR * i, nn = idx >> 6, kk = idx & 63; Wt[(size_t)(n0 + nn) * 2048 + k0 + kk] = f2bf(smem[kk * 65 + nn]); }
    __syncthreads();
}

template <int WHICH>
__device__ __forceinline__ void norm_row(const Params& p, int row) {
    const int lane = threadIdx.x & 63;
    bf16_t* dst = (WHICH == 0 ? p.h1 : p.h2) + (size_t)row * 2048;
    if (row >= NTOK) { for (int i = 0; i < 8; ++i) { const int c = i * 256 + lane * 4; *(uint2*)(dst + c) = make_uint2(0u, 0u); } return; }
    const int mrow = row < NP ? row / SEQ : 4 + (row - NP);
    const float* xr = row < NP ? p.x_prompt + (size_t)row * 2048 : p.x_sample + (size_t)(row - NP) * 2048;
    const float* mod = p.mod + (size_t)mrow * 12288;
    const float* nw = WHICH == 0 ? p.norm_mix : p.norm_ffn;
    float4 v[8]; float ss = 0.f;
#pragma unroll
    for (int i = 0; i < 8; ++i) { const int c = i * 256 + lane * 4; v[i] = *(const float4*)(xr + c);
        if (WHICH == 1) { const float4 a = *(const float4*)(p.acc2 + (size_t)row * 2048 + c); const float4 g = *(const float4*)(mod + 4096 + c);
            v[i].x += g.x * a.x; v[i].y += g.y * a.y; v[i].z += g.z * a.z; v[i].w += g.w * a.w; *(float4*)(p.x1 + (size_t)row * 2048 + c) = v[i]; }
        ss += v[i].x * v[i].x + v[i].y * v[i].y + v[i].z * v[i].z + v[i].w * v[i].w; }
    ss = wave_sum(ss);
    const float rstd = rsqrtf(ss * (1.f / 2048.f) + 1e-6f);
    const int osh = WHICH == 0 ? 0 : 6144, osc = WHICH == 0 ? 2048 : 8192;
#pragma unroll
    for (int i = 0; i < 8; ++i) { const int c = i * 256 + lane * 4;
        const float4 w = *(const float4*)(nw + c), sc = *(const float4*)(mod + osc + c), sh = *(const float4*)(mod + osh + c);
        float4 h; h.x = v[i].x * rstd * w.x * (1.f + sc.x) + sh.x; h.y = v[i].y * rstd * w.y * (1.f + sc.y) + sh.y; h.z = v[i].z * rstd * w.z * (1.f + sc.z) + sh.z; h.w = v[i].w * rstd * w.w * (1.f + sc.w) + sh.w;
        uint2 pk; pk.x = (unsigned)f2bf(h.x) | ((unsigned)f2bf(h.y) << 16); pk.y = (unsigned)f2bf(h.z) | ((unsigned)f2bf(h.w) << 16);
        *(uint2*)(dst + c) = pk;
        if (WHICH == 1) *(float4*)(p.h2f + (size_t)row * 2048 + c) = h; }
}

__device__ __forceinline__ void ph3_scatter(const Params& p, int row) {
    const int tid = threadIdx.x;
    const float* Pr = p.P + (size_t)row * INCP;
    if (row < NP) {
        const int b = row / SEQ, t = row % SEQ;
        p.out[O_CKP + (size_t)row * 512 + tid] = Pr[C_KVC + tid];
        p.out[O_SKP + (size_t)row * 512 + tid] = Pr[C_KVS + tid];
        if (t >= SEQ - 512) p.out[O_WKP + ((size_t)b * 512 + (t - (SEQ - 512))) * 512 + tid] = Pr[C_KVW + tid];
        if (t >= SEQ - 3) for (int c = tid; c < 3072; c += NTHR) p.out[O_CVP + ((size_t)b * 3 + (t - (SEQ - 3))) * 3072 + c] = Pr[C_QKV + c];
    } else {
        const int b = row - NP;
        p.out[O_CKS + b * 512 + tid] = Pr[C_KVC + tid];
        p.out[O_SKS + b * 512 + tid] = Pr[C_KVS + tid];
        for (int j = 0; j < 512; ++j) p.out[O_WKS + ((size_t)b * 512 + j) * 512 + tid] = j < 511 ? p.state_win[((size_t)b * 512 + j + 1) * 512 + tid] : Pr[C_KVW + tid];
        for (int i = 0; i < 3; ++i) for (int c = tid; c < 3072; c += NTHR) p.out[O_CVS + ((size_t)b * 3 + i) * 3072 + c] = i < 2 ? p.state_conv[((size_t)b * 3 + i + 1) * 3072 + c] : Pr[C_QKV + c];
    }
}
__device__ __forceinline__ void ph3_compress(const Params& p, int u, float* smem) {
    float* in = smem;
    float* red = smem + 4 * 4096;
    float* hid = red + 4 * 4 * 128;
    const int tid = threadIdx.x;
    const bool smp = u >= 256; int v = smp ? u - 256 : u;
    const int s = v & 1, h = (v >> 1) & 1; v >>= 2;
    const int ng = smp ? 128 : 16, g = v % ng, b = v / ng;
    for (int i = tid; i < 4 * 4096; i += NTHR) { const int nn = i >> 12, l = (i >> 7) & 31, d = i & 127; const int tok = (g * 4 + nn) * 32 + l;
        float x;
        if (!smp) x = p.P[(size_t)(b * SEQ + tok) * INCP + C_KVC + s * 256 + h * 128 + d];
        else { const int page = p.page_table[b * NPAGES + (tok >> 7)]; x = p.cache_cmp[((size_t)page * 128 + (tok & 127)) * 512 + s * 256 + h * 128 + d]; }
        in[i] = x + p.cmp_pe[(s * 32 + l) * 128 + d]; }
    __syncthreads();
    const int e = tid & 127, ks = tid >> 7;
    float a0 = 0.f, a1 = 0.f, a2 = 0.f, a3 = 0.f;
    const float* w1 = p.cmp_w1 + ((size_t)s * 4096 + ks * 1024) * 128 + e;
    for (int k = 0; k < 1024; ++k) { const float w = w1[(size_t)k * 128]; const int kk = ks * 1024 + k;
        a0 += in[kk] * w; a1 += in[4096 + kk] * w; a2 += in[8192 + kk] * w; a3 += in[12288 + kk] * w; }
    red[(ks * 4 + 0) * 128 + e] = a0; red[(ks * 4 + 1) * 128 + e] = a1; red[(ks * 4 + 2) * 128 + e] = a2; red[(ks * 4 + 3) * 128 + e] = a3;
    __syncthreads();
    { const int nn = tid >> 7; const float sum = red[(0 * 4 + nn) * 128 + e] + red[(1 * 4 + nn) * 128 + e] + red[(2 * 4 + nn) * 128 + e] + red[(3 * 4 + nn) * 128 + e] + p.cmp_b1[s * 128 + e];
      hid[nn * 128 + e] = gelu_tanh(sum); }
    __syncthreads();
    { const int nn = tid >> 7, d = tid & 127; float acc = 0.f; const float* w2 = p.cmp_w2 + (size_t)s * 128 * 128 + d;
      for (int k = 0; k < 128; ++k) acc += hid[nn * 128 + k] * w2[k * 128];
      const int n = g * 4 + nn; float* dst = smp ? p.ckv_s : p.ckv_p; const int NC = smp ? 512 : 64;
      dst[((((size_t)b * NC + n) * 2 + s) * 2 + h) * 128 + d] = acc; }
    __syncthreads();
}
__device__ __forceinline__ void ph3_gdnprep(const Params& p, int row, float* smem) {
    float* cv = smem;
    const int tid = threadIdx.x;
    const float* Pr = p.P + (size_t)row * INCP;
    for (int c = tid; c < 3072; c += NTHR) {
        float acc = 0.f;
        if (row < NP) { const int t = row % SEQ;
#pragma unroll
            for (int i = 0; i < 4; ++i) { const int tt = t - 3 + i; if (tt >= 0) acc += p.P[(size_t)(row - 3 + i) * INCP + C_QKV + c] * p.conv_w[i * 3072 + c]; } }
        else { const int b = row - NP;
#pragma unroll
            for (int i = 0; i < 3; ++i) acc += p.state_conv[((size_t)b * 3 + i) * 3072 + c] * p.conv_w[i * 3072 + c];
            acc += Pr[C_QKV + c] * p.conv_w[3 * 3072 + c]; }
        cv[c] = silu_f(acc);
    }
    __syncthreads();
    const int wave = tid >> 6, lane = tid & 63;
    for (int hh = wave; hh < 16; hh += 8) {
        const float a = cv[hh * 128 + lane], b2 = cv[hh * 128 + 64 + lane];
        const float ss = wave_sum(a * a + b2 * b2);
        float r = rsqrtf(ss + 1e-6f); if (hh < 8) r *= 0.08838834764831845f;
        p.qkvn[(size_t)row * 3072 + hh * 128 + lane] = a * r; p.qkvn[(size_t)row * 3072 + hh * 128 + 64 + lane] = b2 * r;
    }
    for (int c = tid; c < 1024; c += NTHR) p.qkvn[(size_t)row * 3072 + 2048 + c] = cv[2048 + c];
    if (tid < 8) { p.gbeta[row * 8 + tid] = sigmoid_f(Pr[C_BL + tid]); p.gg[row * 8 + tid] = -__expf(p.a_log[tid]) * softplus_f(Pr[C_AL + tid] + p.dt_bias[tid]); }
    __syncthreads();
}

template <int BR, bool SMP>
__device__ __forceinline__ void nsa_key(const Params& p, int b, int tpos, int kvh, int j, const int* sel, int& pos, bool& valid, const float*& kp, const float*& vp) {
    if (BR == 0) {
        const int NC = SMP ? 512 : 64; pos = 32 * j + 31; valid = pos <= tpos;
        const float* base = (SMP ? p.ckv_s : p.ckv_p) + (((size_t)b * NC + j) * 4) * 128; kp = base + kvh * 128; vp = base + (2 + kvh) * 128;
    } else if (BR == 1) {
        const int blk = sel[j >> 6]; pos = blk * 64 + (j & 63); valid = pos <= tpos;
        const float* base;
        if (!SMP) base = p.P + (size_t)(b * SEQ + (valid ? pos : 0)) * INCP + C_KVS;
        else if (pos < PAST) base = p.cache_sel + ((size_t)p.page_table[b * NPAGES + (pos >> 7)] * 128 + (pos & 127)) * 512;
        else base = p.P + (size_t)(NP + b) * INCP + C_KVS;
        kp = base + kvh * 128; vp = base + 256 + kvh * 128;
    } else {
        const float* base;
        if (!SMP) { pos = tpos - 511 + j; valid = pos >= 0; base = p.P + (size_t)(b * SEQ + (valid ? pos : 0)) * INCP + C_KVW; }
        else { const int jj = j + 1; pos = PAST - 512 + jj; valid = true; base = jj < 512 ? p.state_win + ((size_t)b * 512 + jj) * 512 : p.P + (size_t)(NP + b) * INCP + C_KVW; }
        kp = base + kvh * 128; vp = base + 256 + kvh * 128;
    }
}
template <int BR, bool SMP>
__device__ __forceinline__ void nsa_branch(const Params& p, int b, int tpos, int kvh, int nkeys, const int* sel, const float* myq, float* mysc, float slope, int lane, float& r0, float& r1) {
    const float scale = 0.08838834764831845f;
    float mloc = -1e30f;
    for (int j0 = 0; j0 < nkeys; j0 += 64) {
        const int j = j0 + lane; float s = -1e30f;
        if (j < nkeys) {
            int pos; bool valid; const float *kp, *vp; nsa_key<BR, SMP>(p, b, tpos, kvh, j, sel, pos, valid, kp, vp);
            if (valid) { float dot = 0.f;
                for (int d = 0; d < 128; d += 4) { const float4 kv = *(const float4*)(kp + d); dot += myq[d] * kv.x + myq[d + 1] * kv.y + myq[d + 2] * kv.z + myq[d + 3] * kv.w; }
                s = dot * scale - slope * (float)(tpos - pos); }
            mysc[j] = s;
        }
        mloc = fmaxf(mloc, s);
    }
    const float m = wave_max(mloc);
    float lsum = 0.f;
    for (int j0 = 0; j0 < nkeys; j0 += 64) { const int j = j0 + lane; if (j < nkeys) { const float s = mysc[j]; const float e = s > -1e29f ? __expf(s - m) : 0.f; mysc[j] = e; lsum += e; } }
    const float l = wave_sum(lsum);
    const float linv = l > 0.f ? 1.f / l : 0.f;
    for (int j0 = 0; j0 < nkeys; j0 += 64) { const int j = j0 + lane; if (j < nkeys) mysc[j] *= linv; }
    float a0 = 0.f, a1 = 0.f;
    for (int j = 0; j < nkeys; ++j) {
        const float pj = mysc[j];
        if (pj != 0.f) { int pos; bool valid; const float *kp, *vp; nsa_key<BR, SMP>(p, b, tpos, kvh, j, sel, pos, valid, kp, vp);
            const float2 vv = *(const float2*)(vp + 2 * lane); a0 += pj * vv.x; a1 += pj * vv.y; }
    }
    r0 = a0; r1 = a1;
}
template <bool SMP>
__device__ __forceinline__ void ph4_nsa(const Params& p, int b, int t, float* smem) {
    float* q_s = smem;
    float* sc = smem + 1024;
    int* sel_s = (int*)(sc + 8 * 1024);
    const int tid = threadIdx.x, wave = tid >> 6, lane = tid & 63, hd = wave, kvh = wave >> 2;
    const int row = SMP ? NP + b : b * SEQ + t, tpos = SMP ? PAST : t;
    const float* Pr = p.P + (size_t)row * INCP;
    for (int i = tid; i < 1024; i += NTHR) q_s[i] = Pr[C_Q + i];
    __syncthreads();
    const float slope = exp2f(-(float)(hd + 1));
    float* mysc = sc + wave * 1024; const float* myq = q_s + hd * 128;
    const int NC = SMP ? 512 : 64;
    float c0, c1, s0, s1, w0, w1;
    nsa_branch<0, SMP>(p, b, tpos, kvh, NC, nullptr, myq, mysc, slope, lane, c0, c1);
    __syncthreads();
    const int cur = tpos >> 6, ncand = cur + 1, nsel = ncand < 16 ? ncand : 16;
    if ((wave & 3) == 0) {
        float val[5];
#pragma unroll
        for (int i = 0; i < 5; ++i) { const int blk = lane + 64 * i; float v = -INFINITY;
            if (blk < ncand) { const bool forced = blk == 0 || blk == cur || blk == cur - 1; float imp = 0.f;
                if (!forced) { for (int g = 0; g < 4; ++g) { const float* ps = sc + (kvh * 4 + g) * 1024; if (2 * blk < NC) imp += ps[2 * blk]; if (2 * blk + 1 < NC) imp += ps[2 * blk + 1]; } }
                v = forced ? 1e4f : imp; }
            val[i] = v; }
        for (int r = 0; r < nsel; ++r) {
            float bv = val[0]; int bi = lane;
#pragma unroll
            for (int i = 1; i < 5; ++i) if (val[i] > bv) { bv = val[i]; bi = lane + 64 * i; }
            for (int o = 32; o > 0; o >>= 1) { const float ov = __shfl_xor(bv, o); const int oi = __shfl_xor(bi, o); if (ov > bv || (ov == bv && oi < bi)) { bv = ov; bi = oi; } }
            if (lane == 0) sel_s[kvh * 16 + r] = bi;
#pragma unroll
            for (int i = 0; i < 5; ++i) if (lane + 64 * i == bi) val[i] = -INFINITY;
        }
    }
    __syncthreads();
    nsa_branch<1, SMP>(p, b, tpos, kvh, nsel * 64, sel_s + kvh * 16, myq, mysc, slope, lane, s0, s1);
    nsa_branch<2, SMP>(p, b, tpos, kvh, 512, nullptr, myq, mysc, slope, lane, w0, w1);
    const float g0 = sigmoid_f(Pr[C_GTS + hd * 3 + 0]), g1 = sigmoid_f(Pr[C_GTS + hd * 3 + 1]), g2 = sigmoid_f(Pr[C_GTS + hd * 3 + 2]);
    const float o0 = g0 * c0 + g1 * s0 + g2 * w0, o1 = g0 * c1 + g1 * s1 + g2 * w1;
    *(unsigned*)(p.amix + (size_t)row * 2048 + hd * 128 + 2 * lane) = (unsigned)f2bf(o0) | ((unsigned)f2bf(o1) << 16);
    __syncthreads();
}
__device__ __forceinline__ void ph4_gdn(const Params& p, int u, float* smem) {
    float* qs = smem;
    float* ks = qs + 16 * 128;
    float* vs = ks + 16 * 128;
    float* ab = vs + 16 * 128;
    float* red = ab + 32;
    float* red2 = red + 512;
    const int tid = threadIdx.x, dv = tid & 127, grp = tid >> 7;
    const bool smp = u >= 32; const int v = smp ? u - 32 : u, b = v >> 3, h = v & 7;
    const int T = smp ? 1 : SEQ, row0 = smp ? NP + b : b * SEQ;
    float S[32];
#pragma unroll
    for (int i = 0; i < 32; ++i) S[i] = smp ? p.state_gdn[(((size_t)b * 8 + h) * 128 + grp * 32 + i) * 128 + dv] : 0.f;
    for (int t0 = 0; t0 < T; t0 += 16) {
        const int nst = (T - t0) < 16 ? (T - t0) : 16;
        __syncthreads();
        for (int i = tid; i < nst * 128; i += NTHR) { const int st = i >> 7, d = i & 127; const float* r = p.qkvn + (size_t)(row0 + t0 + st) * 3072 + h * 128 + d;
            qs[i] = r[0]; ks[i] = r[1024]; vs[i] = r[2048]; }
        if (tid < nst) { ab[tid * 2] = __expf(p.gg[(row0 + t0 + tid) * 8 + h]); ab[tid * 2 + 1] = p.gbeta[(row0 + t0 + tid) * 8 + h]; }
        __syncthreads();
        for (int st = 0; st < nst; ++st) {
            const float a = ab[st * 2], be = ab[st * 2 + 1];
            const float* kk = ks + st * 128 + grp * 32; const float* qq = qs + st * 128 + grp * 32;
            float part = 0.f;
#pragma unroll
            for (int i = 0; i < 32; ++i) part += kk[i] * S[i];
            red[grp * 128 + dv] = part;
            __syncthreads();
            const float kS = red[dv] + red[128 + dv] + red[256 + dv] + red[384 + dv];
            const float vn = be * (vs[st * 128 + dv] - a * kS);
            float op = 0.f;
#pragma unroll
            for (int i = 0; i < 32; ++i) { S[i] = a * S[i] + kk[i] * vn; op += qq[i] * S[i]; }
            red2[grp * 128 + dv] = op;
            __syncthreads();
            if (grp == 0) p.ograw[(size_t)(row0 + t0 + st) * 1024 + h * 128 + dv] = red2[dv] + red2[128 + dv] + red2[256 + dv] + red2[384 + dv];
        }
    }
    float* So = p.out + (smp ? O_GS : O_GP) + (((size_t)b * 8 + h) * 128) * 128;
#pragma unroll
    for (int i = 0; i < 32; ++i) So[(size_t)(grp * 32 + i) * 128 + dv] = S[i];
    __syncthreads();
}

__device__ __forceinline__ void ph5_gdnout(const Params& p, int row) {
    const int wave = threadIdx.x >> 6, lane = threadIdx.x & 63, h = wave;
    const float* o = p.ograw + (size_t)row * 1024 + h * 128; const float* z = p.P + (size_t)row * INCP + C_Z + h * 128;
    const float a = o[2 * lane], b = o[2 * lane + 1];
    const float ss = wave_sum(a * a + b * b);
    const float r = rsqrtf(ss * (1.f / 128.f) + 1e-6f);
    const float y0 = a * r * p.gdn_norm[2 * lane] * silu_f(z[2 * lane]), y1 = b * r * p.gdn_norm[2 * lane + 1] * silu_f(z[2 * lane + 1]);
    *(unsigned*)(p.amix + (size_t)row * 2048 + 1024 + h * 128 + 2 * lane) = (unsigned)f2bf(y0) | ((unsigned)f2bf(y1) << 16);
}

__device__ __forceinline__ void ph9_peer(const Params& p, int row, float* smem) {
    float* qs = smem;
    float* hs = qs + 2048;
    float* ssc = hs + 2048;
    float* s_half = ssc + 2048;
    int* i_half = (int*)(s_half + 256);
    float* wgt = (float*)(i_half + 256);
    int* eid = (int*)(wgt + 128);
    float* red = (float*)(eid + 128);
    const int tid = threadIdx.x, wave = tid >> 6, lane = tid & 63;
    for (int i = tid; i < 2048; i += NTHR) { qs[i] = p.qp[(size_t)row * 2048 + i]; hs[i] = p.h2f[(size_t)row * 2048 + i]; }
    __syncthreads();
    for (int i = 0; i < 4; ++i) { const int idx = tid + NTHR * i, hp = idx >> 7, k = idx & 127, half = hp & 1;
        const float* kr = p.peer_keys + ((size_t)half * 128 + k) * 128; const float* qq = qs + (hp >> 1) * 256 + half * 128;
        float acc = 0.f; for (int d = 0; d < 128; d += 4) { const float4 kv = *(const float4*)(kr + d); acc += qq[d] * kv.x + qq[d + 1] * kv.y + qq[d + 2] * kv.z + qq[d + 3] * kv.w; }
        ssc[idx] = acc; }
    __syncthreads();
    for (int li = 0; li < 2; ++li) { const int hp = wave * 2 + li;
        float v0 = ssc[hp * 128 + lane], v1 = ssc[hp * 128 + 64 + lane];
        for (int r = 0; r < 16; ++r) {
            float bv = v0; int bi = lane; if (v1 > bv) { bv = v1; bi = lane + 64; }
            for (int o = 32; o > 0; o >>= 1) { const float ov = __shfl_xor(bv, o); const int oi = __shfl_xor(bi, o); if (ov > bv || (ov == bv && oi < bi)) { bv = ov; bi = oi; } }
            if (lane == 0) { s_half[hp * 16 + r] = bv; i_half[hp * 16 + r] = bi; }
            if (bi == lane) v0 = -INFINITY; if (bi == lane + 64) v1 = -INFINITY;
        } }
    __syncthreads();
    { const int h = wave; float cv[4];
#pragma unroll
      for (int c = 0; c < 4; ++c) { const int f = lane + 64 * c; cv[c] = s_half[(h * 2) * 16 + (f >> 4)] + s_half[(h * 2 + 1) * 16 + (f & 15)]; }
      float bs_mine = 0.f; int e_mine = 0;
      for (int r = 0; r < 16; ++r) {
          float bv = cv[0]; int bi = lane;
#pragma unroll
          for (int c = 1; c < 4; ++c) if (cv[c] > bv) { bv = cv[c]; bi = lane + 64 * c; }
          for (int o = 32; o > 0; o >>= 1) { const float ov = __shfl_xor(bv, o); const int oi = __shfl_xor(bi, o); if (ov > bv || (ov == bv && oi < bi)) { bv = ov; bi = oi; } }
          if (lane == r) { bs_mine = bv; e_mine = i_half[(h * 2) * 16 + (bi >> 4)] * 128 + i_half[(h * 2 + 1) * 16 + (bi & 15)]; }
#pragma unroll
          for (int c = 0; c < 4; ++c) if (lane + 64 * c == bi) cv[c] = -INFINITY;
      }
      float mx = lane < 16 ? bs_mine : -INFINITY; mx = wave_max(mx);
      const float ex = lane < 16 ? __expf(bs_mine - mx) : 0.f; const float den = wave_sum(ex);
      const float gate = ex / den;
      for (int r = 0; r < 16; ++r) { const int e = __shfl(e_mine, r); const float* ur = p.peer_u + (size_t)e * 2048;
          float acc = 0.f;
#pragma unroll
          for (int i = 0; i < 8; ++i) { const int c = i * 256 + lane * 4; const float4 uv = *(const float4*)(ur + c); acc += hs[c] * uv.x + hs[c + 1] * uv.y + hs[c + 2] * uv.z + hs[c + 3] * uv.w; }
          acc = wave_sum(acc);
          const float g = __shfl(gate, r);
          if (lane == 0) { wgt[h * 16 + r] = g * gelu_tanh(acc); eid[h * 16 + r] = e; } }
    }
    __syncthreads();
    float4 o = make_float4(0.f, 0.f, 0.f, 0.f);
    for (int j = 0; j < 128; ++j) { const float w = wgt[j]; const float4 vv = *(const float4*)(p.peer_v + (size_t)eid[j] * 2048 + tid * 4); o.x += w * vv.x; o.y += w * vv.y; o.z += w * vv.z; o.w += w * vv.w; }
    const int mrow = row < NP ? row / SEQ : 4 + (row - NP);
    const float4 g2 = *(const float4*)(p.mod + (size_t)mrow * 12288 + 10240 + tid * 4);
    const float4 xv = *(const float4*)(p.x1 + (size_t)row * 2048 + tid * 4);
    float4 x2; x2.x = xv.x + g2.x * o.x; x2.y = xv.y + g2.y * o.y; x2.z = xv.z + g2.z * o.z; x2.w = xv.w + g2.w * o.w;
    float ss = wave_sum(x2.x * x2.x + x2.y * x2.y + x2.z * x2.z + x2.w * x2.w);
    if (lane == 0) red[wave] = ss;
    __syncthreads();
    ss = red[0] + red[1] + red[2] + red[3] + red[4] + red[5] + red[6] + red[7];
    const float rstd = rsqrtf(ss * (1.f / 2048.f) + 1e-6f);
    const float4 fw = *(const float4*)(p.final_norm + tid * 4);
    float4 y; y.x = x2.x * rstd * fw.x; y.y = x2.y * rstd * fw.y; y.z = x2.z * rstd * fw.z; y.w = x2.w * rstd * fw.w;
    float* dst = row < NP ? p.out + O_YP + (size_t)row * 2048 : p.out + O_YS + (size_t)(row - NP) * 2048;
    *(float4*)(dst + tid * 4) = y;
    __syncthreads();
}

__global__ void __launch_bounds__(NTHR, 2) fwd(Params p) {
    extern __shared__ __attribute__((aligned(16))) unsigned char lds[];
    float* smem = (float*)lds;
    LAS unsigned* xbw = (LAS unsigned*)(lds + LDS_BYTES - 16);
    const int tid = threadIdx.x, G = gridDim.x, bx = blockIdx.x;
    if (tid < 4) xbw[tid] = 0u;
    __syncthreads();
    XcdBarrier bar; bar.bar = p.bar; bar.x = 0; bar.st = nullptr;
    const int lo = p.ph_lo, hi = p.ph_hi;
    if (hi - lo > 1) bar = xcd_barrier_post(p.bar, (volatile LAS unsigned*)xbw);
#define IN(k) (lo <= (k) && (k) < hi)
#define SEAM(k) do { if (IN(k) && IN((k) + 1)) xcd_barrier(bar); } while (0)

    if (IN(0)) {
        constexpr int NA = 96, NT_IN = 32 * (INCP / 64), NT_SQ = 32 * 32;
        for (int u = bx; u < NA + NT_IN + 2 * NT_SQ; u += G) {
            if (u < NA) ph0_adaln(p, u, smem);
            else if (u < NA + NT_IN) ph0_transpose(p.w_in, p.wt_in, INC, INCP / 64, u - NA, smem);
            else if (u < NA + NT_IN + NT_SQ) ph0_transpose(p.w_out, p.wt_out, 2048, 32, u - NA - NT_IN, smem);
            else ph0_transpose(p.peer_wq, p.wt_q, 2048, 32, u - NA - NT_IN - NT_SQ, smem);
        }
    }
    SEAM(0);
    if (IN(1)) { for (int u = bx; u < MPAD / 8; u += G) norm_row<0>(p, u * 8 + (tid >> 6)); }
    SEAM(1);
    if (IN(2)) {
        float* C = p.P;
        auto epi = [C](int r, int c, float v) { C[(size_t)r * INCP + c] = v; };
        for (int u = bx; u < (MPAD / 256) * (INCP / 256); u += G) { const int pn = u / (MPAD / 256), pm = u % (MPAD / 256); gemm_tile(p.h1, p.wt_in, 2048, pm * 256, pn * 256, (bf16_t*)lds, epi); }
    }
    SEAM(2);
    if (IN(3)) {
        constexpr int NCMP = 256 + 4096;
        for (int u = bx; u < NCMP + 2 * NTOK; u += G) {
            if (u < NCMP) ph3_compress(p, u, smem);
            else if (u < NCMP + NTOK) ph3_gdnprep(p, u - NCMP, smem);
            else ph3_scatter(p, u - NCMP - NTOK);
        }
    }
    SEAM(3);
    if (IN(4)) {
        for (int u = bx; u < 96 + NTOK; u += G) {
            if (u < 96) ph4_gdn(p, u, smem);
            else if (u < 96 + NP) { const int r = u - 96; ph4_nsa<false>(p, r / SEQ, r % SEQ, smem); }
            else ph4_nsa<true>(p, u - 96 - NP, 0, smem);
        }
    }
    SEAM(4);
    if (IN(5)) { for (int u = bx; u < NTOK; u += G) ph5_gdnout(p, u); }
    SEAM(5);
    if (IN(6)) {
        float* C = p.acc2;
        auto epi = [C](int r, int c, float v) { C[(size_t)r * 2048 + c] = v; };
        for (int u = bx; u < (MPAD / 256) * 8; u += G) { const int pn = u / (MPAD / 256), pm = u % (MPAD / 256); gemm_tile(p.amix, p.wt_out, 2048, pm * 256, pn * 256, (bf16_t*)lds, epi); }
    }
    SEAM(6);
    if (IN(7)) { for (int u = bx; u < MPAD / 8; u += G) norm_row<1>(p, u * 8 + (tid >> 6)); }
    SEAM(7);
    if (IN(8)) {
        float* C = p.qp;
        auto epi = [C](int r, int c, float v) { C[(size_t)r * 2048 + c] = v; };
        for (int u = bx; u < (MPAD / 256) * 8; u += G) { const int pn = u / (MPAD / 256), pm = u % (MPAD / 256); gemm_tile(p.h2, p.wt_q, 2048, pm * 256, pn * 256, (bf16_t*)lds, epi); }
    }
    SEAM(8);
    if (IN(9)) { for (int u = bx; u < NTOK; u += G) ph9_peer(p, u, smem); }
}

extern "C" void kernel_launch(void* const* d_in, const int* in_sizes, int n_in, void* d_out, int out_size, void* d_ws, size_t ws_size, hipStream_t stream) {
    static int grid = 0;
    if (grid == 0) {
        int dev = 0, cus = 0;
        if (hipGetDevice(&dev) != hipSuccess || hipDeviceGetAttribute(&cus, hipDeviceAttributeMultiprocessorCount, dev) != hipSuccess) { fprintf(stderr, "kernel_launch: device query failed\n"); grid = -1; return; }
        if (hipFuncSetAttribute((const void*)fwd, hipFuncAttributeMaxDynamicSharedMemorySize, LDS_BYTES) != hipSuccess) { fprintf(stderr, "kernel_launch: hipFuncSetAttribute failed\n"); grid = -1; return; }
        int per_cu = 0;
        if (hipOccupancyMaxActiveBlocksPerMultiprocessor(&per_cu, (const void*)fwd, NTHR, LDS_BYTES) != hipSuccess || per_cu < 1) fprintf(stderr, "kernel_launch: occupancy query says %d\n", per_cu);
        (void)hipGetLastError();
        grid = cus;
    }
    if (grid < 0) return;
    Params p{};
    p.x_prompt = (const float*)d_in[0]; p.x_sample = (const float*)d_in[1]; p.cache_cmp = (const float*)d_in[2]; p.cache_sel = (const float*)d_in[3];
    p.state_win = (const float*)d_in[4]; p.state_conv = (const float*)d_in[5]; p.state_gdn = (const float*)d_in[6]; p.page_table = (const int*)d_in[7];
    p.c_prompt = (const float*)d_in[8]; p.c_sample = (const float*)d_in[9]; p.w_ada = (const float*)d_in[10]; p.b_ada = (const float*)d_in[11];
    p.norm_mix = (const float*)d_in[12]; p.norm_ffn = (const float*)d_in[13]; p.w_in = (const float*)d_in[14]; p.cmp_pe = (const float*)d_in[15];
    p.cmp_w1 = (const float*)d_in[16]; p.cmp_b1 = (const float*)d_in[17]; p.cmp_w2 = (const float*)d_in[18]; p.conv_w = (const float*)d_in[19];
    p.a_log = (const float*)d_in[20]; p.dt_bias = (const float*)d_in[21]; p.gdn_norm = (const float*)d_in[22]; p.w_out = (const float*)d_in[23];
    p.peer_wq = (const float*)d_in[24]; p.peer_keys = (const float*)d_in[25]; p.peer_u = (const float*)d_in[26]; p.peer_v = (const float*)d_in[27];
    p.final_norm = (const float*)d_in[28];
    p.out = (float*)d_out;
    unsigned char* ws = (unsigned char*)d_ws; size_t off = 0;
    auto take = [&](size_t bytes) { unsigned char* r = ws + off; off += (bytes + 255) & ~(size_t)255; return r; };
    p.bar = (unsigned*)take(16384);
    p.mod = (float*)take((size_t)12 * 12288 * 4);
    p.h1 = (bf16_t*)take((size_t)MPAD * 2048 * 2);
    p.wt_in = (bf16_t*)take((size_t)INCP * 2048 * 2);
    p.wt_out = (bf16_t*)take((size_t)2048 * 2048 * 2);
    p.wt_q = (bf16_t*)take((size_t)2048 * 2048 * 2);
    p.P = (float*)take((size_t)MPAD * INCP * 4);
    p.ckv_p = (float*)take((size_t)4 * 64 * 4 * 128 * 4);
    p.ckv_s = (float*)take((size_t)8 * 512 * 4 * 128 * 4);
    p.qkvn = (float*)take((size_t)NTOK * 3072 * 4);
    p.gbeta = (float*)take((size_t)NTOK * 8 * 4);
    p.gg = (float*)take((size_t)NTOK * 8 * 4);
    p.ograw = (float*)take((size_t)NTOK * 1024 * 4);
    p.amix = (bf16_t*)take((size_t)MPAD * 2048 * 2);
    p.acc2 = (float*)take((size_t)MPAD * 2048 * 4);
    p.x1 = (float*)take((size_t)NTOK * 2048 * 4);
    p.h2f = (float*)take((size_t)NTOK * 2048 * 4);
    p.h2 = (bf16_t*)take((size_t)MPAD * 2048 * 2);
    p.qp = (float*)take((size_t)MPAD * 2048 * 4);
    if (off > ws_size) { fprintf(stderr, "kernel_launch: workspace too small (%zu > %zu)\n", off, ws_size); return; }
    (void)hipMemsetAsync(p.bar, 0, 16384, stream);
    if (N_LAUNCHES == 1) { p.ph_lo = 0; p.ph_hi = NPH; hipLaunchKernelGGL(fwd, dim3(grid), dim3(NTHR), LDS_BYTES, stream, p); }
    else for (int li = 0; li < NPH; ++li) { p.ph_lo = li; p.ph_hi = li + 1; hipLaunchKernelGGL(fwd, dim3(grid), dim3(NTHR), LDS_BYTES, stream, p); }
    const hipError_t le = hipPeekAtLastError();
    if (le != hipSuccess) fprintf(stderr, "kernel_launch: launch failed: %s\n", hipGetErrorName(le));
}
```

```cpp
#include <hip/hip_runtime.h>
#include <stdint.h>
#include <stdio.h>

#ifndef N_LAUNCHES
#define N_LAUNCHES 1
#endif

typedef unsigned short bf16_t;
typedef short bf16x8 __attribute__((ext_vector_type(8)));
typedef float f32x4 __attribute__((ext_vector_type(4)));
typedef float f32x16 __attribute__((ext_vector_type(16)));
typedef unsigned u32x4 __attribute__((ext_vector_type(4)));
typedef unsigned u32x2 __attribute__((ext_vector_type(2)));
typedef __bf16 bf2_t __attribute__((ext_vector_type(2)));
typedef float f32x2 __attribute__((ext_vector_type(2)));
typedef int i32x2 __attribute__((ext_vector_type(2)));
#define MFMA32(a, b, c) __builtin_amdgcn_mfma_f32_32x32x16_bf16((a), (b), (c), 0, 0, 0)
#define MFMA16(a, b, c) __builtin_amdgcn_mfma_f32_16x16x32_bf16((a), (b), (c), 0, 0, 0)

constexpr int DM = 2048, SEQ = 2048, NB = 4, NSB = 8;
constexpr int NP = NB * SEQ;
constexpr int NTOK = NP + NSB;
constexpr int MPAD = 8448;
constexpr int INC = 6696, INCP = 6912;
constexpr int C_Q = 0, C_KVC = 1024, C_KVS = 1536, C_KVW = 2048, C_GTS = 2560, C_QKV = 2584, C_Z = 5656, C_BL = 6680, C_AL = 6688;
constexpr int PAST = 16384, NPAGES = 128;
constexpr int NPH = 14;
constexpr int LDS_BYTES = 147456;
constexpr int NTHR = 512;

struct Params {
    const float *x_prompt, *x_sample, *cache_cmp, *cache_sel, *state_win, *state_conv, *state_gdn;
    const int* page_table;
    const float *c_prompt, *c_sample, *w_ada, *b_ada, *norm_mix, *norm_ffn, *w_in, *cmp_pe, *cmp_w1, *cmp_b1, *cmp_w2,
        *conv_w, *a_log, *dt_bias, *gdn_norm, *w_out, *peer_wq, *peer_keys, *peer_u, *peer_v, *final_norm;
    float* out;
    unsigned* bar;
    float* mod;
    bf16_t* h1;
    bf16_t* wt_in;
    bf16_t* wt_out;
    bf16_t* wt_q;
    float* P;
    float* ckv_p;
    float* ckv_s;
    float* qkvn;
    float* gbeta;
    float* gg;
    float* ograw;
    bf16_t* amix;
    float* acc2;
    float* x1;
    float* h2f;
    bf16_t* h2;
    float* qp;
    bf16_t* Qb;
    bf16_t* gN;
    bf16_t* gBT;
    bf16_t* gQp;
    bf16_t* gOpT;
    bf16_t* gST;
    float* ggl;
    unsigned char* u8;
    unsigned char* v8;
    float* us;
    float* vs;
    int* pk_eid;
    float* pk_gate;
    float* pd;
    unsigned char* h2q;
    float* wv;
    float* po;
    unsigned char* wq;
    float* wsc;
    bf16_t* kh;
    bf16_t* kl;
    bf16_t* w1t;
    bf16_t* w2t;
    bf16_t* KVb;
    int ph_lo, ph_hi;
};

constexpr size_t O_YP = 0, O_YS = O_YP + (size_t)NP * DM, O_CKP = O_YS + (size_t)NSB * DM, O_CKS = O_CKP + (size_t)NP * 512,
                 O_SKP = O_CKS + NSB * 512, O_SKS = O_SKP + (size_t)NP * 512, O_WKP = O_SKS + NSB * 512, O_WKS = O_WKP + (size_t)NB * 512 * 512,
                 O_CVP = O_WKS + (size_t)NSB * 512 * 512, O_CVS = O_CVP + NB * 3 * 3072, O_GP = O_CVS + NSB * 3 * 3072,
                 O_GS = O_GP + (size_t)NB * 8 * 128 * 128, O_END = O_GS + (size_t)NSB * 8 * 128 * 128;

__device__ __forceinline__ bf16_t f2bf(float f) { unsigned u = __float_as_uint(f); u += 0x7fffu + ((u >> 16) & 1u); return (bf16_t)(u >> 16); }
__device__ __forceinline__ unsigned pk2(float a, float b) { return (unsigned)f2bf(a) | ((unsigned)f2bf(b) << 16); }
__device__ __forceinline__ float wave_sum(float v) { for (int o = 32; o > 0; o >>= 1) v += __shfl_xor(v, o); return v; }
__device__ __forceinline__ float wave_sum_sw(float v) {
    v += __int_as_float(__builtin_amdgcn_ds_swizzle(__float_as_int(v), (1 << 10) | 0x1f));
    v += __int_as_float(__builtin_amdgcn_ds_swizzle(__float_as_int(v), (2 << 10) | 0x1f));
    v += __int_as_float(__builtin_amdgcn_ds_swizzle(__float_as_int(v), (4 << 10) | 0x1f));
    v += __int_as_float(__builtin_amdgcn_ds_swizzle(__float_as_int(v), (8 << 10) | 0x1f));
    v += __int_as_float(__builtin_amdgcn_ds_swizzle(__float_as_int(v), (16 << 10) | 0x1f));
    const auto rr = __builtin_amdgcn_permlane32_swap(__float_as_uint(v), __float_as_uint(v), false, false);
    return __uint_as_float(rr[0]) + __uint_as_float(rr[1]);
}
__device__ __forceinline__ float wave_max(float v) { for (int o = 32; o > 0; o >>= 1) v = fmaxf(v, __shfl_xor(v, o)); return v; }
__device__ __forceinline__ float silu_f(float x) { return x / (1.f + __expf(-x)); }
__device__ __forceinline__ float sigmoid_f(float x) { return 1.f / (1.f + __expf(-x)); }
__device__ __forceinline__ float gelu_tanh(float x) { return 0.5f * x * (1.f + tanhf(0.7978845608028654f * (x + 0.044715f * x * x * x))); }
__device__ __forceinline__ float softplus_f(float x) { return x > 20.f ? x : log1pf(__expf(x)); }

#define XB_TMO      128
#define XB_XCNT(j)  (256  + 64 * (j))
#define XB_XSUB(j)  (1280 + 64 * (j))
#define XB_XGEN(j)  (2304 + 64 * (j))
#define XB_TOP      3328
#define XB_TOPGEN   3392
#define XCD_BAR_WORDS 3456
#define XB_SPIN_CAP (1u << 18)
#define LAS __attribute__((address_space(3)))
__device__ __forceinline__ unsigned xb_ld(unsigned* p)              { return __hip_atomic_load(p, __ATOMIC_RELAXED, __HIP_MEMORY_SCOPE_AGENT); }
__device__ __forceinline__ unsigned xb_add(unsigned* p, unsigned v) { return __hip_atomic_fetch_add(p, v, __ATOMIC_RELAXED, __HIP_MEMORY_SCOPE_AGENT); }
__device__ __forceinline__ unsigned xb_xcc_id() { return (unsigned)__builtin_amdgcn_s_getreg((3 << 11) | 20) & 0xFu; }
#define XB_SPIN(cond, bar) do { unsigned _sp = 0; while (cond) { __builtin_amdgcn_s_sleep(1); \
    if ((++_sp & 255u) == 0u) { if (xb_ld(&(bar)[XB_TMO])) break; if (_sp > XB_SPIN_CAP) { atomicAdd(&(bar)[XB_TMO], 1u); break; } } } } while (0)
struct XcdBarrier { unsigned* bar; unsigned x; volatile LAS unsigned* st; };
__device__ __forceinline__ XcdBarrier xcd_barrier_post(unsigned* bar, volatile LAS unsigned* st) {
    XcdBarrier b; b.bar = bar; b.x = xb_xcc_id(); b.st = st;
    if (threadIdx.x == 0) (void)xb_add(&bar[XB_XCNT(b.x)], 1u);
    return b;
}
__device__ __forceinline__ void xcd_barrier_complete(unsigned* bar, unsigned x, unsigned& nloc, unsigned& nx) {
    const unsigned G = gridDim.x * gridDim.y * gridDim.z;
    unsigned sum, cnt, mine, sp = 0u;
    for (;;) {
        sum = 0u; cnt = 0u; mine = 0u;
#pragma unroll
        for (unsigned j = 0; j < 16; ++j) { const unsigned c = xb_ld(&bar[XB_XCNT(j)]); sum += c; cnt += (c > 0u) ? 1u : 0u; mine = (j == x) ? c : mine; }
        if (sum == G) break;
        __builtin_amdgcn_s_sleep(1);
        if ((++sp & 255u) == 0u) { if (xb_ld(&bar[XB_TMO])) break; if (sp > XB_SPIN_CAP) { atomicAdd(&bar[XB_TMO], 1u); break; } }
    }
    nloc = mine > 0u ? mine : 1u; nx = cnt > 0u ? cnt : 1u;
}
__device__ __forceinline__ void xcd_barrier(const XcdBarrier& b) {
    asm volatile("s_waitcnt vmcnt(0)" ::: "memory");
    __syncthreads();
    if (threadIdx.x == 0) {
        unsigned* bar = b.bar;
        __builtin_amdgcn_s_waitcnt(0);
        unsigned nloc = b.st[0], nx = b.st[1];
        if (nloc == 0u) { xcd_barrier_complete(bar, b.x, nloc, nx); b.st[0] = nloc; b.st[1] = nx; }
        const unsigned old = xb_add(&bar[XB_XSUB(b.x)], 1u);
        const unsigned gen = old / nloc;
        if (old + 1u == (gen + 1u) * nloc) {
            __builtin_amdgcn_fence(__ATOMIC_RELEASE, "agent");
            asm volatile("s_waitcnt vmcnt(0)" ::: "memory");
            const unsigned og = xb_add(&bar[XB_TOP], 1u);
            const unsigned tg = og / nx;
            if (og + 1u == (tg + 1u) * nx) xb_add(&bar[XB_TOPGEN], 1u);
            else XB_SPIN(xb_ld(&bar[XB_TOPGEN]) == tg, bar);
            __builtin_amdgcn_fence(__ATOMIC_ACQUIRE, "agent");
            xb_add(&bar[XB_XGEN(b.x)], 1u);
            asm volatile("s_waitcnt vmcnt(0)" ::: "memory");
        } else {
            XB_SPIN(xb_ld(&bar[XB_XGEN(b.x)]) == gen, bar);
            __builtin_amdgcn_fence(__ATOMIC_ACQUIRE, "agent");
            asm volatile("s_waitcnt vmcnt(0)" ::: "memory");
        }
    }
    __syncthreads();
}

constexpr int BM = 256, BK = 64, HALF = 128, HT = HALF * BK;
__device__ __forceinline__ int lds_byte(int r, int c) { int st = (r >> 4) * 2 + (c >> 5), rr = r & 15, cc = c & 31, ob = rr * 64 + cc * 2; return st * 1024 + (ob ^ (((ob >> 9) & 1) << 5)); }
__device__ __forceinline__ void stage_rc(int b, int& R, int& C) { int st = b / 1024, sb = b % 1024, swz = sb ^ (((sb >> 9) & 1) << 5); R = (st >> 1) * 16 + swz / 64; C = (st & 1) * 32 + (swz % 64) / 2; }

template <class Epi>
__device__ __forceinline__ void gemm_tile(const bf16_t* __restrict__ A, const bf16_t* __restrict__ Bt, const int K, const int brow, const int bcol, bf16_t* shm, const Epi& epi) {
#define SA(b, h) (shm + ((b) * 2 + (h)) * HT)
#define SB(b, h) (shm + (4 + (b) * 2 + (h)) * HT)
#define STAGE_X(T, Pp, BASE, br, kt) do { long _g = (long)(br) * K + (long)(kt) * BK; \
    for (int _i = 0; _i < 2; ++_i) { int _b = (T) * 16 + _i * 8192; int _r, _c; stage_rc(_b, _r, _c); \
      __builtin_amdgcn_global_load_lds((const unsigned*)(BASE + _g + (long)_r * K + _c), (LAS unsigned*)((LAS char*)(Pp) + _b), 16, 0, 0); } } while (0)
#define STAGE(Pp, BASE, br, kt) STAGE_X(tx, Pp, BASE, br, kt)
#define LDA(dst, b, h) for (int m = 0; m < 4; ++m) for (int k = 0; k < 2; ++k) \
    dst[m][k] = *reinterpret_cast<const bf16x8*>((char*)SA(b, h) + lds_byte(wr * 64 + m * 16 + fr, k * 32 + fq * 8))
#define LDB(dst, b, h) for (int n = 0; n < 2; ++n) for (int k = 0; k < 2; ++k) \
    dst[n][k] = *reinterpret_cast<const bf16x8*>((char*)SB(b, h) + lds_byte(wc * 32 + n * 16 + fr, k * 32 + fq * 8))
#define MMA(ai, bj, At, Bt_) do { __builtin_amdgcn_s_setprio(1); \
    for (int m = 0; m < 4; ++m) for (int n = 0; n < 2; ++n) for (int k = 0; k < 2; ++k) \
      acc[ai][bj][m][n] = __builtin_amdgcn_mfma_f32_16x16x32_bf16(At[m][k], Bt_[n][k], acc[ai][bj][m][n], 0, 0, 0); \
    __builtin_amdgcn_s_setprio(0); } while (0)
#define WAIT_V(n) asm volatile("s_waitcnt vmcnt(" #n ")" ::: "memory")
#define WAIT_L(n) asm volatile("s_waitcnt lgkmcnt(" #n ")" ::: "memory")
#define BAR __builtin_amdgcn_s_barrier()
#define SCHED __builtin_amdgcn_sched_barrier(0)
    int tx = threadIdx.x; asm volatile("" : "+v"(tx));
    int wid = tx >> 6, lane = tx & 63, wr = wid >> 2, wc = wid & 3, fr = lane & 15, fq = lane >> 4;
    f32x4 acc[2][2][4][2] = {};
    bf16x8 At[4][2], B0[2][2], B1[2][2];
    const int nt = K / BK;
    STAGE(SB(0, 0), Bt, bcol, 0); STAGE(SA(0, 0), A, brow, 0);
    STAGE(SB(0, 1), Bt, bcol + HALF, 0); STAGE(SA(0, 1), A, brow + HALF, 0);
    if (wr == 1) BAR;
    WAIT_V(4); BAR;
    STAGE(SB(1, 0), Bt, bcol, 1); STAGE(SA(1, 0), A, brow, 1); STAGE(SB(1, 1), Bt, bcol + HALF, 1);
    WAIT_V(6); BAR;
    for (int t = 0; t < nt - 2; t += 2) {
        LDB(B0, 0, 0); SCHED; LDA(At, 0, 0); STAGE(SA(1, 1), A, brow + HALF, t + 1);
        WAIT_L(8); BAR; WAIT_L(0); MMA(0, 0, At, B0); BAR; SCHED;
        LDB(B1, 0, 1); STAGE(SB(0, 0), Bt, bcol, t + 2);
        BAR; WAIT_L(0); MMA(0, 1, At, B1); BAR;
        LDA(At, 0, 1); STAGE(SA(0, 0), A, brow, t + 2);
        BAR; WAIT_L(0); MMA(1, 0, At, B0); BAR; SCHED;
        STAGE(SB(0, 1), Bt, bcol + HALF, t + 2);
        WAIT_V(6); BAR; MMA(1, 1, At, B1); BAR;
        LDB(B0, 1, 0); SCHED; LDA(At, 1, 0); STAGE(SA(0, 1), A, brow + HALF, t + 2);
        WAIT_L(8); BAR; WAIT_L(0); MMA(0, 0, At, B0); BAR; SCHED;
        LDB(B1, 1, 1); STAGE(SB(1, 0), Bt, bcol, t + 3);
        BAR; WAIT_L(0); MMA(0, 1, At, B1); BAR;
        LDA(At, 1, 1); STAGE(SA(1, 0), A, brow, t + 3);
        BAR; WAIT_L(0); MMA(1, 0, At, B0); BAR; SCHED;
        STAGE(SB(1, 1), Bt, bcol + HALF, t + 3);
        WAIT_V(6); BAR; MMA(1, 1, At, B1); BAR;
    }
    int tz = threadIdx.x; asm volatile("" : "+v"(tz)); wid = tz >> 6; lane = tz & 63; wr = wid >> 2; wc = wid & 3; fr = lane & 15; fq = lane >> 4;
    { LDB(B0, 0, 0); WAIT_V(0); LDA(At, 0, 0); STAGE_X(tz, SA(1, 1), A, brow + HALF, nt - 1);
      BAR; WAIT_L(0); MMA(0, 0, At, B0); BAR;
      LDB(B1, 0, 1); BAR; WAIT_L(0); MMA(0, 1, At, B1); BAR;
      LDA(At, 0, 1); WAIT_V(4); BAR; WAIT_L(0); MMA(1, 0, At, B0); MMA(1, 1, At, B1); BAR; }
    { LDB(B0, 1, 0); LDA(At, 1, 0); WAIT_V(2); BAR; WAIT_L(0); MMA(0, 0, At, B0); BAR;
      LDB(B1, 1, 1); WAIT_V(0); BAR; WAIT_L(0); MMA(0, 1, At, B1); BAR;
      LDA(At, 1, 1); BAR; WAIT_L(0); MMA(1, 0, At, B0); MMA(1, 1, At, B1); BAR; }
    if (wr == 0) BAR;
#pragma unroll
    for (int ai = 0; ai < 2; ++ai)
#pragma unroll
        for (int bj = 0; bj < 2; ++bj)
#pragma unroll
            for (int m = 0; m < 4; ++m)
#pragma unroll
                for (int n = 0; n < 2; ++n)
#pragma unroll
                    for (int j = 0; j < 4; ++j) epi(brow + ai * HALF + wr * 64 + m * 16 + fq * 4 + j, bcol + bj * HALF + wc * 32 + n * 16 + fr, acc[ai][bj][m][n][j]);
    __syncthreads();
#undef SA
#undef SB
}


template <int NCB, class Epi>
__device__ __forceinline__ void gemm_rows8(const bf16_t* __restrict__ A, const bf16_t* __restrict__ Bt, int cu, unsigned char* lds, const Epi& epi) {
    int tid = threadIdx.x; asm volatile("" : "+v"(tid));
    const int wave = tid >> 6, lane = tid & 63, r16 = lane & 15, quad = lane >> 4, k0 = wave * 256;
    constexpr int NC = 16 * NCB;
    f32x4 acc[NCB];
#pragma unroll
    for (int cb = 0; cb < NCB; ++cb) acc[cb] = (f32x4){0.f, 0.f, 0.f, 0.f};
#pragma unroll
    for (int ks = 0; ks < 8; ++ks) {
        bf16x8 a = (bf16x8){0, 0, 0, 0, 0, 0, 0, 0};
        if (r16 < 8) a = *(const bf16x8*)(A + (size_t)r16 * 2048 + k0 + 32 * ks + 8 * quad);
#pragma unroll
        for (int cb = 0; cb < NCB; ++cb) { const bf16x8 b = *(const bf16x8*)(Bt + (size_t)(cu * NC + 16 * cb + r16) * 2048 + k0 + 32 * ks + 8 * quad); acc[cb] = MFMA16(a, b, acc[cb]); }
    }
    float* red = (float*)lds;
    if (quad < 2) {
#pragma unroll
        for (int cb = 0; cb < NCB; ++cb)
#pragma unroll
            for (int rg = 0; rg < 4; ++rg) red[(wave * 8 + 4 * quad + rg) * NC + 16 * cb + r16] = acc[cb][rg]; }
    __syncthreads();
    if (tid < 8 * NC) { const int row = tid / NC, col = tid % NC; float v = 0.f;
#pragma unroll
      for (int w = 0; w < 8; ++w) v += red[(w * 8 + row) * NC + col];
      epi(NP + row, cu * NC + col, v); }
    __syncthreads();
}
__device__ __forceinline__ void ph0_adaln(const Params& p, int u, float* smem) {
    float* sc = smem;
    float* red = smem + 12 * 2048;
    const int tid = threadIdx.x;
    for (int i = tid; i < 12 * 2048; i += NTHR) { const int r = i >> 11, k = i & 2047; const float c = r < 4 ? p.c_prompt[r * 2048 + k] : p.c_sample[(r - 4) * 2048 + k]; sc[i] = silu_f(c); }
    __syncthreads();
    const int col = u * 64 + (tid & 63), ks = tid >> 6;
    float a[12];
#pragma unroll
    for (int r = 0; r < 12; ++r) a[r] = 0.f;
    const float* w = p.w_ada + (size_t)(ks * 256) * 12288 + col;
#pragma unroll 1
    for (int k0 = 0; k0 < 256; k0 += 16) {
        float wv[16];
#pragma unroll
        for (int kk = 0; kk < 16; ++kk) wv[kk] = w[(size_t)(k0 + kk) * 12288];
#pragma unroll
        for (int kk = 0; kk < 16; ++kk)
#pragma unroll
            for (int r = 0; r < 12; ++r) a[r] += sc[r * 2048 + ks * 256 + k0 + kk] * wv[kk];
    }
#pragma unroll
    for (int r = 0; r < 12; ++r) red[(ks * 12 + r) * 64 + (tid & 63)] = a[r];
    __syncthreads();
    for (int i = tid; i < 12 * 64; i += NTHR) { const int r = i >> 6, c = i & 63; const int cc = u * 64 + c; float s = p.b_ada[cc];
#pragma unroll
        for (int k8 = 0; k8 < 8; ++k8) s += red[(k8 * 12 + r) * 64 + c];
        p.mod[r * 12288 + cc] = s; }
    __syncthreads();
}
__device__ __forceinline__ void ph0_transpose(const float* __restrict__ W, bf16_t* __restrict__ Wt, int Nreal, int ntn, int u, float* smem, int Kdim = 2048) {
    const int tk = u / ntn, tn = u % ntn, k0 = tk * 64, n0 = tn * 64, tid = threadIdx.x;
    for (int i = 0; i < 8; ++i) { const int idx = tid + NTHR * i, kk = idx >> 6, nn = idx & 63; smem[kk * 65 + nn] = (n0 + nn < Nreal) ? W[(size_t)(k0 + kk) * Nreal + n0 + nn] : 0.f; }
    __syncthreads();
    for (int i = 0; i < 8; ++i) { const int idx = tid + NTHR * i, nn = idx >> 6, kk = idx & 63; Wt[(size_t)(n0 + nn) * Kdim + k0 + kk] = f2bf(smem[kk * 65 + nn]); }
    __syncthreads();
}


__device__ __forceinline__ void ph0_cvt(const float* __restrict__ s, bf16_t* __restrict__ d, size_t u) {
    const size_t i = u * 4096 + (size_t)threadIdx.x * 8;
    const float4 a = *(const float4*)(s + i), b = *(const float4*)(s + i + 4);
    *(uint4*)(d + i) = make_uint4((unsigned)f2bf(a.x) | ((unsigned)f2bf(a.y) << 16), (unsigned)f2bf(a.z) | ((unsigned)f2bf(a.w) << 16), (unsigned)f2bf(b.x) | ((unsigned)f2bf(b.y) << 16), (unsigned)f2bf(b.z) | ((unsigned)f2bf(b.w) << 16));
}

__device__ __forceinline__ void ph0_fp8(const float* __restrict__ src, unsigned char* __restrict__ dst, float* __restrict__ scl, int u) {
    const int wave = threadIdx.x >> 6, lane = threadIdx.x & 63, r = u * 8 + wave;
    const float* s = src + (size_t)r * 2048 + lane * 16;
    float4 v[8]; float am = 0.f;
#pragma unroll
    for (int c = 0; c < 2; ++c)
#pragma unroll
        for (int k = 0; k < 4; ++k) { v[c * 4 + k] = *(const float4*)(s + c * 1024 + k * 4); const float4 t = v[c * 4 + k];
            am = fmaxf(am, fmaxf(fmaxf(fabsf(t.x), fabsf(t.y)), fmaxf(fabsf(t.z), fabsf(t.w)))); }
    am = wave_max(am);
    const float sc = fmaxf(am, 1e-30f) * (1.f / 440.f), inv = 1.f / sc;
#pragma unroll
    for (int c = 0; c < 2; ++c) { u32x4 w;
#pragma unroll
        for (int k = 0; k < 4; ++k) { const float4 t = v[c * 4 + k]; int pk = 0; pk = __builtin_amdgcn_cvt_pk_fp8_f32(t.x * inv, t.y * inv, pk, false); pk = __builtin_amdgcn_cvt_pk_fp8_f32(t.z * inv, t.w * inv, pk, true); w[k] = (unsigned)pk; }
        *(u32x4*)(dst + (size_t)(c * 8 + (lane >> 3)) * (16384 * 128) + (size_t)r * 128 + (lane & 7) * 16) = w; }
    if (lane == 0) scl[r] = sc;
}
__device__ __forceinline__ void ph0_keys(const Params& p, int u) {
    for (int k = 0; k < 8; ++k) { const int i = u * 4096 + threadIdx.x * 8 + k; const float x = p.peer_keys[i]; const bf16_t h = f2bf(x); p.kh[i] = h; p.kl[i] = f2bf(x - __uint_as_float((unsigned)h << 16)); }
}
template <int WHICH>
__device__ __forceinline__ void norm_row(const Params& p, int row) {
    const int lane = threadIdx.x & 63;
    bf16_t* dst = (WHICH == 0 ? p.h1 : p.h2) + (size_t)row * 2048;
    if (row >= NTOK) { for (int i = 0; i < 8; ++i) { const int c = i * 256 + lane * 4; *(uint2*)(dst + c) = make_uint2(0u, 0u); } return; }
    const int mrow = row < NP ? row / SEQ : 4 + (row - NP);
    const float* xr = row < NP ? p.x_prompt + (size_t)row * 2048 : p.x_sample + (size_t)(row - NP) * 2048;
    const float* mod = p.mod + (size_t)mrow * 12288;
    const float* nw = WHICH == 0 ? p.norm_mix : p.norm_ffn;
    float4 v[8]; float ss = 0.f;
#pragma unroll
    for (int i = 0; i < 8; ++i) { const int c = i * 256 + lane * 4; v[i] = *(const float4*)(xr + c);
        if (WHICH == 1) { const float4 a = *(const float4*)(p.acc2 + (size_t)row * 2048 + c); const float4 g = *(const float4*)(mod + 4096 + c);
            v[i].x += g.x * a.x; v[i].y += g.y * a.y; v[i].z += g.z * a.z; v[i].w += g.w * a.w; *(float4*)(p.x1 + (size_t)row * 2048 + c) = v[i]; }
        ss += v[i].x * v[i].x + v[i].y * v[i].y + v[i].z * v[i].z + v[i].w * v[i].w; }
    ss = wave_sum(ss);
    const float rstd = rsqrtf(ss * (1.f / 2048.f) + 1e-6f);
    const int osh = WHICH == 0 ? 0 : 6144, osc = WHICH == 0 ? 2048 : 8192;
#pragma unroll
    for (int i = 0; i < 8; ++i) { const int c = i * 256 + lane * 4;
        const float4 w = *(const float4*)(nw + c), sc = *(const float4*)(mod + osc + c), sh = *(const float4*)(mod + osh + c);
        float4 h; h.x = v[i].x * rstd * w.x * (1.f + sc.x) + sh.x; h.y = v[i].y * rstd * w.y * (1.f + sc.y) + sh.y; h.z = v[i].z * rstd * w.z * (1.f + sc.z) + sh.z; h.w = v[i].w * rstd * w.w * (1.f + sc.w) + sh.w;
        uint2 pk; pk.x = (unsigned)f2bf(h.x) | ((unsigned)f2bf(h.y) << 16); pk.y = (unsigned)f2bf(h.z) | ((unsigned)f2bf(h.w) << 16);
        *(uint2*)(dst + c) = pk;
        if (WHICH == 1) {
            int q8 = 0; q8 = __builtin_amdgcn_cvt_pk_fp8_f32(h.x, h.y, q8, false); q8 = __builtin_amdgcn_cvt_pk_fp8_f32(h.z, h.w, q8, true); *(int*)(p.h2q + (size_t)row * 2048 + c) = q8; } }
}

__device__ __forceinline__ void ph3_scatter(const Params& p, int u) {
    const int tid = threadIdx.x;
    if (u >= NSB) { const int b = (u - NSB) / 3, i = (u - NSB) % 3; const float* Pr = p.P + (size_t)(b * SEQ + SEQ - 3 + i) * INCP;
        for (int c = tid; c < 3072; c += NTHR) p.out[O_CVP + ((size_t)b * 3 + i) * 3072 + c] = Pr[C_QKV + c];
        return; }
    const int b = u, row = NP + b;
    const float* Pr = p.P + (size_t)row * INCP;
    { const int c = tid * 2; *(unsigned*)(p.Qb + (size_t)row * 1024 + c) = (unsigned)f2bf(Pr[C_Q + c]) | ((unsigned)f2bf(Pr[C_Q + c + 1]) << 16);
      *(unsigned*)(p.KVb + (size_t)row * 1024 + c) = (unsigned)f2bf(Pr[C_KVS + c]) | ((unsigned)f2bf(Pr[C_KVS + c + 1]) << 16); }
    p.out[O_CKS + b * 512 + tid] = Pr[C_KVC + tid];
    p.out[O_SKS + b * 512 + tid] = Pr[C_KVS + tid];
    p.out[O_WKS + ((size_t)b * 512 + 511) * 512 + tid] = Pr[C_KVW + tid];
    for (int i = 0; i < 3; ++i) for (int c = tid; c < 3072; c += NTHR) p.out[O_CVS + ((size_t)b * 3 + i) * 3072 + c] = i < 2 ? p.state_conv[((size_t)b * 3 + i + 1) * 3072 + c] : Pr[C_QKV + c];
}
constexpr int CP_A = 0, CP_B = 34816, CP_H = 69632;
template <bool SMP>
__device__ __forceinline__ void cmp_tile(const Params& p, int tile, int s, unsigned char* lds) {
    int tid = threadIdx.x; asm volatile("" : "+v"(tid));
    const int wave = tid >> 6, lane = tid & 63, r16 = lane & 15, quad = lane >> 4, wr = wave >> 1, wc = wave & 1;
    const int NC = SMP ? 512 : 64, STR = 512;
    const float* abase[8];
#pragma unroll
    for (int i = 0; i < 8; ++i) { const int id = tid + 512 * i, R = tile * 128 + (id >> 5), part = id & 31;
        const int h = R & 1, n = (R >> 1) & (NC - 1), b = R / (2 * NC);
        if (SMP) abase[i] = p.cache_cmp + ((size_t)p.page_table[b * NPAGES + (n >> 2)] * 128 + (n & 3) * 32) * 512 + s * 256 + h * 128 + part * 4;
        else abase[i] = p.out + O_CKP + (size_t)(b * SEQ + n * 32) * 512 + s * 256 + h * 128 + part * 4; }
    const float* pe = p.cmp_pe + (size_t)s * 4096 + ((tid & 31) * 4);
    const bf16_t* bsrc[4];
#pragma unroll
    for (int i = 0; i < 4; ++i) { const int id = tid + 512 * i; bsrc[i] = p.w1t + ((size_t)s * 128 + (id >> 4)) * 4096 + (id & 15) * 8; }
    float4 av[8]; u32x4 bv[4];
#pragma unroll
    for (int i = 0; i < 8; ++i) av[i] = *(const float4*)(abase[i]);
#pragma unroll
    for (int i = 0; i < 4; ++i) bv[i] = *(const u32x4*)(bsrc[i]);
    f32x4 acc[2][4];
#pragma unroll
    for (int a = 0; a < 2; ++a) for (int c = 0; c < 4; ++c) acc[a][c] = (f32x4){0.f, 0.f, 0.f, 0.f};
    unsigned char* Ab = lds + CP_A; unsigned char* Bb = lds + CP_B;
#pragma unroll 1
    for (int l = 0; l < 32; ++l) {
        { const float4 pv = *(const float4*)(pe + l * 128);
#pragma unroll
          for (int i = 0; i < 8; ++i) { const int id = tid + 512 * i; uint2 w; w.x = pk2(av[i].x + pv.x, av[i].y + pv.y); w.y = pk2(av[i].z + pv.z, av[i].w + pv.w);
              *(uint2*)(Ab + (id >> 5) * 272 + (id & 31) * 8) = w; } }
#pragma unroll
        for (int i = 0; i < 4; ++i) { const int id = tid + 512 * i; *(u32x4*)(Bb + (id >> 4) * 272 + (id & 15) * 16) = bv[i]; }
        __syncthreads();
        if (l + 1 < 32) {
#pragma unroll
            for (int i = 0; i < 8; ++i) av[i] = *(const float4*)(abase[i] + (size_t)(l + 1) * STR);
#pragma unroll
            for (int i = 0; i < 4; ++i) bv[i] = *(const u32x4*)(bsrc[i] + (l + 1) * 128); }
#pragma unroll
        for (int ks = 0; ks < 4; ++ks) { bf16x8 a[2], b[4];
#pragma unroll
            for (int rb = 0; rb < 2; ++rb) a[rb] = *(const bf16x8*)(Ab + (32 * wr + 16 * rb + r16) * 272 + (32 * ks + 8 * quad) * 2);
#pragma unroll
            for (int cb = 0; cb < 4; ++cb) b[cb] = *(const bf16x8*)(Bb + (64 * wc + 16 * cb + r16) * 272 + (32 * ks + 8 * quad) * 2);
#pragma unroll
            for (int rb = 0; rb < 2; ++rb)
#pragma unroll
                for (int cb = 0; cb < 4; ++cb) acc[rb][cb] = MFMA16(a[rb], b[cb], acc[rb][cb]); }
        __syncthreads();
    }
    unsigned char* H = lds + CP_H;
#pragma unroll
    for (int rb = 0; rb < 2; ++rb)
#pragma unroll
        for (int cb = 0; cb < 4; ++cb) { const int e = 64 * wc + 16 * cb + r16; const float b1 = p.cmp_b1[s * 128 + e];
#pragma unroll
            for (int rg = 0; rg < 4; ++rg) *(bf16_t*)(H + (32 * wr + 16 * rb + 4 * quad + rg) * 272 + e * 2) = f2bf(gelu_tanh(acc[rb][cb][rg] + b1)); }
    __syncthreads();
    float* dst = SMP ? p.ckv_s : p.ckv_p;
#pragma unroll
    for (int rb = 0; rb < 2; ++rb)
#pragma unroll
        for (int cb = 0; cb < 4; ++cb) { f32x4 o = (f32x4){0.f, 0.f, 0.f, 0.f}; const int d = 64 * wc + 16 * cb + r16;
#pragma unroll
            for (int ks = 0; ks < 4; ++ks) { const bf16x8 a = *(const bf16x8*)(H + (32 * wr + 16 * rb + r16) * 272 + (32 * ks + 8 * quad) * 2);
                const bf16x8 b = *(const bf16x8*)(p.w2t + ((size_t)s * 128 + d) * 128 + 32 * ks + 8 * quad); o = MFMA16(a, b, o); }
#pragma unroll
            for (int rg = 0; rg < 4; ++rg) { const int R = tile * 128 + 32 * wr + 16 * rb + 4 * quad + rg; const int h = R & 1, n = (R >> 1) & (NC - 1), b = R / (2 * NC);
                dst[((((size_t)b * NC + n) * 2 + s) * 2 + h) * 128 + d] = o[rg]; } }
    __syncthreads();
}
__device__ __forceinline__ void ph3_gdnprep(const Params& p, int row, float* smem) {
    float* cv = smem;
    const int tid = threadIdx.x;
    const float* Pr = p.P + (size_t)row * INCP;
    for (int c = tid; c < 3072; c += NTHR) {
        float acc = 0.f;
        if (row < NP) { const int t = row % SEQ;
#pragma unroll
            for (int i = 0; i < 4; ++i) { const int tt = t - 3 + i; if (tt >= 0) acc += p.P[(size_t)(row - 3 + i) * INCP + C_QKV + c] * p.conv_w[i * 3072 + c]; } }
        else { const int b = row - NP;
#pragma unroll
            for (int i = 0; i < 3; ++i) acc += p.state_conv[((size_t)b * 3 + i) * 3072 + c] * p.conv_w[i * 3072 + c];
            acc += Pr[C_QKV + c] * p.conv_w[3 * 3072 + c]; }
        cv[c] = silu_f(acc);
    }
    __syncthreads();
    const int wave = tid >> 6, lane = tid & 63;
    for (int hh = wave; hh < 16; hh += 8) {
        const float a = cv[hh * 128 + lane], b2 = cv[hh * 128 + 64 + lane];
        const float ss = wave_sum(a * a + b2 * b2);
        float r = rsqrtf(ss + 1e-6f); if (hh < 8) r *= 0.08838834764831845f;
        p.qkvn[(size_t)row * 3072 + hh * 128 + lane] = a * r; p.qkvn[(size_t)row * 3072 + hh * 128 + 64 + lane] = b2 * r;
    }
    for (int c = tid; c < 1024; c += NTHR) p.qkvn[(size_t)row * 3072 + 2048 + c] = cv[2048 + c];
    if (tid < 8) { p.gbeta[row * 8 + tid] = sigmoid_f(Pr[C_BL + tid]); p.gg[row * 8 + tid] = -__expf(p.a_log[tid]) * softplus_f(Pr[C_AL + tid] + p.dt_bias[tid]); }
    __syncthreads();
}

template <int BR, bool SMP>
__device__ __forceinline__ void nsa_key(const Params& p, int b, int tpos, int kvh, int j, const int* sel, int& pos, bool& valid, const float*& kp, const float*& vp) {
    if (BR == 0) {
        const int NC = SMP ? 512 : 64; pos = 32 * j + 31; valid = pos <= tpos;
        const float* base = (SMP ? p.ckv_s : p.ckv_p) + (((size_t)b * NC + j) * 4) * 128; kp = base + kvh * 128; vp = base + (2 + kvh) * 128;
    } else if (BR == 1) {
        const int blk = sel[j >> 6]; pos = blk * 64 + (j & 63); valid = pos <= tpos;
        const float* base;
        if (!SMP) base = p.P + (size_t)(b * SEQ + (valid ? pos : 0)) * INCP + C_KVS;
        else if (pos < PAST) base = p.cache_sel + ((size_t)p.page_table[b * NPAGES + (pos >> 7)] * 128 + (pos & 127)) * 512;
        else base = p.P + (size_t)(NP + b) * INCP + C_KVS;
        kp = base + kvh * 128; vp = base + 256 + kvh * 128;
    } else {
        const float* base;
        if (!SMP) { pos = tpos - 511 + j; valid = pos >= 0; base = p.P + (size_t)(b * SEQ + (valid ? pos : 0)) * INCP + C_KVW; }
        else { const int jj = j + 1; pos = PAST - 512 + jj; valid = true; base = jj < 512 ? p.state_win + ((size_t)b * 512 + jj) * 512 : p.P + (size_t)(NP + b) * INCP + C_KVW; }
        kp = base + kvh * 128; vp = base + 256 + kvh * 128;
    }
}
template <int BR, bool SMP>
__device__ __forceinline__ void nsa_branch(const Params& p, int b, int tpos, int kvh, int nkeys, const int* sel, const float* myq, float* mysc, float slope, int lane, float& r0, float& r1) {
    const float scale = 0.08838834764831845f;
    float mloc = -1e30f;
    for (int j0 = 0; j0 < nkeys; j0 += 64) {
        const int j = j0 + lane; float s = -1e30f;
        if (j < nkeys) {
            int pos; bool valid; const float *kp, *vp; nsa_key<BR, SMP>(p, b, tpos, kvh, j, sel, pos, valid, kp, vp);
            if (valid) { float dot = 0.f;
                for (int d = 0; d < 128; d += 4) { const float4 kv = *(const float4*)(kp + d); dot += myq[d] * kv.x + myq[d + 1] * kv.y + myq[d + 2] * kv.z + myq[d + 3] * kv.w; }
                s = dot * scale - slope * (float)(tpos - pos); }
            mysc[j] = s;
        }
        mloc = fmaxf(mloc, s);
    }
    const float m = wave_max(mloc);
    float lsum = 0.f;
    for (int j0 = 0; j0 < nkeys; j0 += 64) { const int j = j0 + lane; if (j < nkeys) { const float s = mysc[j]; const float e = s > -1e29f ? __expf(s - m) : 0.f; mysc[j] = e; lsum += e; } }
    const float l = wave_sum(lsum);
    const float linv = l > 0.f ? 1.f / l : 0.f;
    for (int j0 = 0; j0 < nkeys; j0 += 64) { const int j = j0 + lane; if (j < nkeys) mysc[j] *= linv; }
    float a0 = 0.f, a1 = 0.f;
    for (int j = 0; j < nkeys; ++j) {
        const float pj = mysc[j];
        if (pj != 0.f) { int pos; bool valid; const float *kp, *vp; nsa_key<BR, SMP>(p, b, tpos, kvh, j, sel, pos, valid, kp, vp);
            const float2 vv = *(const float2*)(vp + 2 * lane); a0 += pj * vv.x; a1 += pj * vv.y; }
    }
    r0 = a0; r1 = a1;
}
template <bool SMP>
__device__ __forceinline__ void ph4_nsa(const Params& p, int b, int t, float* smem) {
    float* q_s = smem;
    float* sc = smem + 1024;
    int* sel_s = (int*)(sc + 8 * 1024);
    const int tid = threadIdx.x, wave = tid >> 6, lane = tid & 63, hd = wave, kvh = wave >> 2;
    const int row = SMP ? NP + b : b * SEQ + t, tpos = SMP ? PAST : t;
    const float* Pr = p.P + (size_t)row * INCP;
    for (int i = tid; i < 1024; i += NTHR) q_s[i] = Pr[C_Q + i];
    __syncthreads();
    const float slope = exp2f(-(float)(hd + 1));
    float* mysc = sc + wave * 1024; const float* myq = q_s + hd * 128;
    const int NC = SMP ? 512 : 64;
    float c0, c1, s0, s1, w0, w1;
    nsa_branch<0, SMP>(p, b, tpos, kvh, NC, nullptr, myq, mysc, slope, lane, c0, c1);
    __syncthreads();
    const int cur = tpos >> 6, ncand = cur + 1, nsel = ncand < 16 ? ncand : 16;
    if ((wave & 3) == 0) {
        float val[5];
#pragma unroll
        for (int i = 0; i < 5; ++i) { const int blk = lane + 64 * i; float v = -INFINITY;
            if (blk < ncand) { const bool forced = blk == 0 || blk == cur || blk == cur - 1; float imp = 0.f;
                if (!forced) { for (int g = 0; g < 4; ++g) { const float* ps = sc + (kvh * 4 + g) * 1024; if (2 * blk < NC) imp += ps[2 * blk]; if (2 * blk + 1 < NC) imp += ps[2 * blk + 1]; } }
                v = forced ? 1e4f : imp; }
            val[i] = v; }
        for (int r = 0; r < nsel; ++r) {
            float bv = val[0]; int bi = lane;
#pragma unroll
            for (int i = 1; i < 5; ++i) if (val[i] > bv) { bv = val[i]; bi = lane + 64 * i; }
            for (int o = 32; o > 0; o >>= 1) { const float ov = __shfl_xor(bv, o); const int oi = __shfl_xor(bi, o); if (ov > bv || (ov == bv && oi < bi)) { bv = ov; bi = oi; } }
            if (lane == 0) sel_s[kvh * 16 + r] = bi;
#pragma unroll
            for (int i = 0; i < 5; ++i) if (lane + 64 * i == bi) val[i] = -INFINITY;
        }
    }
    __syncthreads();
    nsa_branch<1, SMP>(p, b, tpos, kvh, nsel * 64, sel_s + kvh * 16, myq, mysc, slope, lane, s0, s1);
    nsa_branch<2, SMP>(p, b, tpos, kvh, 512, nullptr, myq, mysc, slope, lane, w0, w1);
    const float g0 = sigmoid_f(Pr[C_GTS + hd * 3 + 0]), g1 = sigmoid_f(Pr[C_GTS + hd * 3 + 1]), g2 = sigmoid_f(Pr[C_GTS + hd * 3 + 2]);
    const float o0 = g0 * c0 + g1 * s0 + g2 * w0, o1 = g0 * c1 + g1 * s1 + g2 * w1;
    *(unsigned*)(p.amix + (size_t)row * 2048 + hd * 128 + 2 * lane) = (unsigned)f2bf(o0) | ((unsigned)f2bf(o1) << 16);
    __syncthreads();
}

constexpr int NSA_KT0 = 0, NSA_VS0 = 17408, NSA_KT1 = 37888, NSA_VS1 = 55296, NSA_IMP = 75776, NSA_SELM = NSA_IMP + 4 * 64 * 33 * 4, NSA_UNI = NSA_SELM + 256;
typedef short s16x4 __attribute__((ext_vector_type(4)));
__device__ __forceinline__ bf16x8 pack8(float x0, float x1, float x2, float x3, float x4, float x5, float x6, float x7) {
    u32x4 p;
    asm volatile("v_cvt_pk_bf16_f32 %0, %4, %5\n\tv_cvt_pk_bf16_f32 %1, %6, %7\n\tv_cvt_pk_bf16_f32 %2, %8, %9\n\tv_cvt_pk_bf16_f32 %3, %10, %11\n\ts_nop 1"
                 : "=&v"(p[0]), "=&v"(p[1]), "=&v"(p[2]), "=&v"(p[3]) : "v"(x0), "v"(x1), "v"(x2), "v"(x3), "v"(x4), "v"(x5), "v"(x6), "v"(x7));
    return __builtin_bit_cast(bf16x8, p);
}
__device__ __forceinline__ void nsa_fetch(const bf16_t* kbase, const bf16_t* vbase, int rs, int tid, uint4 (&kr)[2], uint4 (&vr)[2]) {
#pragma unroll
    for (int u = 0; u < 2; ++u) { const int c = tid + 512 * u; kr[u] = *(const uint4*)(kbase + (size_t)(c >> 4) * rs + (c & 15) * 8); vr[u] = *(const uint4*)(vbase + (size_t)(c >> 4) * rs + (c & 15) * 8); }
}
__device__ __forceinline__ void nsa_store(unsigned char* Kt, unsigned char* Vs, int tid, const uint4 (&kr)[2], const uint4 (&vr)[2]) {
#pragma unroll
    for (int u = 0; u < 2; ++u) { const int c = tid + 512 * u; *(uint4*)(Kt + (c >> 4) * 272 + (c & 15) * 16) = kr[u]; *(uint4*)(Vs + (c >> 4) * 320 + (c & 15) * 16) = vr[u]; }
}
template <int MODE>
__device__ __forceinline__ void nsa_tile(const unsigned char* Kt, const unsigned char* Vt, const bf16x8 (&qf)[8], int lane, int kb0, int t, float scl, float slp, bool sel, int edge,
                                         float& m, float& l, f32x16 (&O)[4], f32x16 (&S)[2], bf16x8 (&pf)[4]) {
    const int ql = lane & 31, h = lane >> 5;
#pragma unroll
    for (int b2 = 0; b2 < 2; ++b2) {
        f32x16 acc; for (int r = 0; r < 16; ++r) acc[r] = 0.f;
        bf16x8 kf[8];
#pragma unroll
        for (int s = 0; s < 8; ++s) kf[s] = *(const bf16x8*)(Kt + (32 * b2 + ql) * 272 + (16 * s + 8 * h) * 2);
#pragma unroll
        for (int s = 0; s < 8; ++s) acc = MFMA32(kf[s], qf[s], acc);
        S[b2] = acc;
    }
    float tmax = -1e30f;
    const int KS = MODE == 0 ? 32 : 1;
    const int d0 = MODE == 0 ? t - 31 - 128 * h : t - kb0 - 4 * h;
    const float nb0 = -slp * (float)d0, slk = slp * (float)KS;
#pragma unroll
    for (int b2 = 0; b2 < 2; ++b2)
#pragma unroll
        for (int r = 0; r < 16; ++r) {
            const int c = 32 * b2 + 8 * (r >> 2) + (r & 3);
            bool valid;
            if (MODE == 0) valid = d0 >= KS * c;
            else if (MODE == 1) valid = sel && (!(edge & 1) || d0 >= c);
            else valid = (!(edge & 1) || d0 >= c) && (!(edge & 2) || d0 < 512 + c);
            const float sc = __builtin_fmaf(S[b2][r], scl, __builtin_fmaf(slk, (float)c, nb0));
            const float sv = valid ? sc : -1e30f;
            S[b2][r] = sv; tmax = fmaxf(tmax, sv);
        }
    tmax = fmaxf(tmax, __shfl_xor(tmax, 32));
    const float mn = fmaxf(m, tmax);
    const float alpha = __builtin_amdgcn_exp2f(m - mn);
    m = mn;
    if (!__all(alpha == 1.f)) {
        l *= alpha;
#pragma unroll
        for (int d = 0; d < 4; ++d)
#pragma unroll
            for (int r = 0; r < 16; ++r) O[d][r] *= alpha;
    }
    float ls = 0.f;
#pragma unroll
    for (int b2 = 0; b2 < 2; ++b2)
#pragma unroll
        for (int r = 0; r < 16; ++r) { const float sv = S[b2][r]; const float pv = sv > -1e29f ? __builtin_amdgcn_exp2f(sv - mn) : 0.f; S[b2][r] = pv; ls += pv; }
    l += ls;
#pragma unroll
    for (int ks = 0; ks < 4; ++ks) { const int b2 = ks >> 1, s = ks & 1;
        pf[ks] = pack8(S[b2][8 * s], S[b2][8 * s + 1], S[b2][8 * s + 2], S[b2][8 * s + 3], S[b2][8 * s + 4], S[b2][8 * s + 5], S[b2][8 * s + 6], S[b2][8 * s + 7]); }
}
__device__ __forceinline__ void nsa_pv(const unsigned char* Vs, int lane, f32x16 (&O)[4], const bf16x8 (&pf)[4]) {
    const int g = lane >> 4, i16 = lane & 15, h = g >> 1;
    const unsigned char* vb = Vs + (4 * h + (i16 >> 2)) * 320 + (16 * (g & 1) + 4 * (i16 & 3)) * 2;
#pragma unroll
    for (int d = 0; d < 4; ++d) {
        s16x4 lo[4], hi[4];
#pragma unroll
        for (int ks = 0; ks < 4; ++ks) { lo[ks] = __builtin_amdgcn_ds_read_tr16_b64_v4i16((LAS s16x4*)(vb + (16 * ks) * 320 + 64 * d)); hi[ks] = __builtin_amdgcn_ds_read_tr16_b64_v4i16((LAS s16x4*)(vb + (16 * ks + 8) * 320 + 64 * d)); }
#pragma unroll
        for (int ks = 0; ks < 4; ++ks) { const bf16x8 av = __builtin_shufflevector(lo[ks], hi[ks], 0, 1, 2, 3, 4, 5, 6, 7); O[d] = MFMA32(av, pf[ks], O[d]); }
    }
}
template <bool FIRST>
__device__ __forceinline__ void nsa_flush(bf16_t* orow, int h, float f, f32x16 (&O)[4]) {
#pragma unroll
    for (int d = 0; d < 4; ++d)
#pragma unroll
        for (int rg = 0; rg < 4; ++rg) {
            uint2* dst = (uint2*)(orow + 32 * d + 8 * rg + 4 * h);
            float a0 = O[d][4 * rg] * f, a1 = O[d][4 * rg + 1] * f, a2 = O[d][4 * rg + 2] * f, a3 = O[d][4 * rg + 3] * f;
            if (!FIRST) { const uint2 old = *dst; a0 += __uint_as_float(old.x << 16); a1 += __uint_as_float(old.x & 0xffff0000u); a2 += __uint_as_float(old.y << 16); a3 += __uint_as_float(old.y & 0xffff0000u); }
            uint2 w; w.x = pk2(a0, a1); w.y = pk2(a2, a3); *dst = w;
            O[d][4 * rg] = 0.f; O[d][4 * rg + 1] = 0.f; O[d][4 * rg + 2] = 0.f; O[d][4 * rg + 3] = 0.f;
        }
}
__device__ __forceinline__ void ph4_nsa_fast(const Params& p, int u, unsigned char* lds) {
    int tid = threadIdx.x; asm volatile("" : "+v"(tid));
    const int wave = tid >> 6, lane = tid & 63, ql = lane & 31;
    const int i = 31 - (u >> 3), b = (u & 7) >> 1, kvh = u & 1;
    const int g = wave >> 1, qh = wave & 1, hd = kvh * 4 + g;
    const int t = i * 64 + qh * 32 + ql;
    const size_t row = (size_t)b * SEQ + t;
    float* imp = (float*)(lds + NSA_IMP); unsigned* selm = (unsigned*)(lds + NSA_SELM); unsigned* uni = (unsigned*)(lds + NSA_UNI);
    bf16x8 qf[8];
    { const bf16_t* qrow = p.Qb + row * 1024 + hd * 128 + 8 * (lane >> 5);
#pragma unroll
      for (int s = 0; s < 8; ++s) qf[s] = *(const bf16x8*)(qrow + 16 * s); }
    const float LOG2E = 1.4426950408889634f;
    const float scl = 0.08838834764831845f * LOG2E, slp = exp2f(-(float)(hd + 1)) * LOG2E;
    const float* Pr = p.P + row * INCP;
    const float g0 = sigmoid_f(Pr[C_GTS + hd * 3 + 0]), g1 = sigmoid_f(Pr[C_GTS + hd * 3 + 1]), g2 = sigmoid_f(Pr[C_GTS + hd * 3 + 2]);
    f32x16 O[4], S[2];
#pragma unroll
    for (int d = 0; d < 4; ++d) for (int r = 0; r < 16; ++r) O[d][r] = 0.f;
    bf16_t* orow = p.amix + row * 2048 + hd * 128;
    uint4 kr[2], vr[2];
    if (wave >= 4) __builtin_amdgcn_s_setprio(1);
    int cnt = 0;
#define KT(k) (lds + (((k) & 1) ? NSA_KT1 : NSA_KT0))
#define VS(k) (lds + (((k) & 1) ? NSA_VS1 : NSA_VS0))
    {
        const float* cb = p.ckv_p + (size_t)b * 64 * 512;
#pragma unroll
        for (int uu = 0; uu < 2; ++uu) { const int c = tid + 512 * uu, n = c >> 4, part = c & 15;
            const float4 a = *(const float4*)(cb + (size_t)n * 512 + kvh * 128 + part * 8), bq = *(const float4*)(cb + (size_t)n * 512 + kvh * 128 + part * 8 + 4);
            kr[uu] = make_uint4(pk2(a.x, a.y), pk2(a.z, a.w), pk2(bq.x, bq.y), pk2(bq.z, bq.w));
            const float4 c4 = *(const float4*)(cb + (size_t)n * 512 + 256 + kvh * 128 + part * 8), d4 = *(const float4*)(cb + (size_t)n * 512 + 256 + kvh * 128 + part * 8 + 4);
            vr[uu] = make_uint4(pk2(c4.x, c4.y), pk2(c4.z, c4.w), pk2(d4.x, d4.y), pk2(d4.z, d4.w)); }
        nsa_store(KT(cnt), VS(cnt), tid, kr, vr);
        __syncthreads();
        float m = -1e30f, l = 0.f;
        bf16x8 pf[4];
        nsa_tile<0>(KT(cnt), nullptr, qf, lane, 0, t, scl, slp, true, 0, m, l, O, S, pf);
        nsa_pv(VS(cnt), lane, O, pf);
        ++cnt;
        const float lt = l + __shfl_xor(l, 32);
        const float linv = lt > 0.f ? 1.f / lt : 0.f;
        float* ip = imp + (size_t)(g * 64 + qh * 32 + ql) * 33;
#pragma unroll
        for (int b2 = 0; b2 < 2; ++b2)
#pragma unroll
            for (int r = 0; r < 16; r += 2) { const int ko = 32 * b2 + 8 * (r >> 2) + 4 * (lane >> 5) + (r & 3); ip[ko >> 1] = (S[b2][r] + S[b2][r + 1]) * linv; }
        nsa_flush<true>(orow, lane >> 5, g0 * linv, O);
    }
    __syncthreads();
    {
        const int qq = tid >> 3, sub = tid & 7, ncand = i + 1;
        unsigned mask;
        if (ncand <= 16) mask = (1u << ncand) - 1u;
        else {
            float val[4];
#pragma unroll
            for (int c = 0; c < 4; ++c) { const int blk = sub + 8 * c; float v = -INFINITY;
                if (blk < ncand) { const bool forced = blk == 0 || blk == i || blk == i - 1;
                    v = forced ? 1e4f : imp[(0 * 64 + qq) * 33 + blk] + imp[(1 * 64 + qq) * 33 + blk] + imp[(2 * 64 + qq) * 33 + blk] + imp[(3 * 64 + qq) * 33 + blk]; }
                val[c] = v; }
            mask = 0u;
            for (int r = 0; r < 16; ++r) {
                float bv = val[0]; int bi = sub;
#pragma unroll
                for (int c = 1; c < 4; ++c) if (val[c] > bv) { bv = val[c]; bi = sub + 8 * c; }
#define SEL_STEP(CTRL) { const float ov = __int_as_float(__builtin_amdgcn_update_dpp(0, __float_as_int(bv), CTRL, 0xf, 0xf, true)); const int oi = __builtin_amdgcn_update_dpp(0, bi, CTRL, 0xf, 0xf, true); \
                         if (ov > bv || (ov == bv && oi < bi)) { bv = ov; bi = oi; } }
                SEL_STEP(0xB1) SEL_STEP(0x4E) SEL_STEP(0x141)
#undef SEL_STEP
                mask |= 1u << bi;
#pragma unroll
                for (int c = 0; c < 4; ++c) if (sub + 8 * c == bi) val[c] = -INFINITY;
            }
        }
        if (sub == 0) selm[qq] = mask;
    }
    __syncthreads();
    if (wave == 0) { unsigned um = selm[lane]; for (int o = 32; o > 0; o >>= 1) um |= __shfl_xor(um, o); if (lane == 0) uni[0] = um; }
    __syncthreads();
    const unsigned mymask = selm[qh * 32 + ql], umask = uni[0];
    {
        const bf16_t* kvb = p.KVb + (size_t)b * SEQ * 1024 + kvh * 128;
        float m = -1e30f, l = 0.f;
        int j = i;
        nsa_fetch(kvb + (size_t)j * 64 * 1024, kvb + (size_t)j * 64 * 1024 + 256, 1024, tid, kr, vr);
        nsa_store(KT(cnt), VS(cnt), tid, kr, vr);
        __syncthreads();
        while (j >= 0) {
            int jn = j - 1; while (jn >= 0 && !((umask >> jn) & 1u)) --jn;
            const bool sel = (mymask >> j) & 1u; const bool any = __any(sel);
            bf16x8 pf[4];
            if (any) nsa_tile<1>(KT(cnt), nullptr, qf, lane, j * 64, t, scl, slp, sel, j == i ? 1 : 0, m, l, O, S, pf);
            if (jn >= 0) nsa_fetch(kvb + (size_t)jn * 64 * 1024, kvb + (size_t)jn * 64 * 1024 + 256, 1024, tid, kr, vr);
            if (any) nsa_pv(VS(cnt), lane, O, pf);
            ++cnt;
            if (jn >= 0) nsa_store(KT(cnt), VS(cnt), tid, kr, vr);
            __syncthreads();
            j = jn;
        }
        const float lt = l + __shfl_xor(l, 32);
        nsa_flush<false>(orow, lane >> 5, lt > 0.f ? g1 / lt : 0.f, O);
    }
    {
        const bf16_t* kvb = p.KVb + (size_t)b * SEQ * 1024 + 512 + kvh * 128;
        float m = -1e30f, l = 0.f;
        const int jlo = i - 8 < 0 ? 0 : i - 8;
        int j = i;
        nsa_fetch(kvb + (size_t)j * 64 * 1024, kvb + (size_t)j * 64 * 1024 + 256, 1024, tid, kr, vr);
        nsa_store(KT(cnt), VS(cnt), tid, kr, vr);
        __syncthreads();
        while (j >= jlo) {
            bf16x8 pf[4];
            nsa_tile<2>(KT(cnt), nullptr, qf, lane, j * 64, t, scl, slp, true, (j == i ? 1 : 0) | (j == i - 8 ? 2 : 0), m, l, O, S, pf);
            if (j - 1 >= jlo) nsa_fetch(kvb + (size_t)(j - 1) * 64 * 1024, kvb + (size_t)(j - 1) * 64 * 1024 + 256, 1024, tid, kr, vr);
            nsa_pv(VS(cnt), lane, O, pf);
            ++cnt;
            if (j - 1 >= jlo) nsa_store(KT(cnt), VS(cnt), tid, kr, vr);
            __syncthreads();
            --j;
        }
        const float lt = l + __shfl_xor(l, 32);
        nsa_flush<false>(orow, lane >> 5, lt > 0.f ? g2 / lt : 0.f, O);
    }
#undef KT
#undef VS
    __builtin_amdgcn_s_setprio(0);
    __syncthreads();
}

constexpr int NS_Q = 0, NS_SC = 2048, NS_SEL = NS_SC + 4 * 2048 * 4, NS_RED = NS_SEL + 256;
__device__ __forceinline__ void ns_softmax(float* s, int lo, int hi, int lane, float mult) {
    float m = -1e30f;
    for (int j = lo + lane; j < hi; j += 64) m = fmaxf(m, s[j]);
    m = wave_max(m);
    float sum = 0.f;
    for (int j = lo + lane; j < hi; j += 64) { const float v = s[j]; const float e = v > -1e29f ? __expf(v - m) : 0.f; s[j] = e; sum += e; }
    sum = wave_sum(sum);
    const float f = sum > 0.f ? mult / sum : 0.f;
    for (int j = lo + lane; j < hi; j += 64) s[j] *= f;
}
__device__ __forceinline__ void ns_scores(const float* q_s, const float* kp, bool valid, int dist, int kvh, float* sc, int j) {
    float a0 = 0.f, a1 = 0.f, a2 = 0.f, a3 = 0.f;
    if (valid) {
#pragma unroll 16
        for (int d = 0; d < 128; d += 4) { const float4 kv = *(const float4*)(kp + d);
            a0 += q_s[d] * kv.x + q_s[d + 1] * kv.y + q_s[d + 2] * kv.z + q_s[d + 3] * kv.w;
            a1 += q_s[128 + d] * kv.x + q_s[128 + d + 1] * kv.y + q_s[128 + d + 2] * kv.z + q_s[128 + d + 3] * kv.w;
            a2 += q_s[256 + d] * kv.x + q_s[256 + d + 1] * kv.y + q_s[256 + d + 2] * kv.z + q_s[256 + d + 3] * kv.w;
            a3 += q_s[384 + d] * kv.x + q_s[384 + d + 1] * kv.y + q_s[384 + d + 2] * kv.z + q_s[384 + d + 3] * kv.w; }
    }
    const float scale = 0.08838834764831845f, fd = (float)dist;
    sc[0 * 2048 + j] = valid ? a0 * scale - exp2f(-(float)(kvh * 4 + 1)) * fd : -1e30f;
    sc[1 * 2048 + j] = valid ? a1 * scale - exp2f(-(float)(kvh * 4 + 2)) * fd : -1e30f;
    sc[2 * 2048 + j] = valid ? a2 * scale - exp2f(-(float)(kvh * 4 + 3)) * fd : -1e30f;
    sc[3 * 2048 + j] = valid ? a3 * scale - exp2f(-(float)(kvh * 4 + 4)) * fd : -1e30f;
}
__device__ __forceinline__ void ph4_nsa_sample(const Params& p, int u, unsigned char* lds) {
    int tid = threadIdx.x; asm volatile("" : "+v"(tid));
    const int wave = tid >> 6, lane = tid & 63, b = u >> 1, kvh = u & 1, row = NP + b, tpos = PAST;
    float* q_s = (float*)(lds + NS_Q); float* sc = (float*)(lds + NS_SC); int* sel_s = (int*)(lds + NS_SEL); float* red = (float*)(lds + NS_RED);
    const float* Pr = p.P + (size_t)row * INCP;
    q_s[tid] = Pr[C_Q + kvh * 512 + tid];
    __syncthreads();
    { int pos; bool valid; const float *kp, *vp; nsa_key<0, true>(p, b, tpos, kvh, tid, nullptr, pos, valid, kp, vp); ns_scores(q_s, kp, valid, tpos - pos, kvh, sc, tid); }
    __syncthreads();
    if (wave < 4) ns_softmax(sc + wave * 2048, 0, 512, lane, 1.f);
    __syncthreads();
    if (wave == 0) {
        const int cur = tpos >> 6, ncand = cur + 1;
        float val[5];
#pragma unroll
        for (int i = 0; i < 5; ++i) { const int blk = lane + 64 * i; float v = -INFINITY;
            if (blk < ncand) { const bool forced = blk == 0 || blk == cur || blk == cur - 1; float imp = 0.f;
                if (!forced) { for (int g = 0; g < 4; ++g) { if (2 * blk < 512) imp += sc[g * 2048 + 2 * blk]; if (2 * blk + 1 < 512) imp += sc[g * 2048 + 2 * blk + 1]; } }
                v = forced ? 1e4f : imp; }
            val[i] = v; }
        for (int r = 0; r < 16; ++r) {
            float bv = val[0]; int bi = lane;
#pragma unroll
            for (int i = 1; i < 5; ++i) if (val[i] > bv) { bv = val[i]; bi = lane + 64 * i; }
            for (int o = 32; o > 0; o >>= 1) { const float ov = __shfl_xor(bv, o); const int oi = __shfl_xor(bi, o); if (ov > bv || (ov == bv && oi < bi)) { bv = ov; bi = oi; } }
            if (lane == 0) sel_s[r] = bi;
#pragma unroll
            for (int i = 0; i < 5; ++i) if (lane + 64 * i == bi) val[i] = -INFINITY;
        }
    }
    __syncthreads();
#pragma unroll
    for (int i = 0; i < 3; ++i) { const int j = 512 + tid + 512 * i; int pos; bool valid; const float *kp, *vp;
        if (i < 2) nsa_key<1, true>(p, b, tpos, kvh, j - 512, sel_s, pos, valid, kp, vp); else nsa_key<2, true>(p, b, tpos, kvh, j - 1536, nullptr, pos, valid, kp, vp);
        ns_scores(q_s, kp, valid, tpos - pos, kvh, sc, j); }
    __syncthreads();
    { const int h = wave & 3, br = wave >> 2; const float gt = sigmoid_f(Pr[C_GTS + (kvh * 4 + h) * 3 + 1 + br]);
      ns_softmax(sc + h * 2048, br ? 1536 : 512, br ? 2048 : 1536, lane, gt);
      if (wave < 4) { const float g0 = sigmoid_f(Pr[C_GTS + (kvh * 4 + h) * 3]); for (int j = lane; j < 512; j += 64) sc[h * 2048 + j] *= g0; } }
    __syncthreads();
    { const int d4 = tid & 31, slice = tid >> 5;
      float4 a0 = make_float4(0.f, 0.f, 0.f, 0.f), a1 = a0, a2 = a0, a3 = a0;
#pragma unroll 16
      for (int i = 0; i < 128; ++i) { const int j = slice * 128 + i; int pos; bool valid; const float *kp, *vp;
          if (slice < 4) nsa_key<0, true>(p, b, tpos, kvh, j, nullptr, pos, valid, kp, vp);
          else if (slice < 12) nsa_key<1, true>(p, b, tpos, kvh, j - 512, sel_s, pos, valid, kp, vp);
          else nsa_key<2, true>(p, b, tpos, kvh, j - 1536, nullptr, pos, valid, kp, vp);
          const float4 v = *(const float4*)(vp + 4 * d4);
          const float w0 = sc[j], w1 = sc[2048 + j], w2 = sc[4096 + j], w3 = sc[6144 + j];
          a0.x += w0 * v.x; a0.y += w0 * v.y; a0.z += w0 * v.z; a0.w += w0 * v.w; a1.x += w1 * v.x; a1.y += w1 * v.y; a1.z += w1 * v.z; a1.w += w1 * v.w;
          a2.x += w2 * v.x; a2.y += w2 * v.y; a2.z += w2 * v.z; a2.w += w2 * v.w; a3.x += w3 * v.x; a3.y += w3 * v.y; a3.z += w3 * v.z; a3.w += w3 * v.w; }
      *(float4*)(red + (slice * 4 + 0) * 128 + 4 * d4) = a0; *(float4*)(red + (slice * 4 + 1) * 128 + 4 * d4) = a1;
      *(float4*)(red + (slice * 4 + 2) * 128 + 4 * d4) = a2; *(float4*)(red + (slice * 4 + 3) * 128 + 4 * d4) = a3; }
    __syncthreads();
    { const int h = tid >> 7, d = tid & 127; float o = 0.f;
#pragma unroll
      for (int s2 = 0; s2 < 16; ++s2) o += red[(s2 * 4 + h) * 128 + d];
      p.amix[(size_t)row * 2048 + (kvh * 4 + h) * 128 + d] = f2bf(o); }
    __syncthreads();
}
__device__ __forceinline__ void ph4_gdn(const Params& p, int u, float* smem) {
    float* qs = smem;
    float* ks = qs + 16 * 128;
    float* vs = ks + 16 * 128;
    float* ab = vs + 16 * 128;
    float* red = ab + 32;
    float* red2 = red + 512;
    const int tid = threadIdx.x, dv = tid & 127, grp = tid >> 7;
    const bool smp = u >= 32; const int v = smp ? u - 32 : u, b = v >> 3, h = v & 7;
    const int T = smp ? 1 : SEQ, row0 = smp ? NP + b : b * SEQ;
    float S[32];
#pragma unroll
    for (int i = 0; i < 32; ++i) S[i] = smp ? p.state_gdn[(((size_t)b * 8 + h) * 128 + grp * 32 + i) * 128 + dv] : 0.f;
    for (int t0 = 0; t0 < T; t0 += 16) {
        const int nst = (T - t0) < 16 ? (T - t0) : 16;
        __syncthreads();
        for (int i = tid; i < nst * 128; i += NTHR) { const int st = i >> 7, d = i & 127; const float* r = p.qkvn + (size_t)(row0 + t0 + st) * 3072 + h * 128 + d;
            qs[i] = r[0]; ks[i] = r[1024]; vs[i] = r[2048]; }
        if (tid < nst) { ab[tid * 2] = __expf(p.gg[(row0 + t0 + tid) * 8 + h]); ab[tid * 2 + 1] = p.gbeta[(row0 + t0 + tid) * 8 + h]; }
        __syncthreads();
        for (int st = 0; st < nst; ++st) {
            const float a = ab[st * 2], be = ab[st * 2 + 1];
            const float* kk = ks + st * 128 + grp * 32; const float* qq = qs + st * 128 + grp * 32;
            float part = 0.f;
#pragma unroll
            for (int i = 0; i < 32; ++i) part += kk[i] * S[i];
            red[grp * 128 + dv] = part;
            __syncthreads();
            const float kS = red[dv] + red[128 + dv] + red[256 + dv] + red[384 + dv];
            const float vn = be * (vs[st * 128 + dv] - a * kS);
            float op = 0.f;
#pragma unroll
            for (int i = 0; i < 32; ++i) { S[i] = a * S[i] + kk[i] * vn; op += qq[i] * S[i]; }
            red2[grp * 128 + dv] = op;
            __syncthreads();
            if (grp == 0) p.ograw[(size_t)(row0 + t0 + st) * 1024 + h * 128 + dv] = red2[dv] + red2[128 + dv] + red2[256 + dv] + red2[384 + dv];
        }
    }
    float* So = p.out + (smp ? O_GS : O_GP) + (((size_t)b * 8 + h) * 128) * 128;
#pragma unroll
    for (int i = 0; i < 32; ++i) So[(size_t)(grp * 32 + i) * 128 + dv] = S[i];
    __syncthreads();
}


constexpr int GA_Q = 0, GA_K = 17408, GA_T = GA_K, GA_VBT = 34816, GA_KBGT = 53248, GA_KDT = 71680, GA_QK = 90112, GA_AF = 99328, GA_WT = 99328, GA_UT = 117760, GA_SC = 136192;
__device__ __forceinline__ uint2 pack4(const f32x4& v) { uint2 w; w.x = pk2(v[0], v[1]); w.y = pk2(v[2], v[3]); return w; }
__device__ __forceinline__ void ph3_gdnA(const Params& p, int u, unsigned char* lds) {
    int tid = threadIdx.x; asm volatile("" : "+v"(tid));
    const int wave = tid >> 6, lane = tid & 63, r16 = lane & 15, quad = lane >> 4;
    const int n = u & 31, h = (u >> 5) & 7, b = u >> 8;
    const int row0 = b * SEQ + n * 64;
    float* sc_beta = (float*)(lds + GA_SC); float* sc_G = sc_beta + 64; float* sc_eG = sc_G + 64; float* sc_eGl = sc_eG + 64;
    if (tid < 64) {
        const float* Pr = p.P + (size_t)(row0 + tid) * INCP;
        const float be = sigmoid_f(Pr[C_BL + h]);
        float g = -__expf(p.a_log[h]) * softplus_f(Pr[C_AL + h] + p.dt_bias[h]);
        for (int o = 1; o < 64; o <<= 1) { const float tt = __shfl_up(g, o); if (lane >= o) g += tt; }
        const float Gl = __shfl(g, 63);
        sc_beta[tid] = be; sc_G[tid] = g; sc_eG[tid] = __expf(g); sc_eGl[tid] = __expf(Gl - g);
    }
    __syncthreads();
    {
        float cw[6][4];
#pragma unroll
        for (int e = 0; e < 6; ++e) { const int col = (e >> 1) * 1024 + h * 128 + lane + 64 * (e & 1);
#pragma unroll
            for (int i = 0; i < 4; ++i) cw[e][i] = p.conv_w[i * 3072 + col]; }
        float raw[11][6];
#pragma unroll
        for (int r = 0; r < 11; ++r) { const int tt = n * 64 + wave * 8 - 3 + r;
#pragma unroll
            for (int e = 0; e < 6; ++e) { const int col = C_QKV + (e >> 1) * 1024 + h * 128 + lane + 64 * (e & 1);
                raw[r][e] = tt >= 0 ? p.P[(size_t)(row0 + wave * 8 - 3 + r) * INCP + col] : 0.f; } }
#pragma unroll
        for (int ii = 0; ii < 8; ++ii) {
            const int c = wave * 8 + ii;
            float val[6];
#pragma unroll
            for (int e = 0; e < 6; ++e) { float acc = 0.f;
#pragma unroll
                for (int i = 0; i < 4; ++i) acc += raw[ii + i][e] * cw[e][i];
                val[e] = silu_f(acc); }
            const float rq = rsqrtf(wave_sum_sw(val[0] * val[0] + val[1] * val[1]) + 1e-6f) * 0.08838834764831845f;
            const float rk = rsqrtf(wave_sum_sw(val[2] * val[2] + val[3] * val[3]) + 1e-6f);
            const float be = sc_beta[c], eG = sc_eG[c], eGl = sc_eGl[c];
#pragma unroll
            for (int e2 = 0; e2 < 2; ++e2) { const int ch = lane + 64 * e2; const float kv = val[2 + e2] * rk;
                *(bf16_t*)(lds + GA_Q + c * 272 + ch * 2) = f2bf(val[e2] * rq);
                *(bf16_t*)(lds + GA_K + c * 272 + ch * 2) = f2bf(kv);
                *(bf16_t*)(lds + GA_KBGT + ch * 144 + c * 2) = f2bf(kv * be * eG);
                *(bf16_t*)(lds + GA_KDT + ch * 144 + c * 2) = f2bf(kv * eGl);
                *(bf16_t*)(lds + GA_VBT + ch * 144 + c * 2) = f2bf(val[4 + e2] * be); }
        }
    }
    __syncthreads();
    {
        const int sel = wave >> 2, rb = wave & 3;
        const unsigned char* Ab = lds + (sel ? GA_Q : GA_K) + (16 * rb + r16) * 272 + quad * 16;
        f32x4 acc[4];
#pragma unroll
        for (int cb = 0; cb < 4; ++cb) acc[cb] = (f32x4){0.f, 0.f, 0.f, 0.f};
#pragma unroll
        for (int ks = 0; ks < 4; ++ks) { const bf16x8 a = *(const bf16x8*)(Ab + ks * 64);
#pragma unroll
            for (int cb = 0; cb < 4; ++cb) { const bf16x8 bb = *(const bf16x8*)(lds + GA_K + (16 * cb + r16) * 272 + quad * 16 + ks * 64); acc[cb] = MFMA16(a, bb, acc[cb]); } }
        float* AF = (float*)(lds + GA_AF);
#pragma unroll
        for (int cb = 0; cb < 4; ++cb)
#pragma unroll
            for (int rg = 0; rg < 4; ++rg) { const int c = 16 * rb + 4 * quad + rg, m = 16 * cb + r16;
                const float dec = m <= c ? __expf(sc_G[c] - sc_G[m]) : 0.f;
                if (sel == 0) AF[c * 64 + m] = m < c ? sc_beta[c] * acc[cb][rg] * dec : 0.f;
                else *(bf16_t*)(lds + GA_QK + c * 144 + m * 2) = f2bf(acc[cb][rg] * dec); }
    }
    __syncthreads();
    if (wave == 0) {
        int zoff = 0; asm volatile("" : "+v"(zoff));
        const float* AF = (const float*)(lds + GA_AF) + zoff;
        float tc[64];
#pragma unroll
        for (int c = 0; c < 64; ++c) {
            f32x4 ar[16];
#pragma unroll
            for (int q = 0; q < (c + 3) / 4; ++q) ar[q] = *(const f32x4*)(AF + c * 64 + 4 * q);
            float acc = (c == lane) ? 1.f : 0.f;
#pragma unroll
            for (int m = 0; m < c; ++m) acc -= ar[m >> 2][m & 3] * tc[m];
            tc[c] = acc; }
#pragma unroll
        for (int c = 0; c < 64; ++c) *(bf16_t*)(lds + GA_T + c * 144 + lane * 2) = f2bf(tc[c]);
    }
    __syncthreads();
    {
        const int isW = wave >> 2;
        const unsigned char* Bs = lds + (isW ? GA_KBGT : GA_VBT); unsigned char* Ds = lds + (isW ? GA_WT : GA_UT);
#pragma unroll
        for (int cbi = 0; cbi < 2; ++cbi) { const int cb = (wave & 3) * 2 + cbi;
            bf16x8 bfr[2];
#pragma unroll
            for (int ks = 0; ks < 2; ++ks) bfr[ks] = *(const bf16x8*)(Bs + (16 * cb + r16) * 144 + ks * 64 + quad * 16);
#pragma unroll
            for (int rb = 0; rb < 4; ++rb) { f32x4 acc = (f32x4){0.f, 0.f, 0.f, 0.f};
#pragma unroll
                for (int ks = 0; ks < 2; ++ks) { const bf16x8 a = *(const bf16x8*)(lds + GA_T + (16 * rb + r16) * 144 + ks * 64 + quad * 16); acc = MFMA16(a, bfr[ks], acc); }
                *(uint2*)(Ds + (16 * cb + r16) * 144 + (16 * rb + 4 * quad) * 2) = pack4(acc); } }
    }
    __syncthreads();
    {
        bf16_t* gN = p.gN + (size_t)u * 16384; bf16_t* gBT = p.gBT + (size_t)u * 16384; bf16_t* gQp = p.gQp + (size_t)u * 8192; bf16_t* gOpT = p.gOpT + (size_t)u * 8192;
        {
            const bool isB = wave >= 4;
            const unsigned char* As = lds + (isB ? GA_KDT : GA_WT); const unsigned char* Bs = lds + (isB ? GA_UT : GA_KDT);
            bf16_t* dst = isB ? gBT : gN;
#pragma unroll
            for (int cbi = 0; cbi < 2; ++cbi) { const int cb = (wave & 3) * 2 + cbi;
                bf16x8 bfr[2];
#pragma unroll
                for (int ks = 0; ks < 2; ++ks) bfr[ks] = *(const bf16x8*)(Bs + (16 * cb + r16) * 144 + ks * 64 + quad * 16);
#pragma unroll
                for (int rb = 0; rb < 8; ++rb) { f32x4 acc = (f32x4){0.f, 0.f, 0.f, 0.f};
#pragma unroll
                    for (int ks = 0; ks < 2; ++ks) { const bf16x8 a = *(const bf16x8*)(As + (16 * rb + r16) * 144 + ks * 64 + quad * 16); acc = MFMA16(a, bfr[ks], acc); }
                    *(uint2*)(dst + (size_t)(16 * cb + r16) * 128 + 16 * rb + 4 * quad) = pack4(acc); } }
        }
        {
            bf16x8 afr[2];
#pragma unroll
            for (int ks = 0; ks < 2; ++ks) afr[ks] = *(const bf16x8*)(lds + GA_WT + (16 * wave + r16) * 144 + ks * 64 + quad * 16);
#pragma unroll
            for (int cb = 0; cb < 4; ++cb) { f32x4 acc = (f32x4){0.f, 0.f, 0.f, 0.f};
#pragma unroll
                for (int ks = 0; ks < 2; ++ks) { const bf16x8 bb = *(const bf16x8*)(lds + GA_QK + (16 * cb + r16) * 144 + ks * 64 + quad * 16); acc = MFMA16(afr[ks], bb, acc); }
                const int c = 16 * cb + r16, dk0 = 16 * wave + 4 * quad; const float eG = sc_eG[c];
                const uint2 qv = *(const uint2*)(lds + GA_Q + c * 272 + dk0 * 2);
                f32x4 o; o[0] = __uint_as_float(qv.x << 16) * eG - acc[0]; o[1] = __uint_as_float(qv.x & 0xffff0000u) * eG - acc[1]; o[2] = __uint_as_float(qv.y << 16) * eG - acc[2]; o[3] = __uint_as_float(qv.y & 0xffff0000u) * eG - acc[3];
                *(uint2*)(gQp + (size_t)c * 128 + dk0) = pack4(o); }
        }
        {
            bf16x8 bfr[2];
#pragma unroll
            for (int ks = 0; ks < 2; ++ks) bfr[ks] = *(const bf16x8*)(lds + GA_UT + (16 * wave + r16) * 144 + ks * 64 + quad * 16);
#pragma unroll
            for (int rb = 0; rb < 4; ++rb) { f32x4 acc = (f32x4){0.f, 0.f, 0.f, 0.f};
#pragma unroll
                for (int ks = 0; ks < 2; ++ks) { const bf16x8 a = *(const bf16x8*)(lds + GA_QK + (16 * rb + r16) * 144 + ks * 64 + quad * 16); acc = MFMA16(a, bfr[ks], acc); }
                *(uint2*)(gOpT + (size_t)(16 * wave + r16) * 64 + 16 * rb + 4 * quad) = pack4(acc); }
        }
        if (tid == 0) p.ggl[u] = sc_eG[63];
    }
    __syncthreads();
}
constexpr int GB_N0 = 0, GB_N1 = 34816;
struct GBSet { u32x4 nreg[4]; u32x2 breg[8]; };
__device__ __forceinline__ void gb_load(const Params& p, size_t ci, int tid, int dv, int quad, GBSet& s) {
    const bf16_t* gN = p.gN + ci * 16384; const bf16_t* gB = p.gBT + ci * 16384;
#pragma unroll
    for (int i = 0; i < 4; ++i) s.nreg[i] = *(const u32x4*)(gN + (size_t)(tid + 512 * i) * 8);
    if (tid < 256) {
#pragma unroll
        for (int rb = 0; rb < 8; ++rb) s.breg[rb] = *(const u32x2*)(gB + (size_t)dv * 128 + 16 * rb + 4 * quad); }
}
__device__ __forceinline__ void gb_step(const Params& p, int u, int n, float gl, unsigned char* lds, int tid, int r16, int quad, int dv, GBSet& s, f32x4 (&S)[8]) {
    const size_t ci = (size_t)u * 32 + n;
    const bool owner = tid < 256;
    bf16_t* gS = p.gST + ci * 16384 + (size_t)dv * 128 + 4 * quad;
    if (owner) {
#pragma unroll
        for (int rb = 0; rb < 8; ++rb) *(uint2*)(gS + 16 * rb) = pack4(S[rb]); }
    bf16x8 bfr[4];
#pragma unroll
    for (int ks = 0; ks < 4; ++ks) bfr[ks] = pack8(S[2 * ks][0], S[2 * ks][1], S[2 * ks][2], S[2 * ks][3], S[2 * ks + 1][0], S[2 * ks + 1][1], S[2 * ks + 1][2], S[2 * ks + 1][3]);
    unsigned char* buf = lds + ((n & 1) ? GB_N1 : GB_N0);
#pragma unroll
    for (int i = 0; i < 4; ++i) { const int idx = tid + 512 * i; *(u32x4*)(buf + (idx >> 4) * 272 + (idx & 15) * 16) = s.nreg[i]; }
    f32x4 Bv[8];
#pragma unroll
    for (int rb = 0; rb < 8; ++rb) { Bv[rb][0] = __uint_as_float(s.breg[rb].x << 16); Bv[rb][1] = __uint_as_float(s.breg[rb].x & 0xffff0000u); Bv[rb][2] = __uint_as_float(s.breg[rb].y << 16); Bv[rb][3] = __uint_as_float(s.breg[rb].y & 0xffff0000u); }
    __syncthreads();
    gb_load(p, (size_t)u * 32 + (n + 2 < 32 ? n + 2 : 31), tid, dv, quad, s);
    if (owner)
#pragma unroll
    for (int rb = 0; rb < 8; ++rb) { f32x4 acc = (f32x4){0.f, 0.f, 0.f, 0.f};
        u32x4 av[4];
#pragma unroll
        for (int ks = 0; ks < 4; ++ks) { const unsigned char* ap = buf + (16 * rb + r16) * 272 + (32 * ks + 4 * quad) * 2;
            const uint2 lo = *(const uint2*)ap, hi = *(const uint2*)(ap + 32); av[ks][0] = lo.x; av[ks][1] = lo.y; av[ks][2] = hi.x; av[ks][3] = hi.y; }
#pragma unroll
        for (int ks = 0; ks < 4; ++ks) acc = MFMA16(__builtin_bit_cast(bf16x8, av[ks]), bfr[ks], acc);
#pragma unroll
        for (int rg = 0; rg < 4; ++rg) S[rb][rg] = gl * S[rb][rg] + Bv[rb][rg] - acc[rg]; }
}
__device__ __forceinline__ void ph4_gdnB(const Params& p, int uu, unsigned char* lds) {
    const int u = uu >> 1, half = uu & 1;
    const int tid = threadIdx.x, wave = tid >> 6, lane = tid & 63, r16 = lane & 15, quad = lane >> 4, dv = 64 * half + 16 * (wave & 3) + r16;
    f32x4 S[8];
#pragma unroll
    for (int rb = 0; rb < 8; ++rb) S[rb] = (f32x4){0.f, 0.f, 0.f, 0.f};
    GBSet A, B;
    gb_load(p, (size_t)u * 32, tid, dv, quad, A);
    gb_load(p, (size_t)u * 32 + 1, tid, dv, quad, B);
    const float glv = p.ggl[(size_t)u * 32 + (lane & 31)];
#pragma unroll 1
    for (int n = 0; n < 32; n += 2) {
        gb_step(p, u, n, __shfl(glv, n), lds, tid, r16, quad, dv, A, S);
        gb_step(p, u, n + 1, __shfl(glv, n + 1), lds, tid, r16, quad, dv, B, S);
    }
    float* So = p.out + O_GP + (size_t)u * 16384;
    if (tid < 256) {
#pragma unroll
        for (int rb = 0; rb < 8; ++rb)
#pragma unroll
            for (int rg = 0; rg < 4; ++rg) So[(size_t)(16 * rb + 4 * quad + rg) * 128 + dv] = S[rb][rg]; }
    __syncthreads();
}
__device__ __forceinline__ void ph5_gdnC(const Params& p, int u, unsigned char* lds) {
    const int tid = threadIdx.x, wave = tid >> 6, lane = tid & 63, r16 = lane & 15, quad = lane >> 4, dv = 16 * wave + r16;
    const int n = u & 31, h = (u >> 5) & 7, b = u >> 8, row0 = b * SEQ + n * 64;
    const bf16_t* Qp = p.gQp + (size_t)u * 8192; const bf16_t* ST = p.gST + (size_t)u * 16384; const bf16_t* OpT = p.gOpT + (size_t)u * 8192;
    bf16x8 bfr[4];
#pragma unroll
    for (int ks = 0; ks < 4; ++ks) bfr[ks] = *(const bf16x8*)(ST + (size_t)dv * 128 + 32 * ks + 8 * quad);
    float zv[4][4];
#pragma unroll
    for (int rb = 0; rb < 4; ++rb)
#pragma unroll
        for (int rg = 0; rg < 4; ++rg) zv[rb][rg] = p.P[(size_t)(row0 + 16 * rb + 4 * quad + rg) * INCP + C_Z + h * 128 + dv];
    f32x4 o[4];
#pragma unroll
    for (int rb = 0; rb < 4; ++rb) { f32x4 acc = (f32x4){0.f, 0.f, 0.f, 0.f};
#pragma unroll
        for (int ks = 0; ks < 4; ++ks) { const bf16x8 a = *(const bf16x8*)(Qp + (size_t)(16 * rb + r16) * 128 + 32 * ks + 8 * quad); acc = MFMA16(a, bfr[ks], acc); }
        const uint2 op = *(const uint2*)(OpT + (size_t)dv * 64 + 16 * rb + 4 * quad);
        acc[0] += __uint_as_float(op.x << 16); acc[1] += __uint_as_float(op.x & 0xffff0000u); acc[2] += __uint_as_float(op.y << 16); acc[3] += __uint_as_float(op.y & 0xffff0000u);
        o[rb] = acc; }
    float* part = (float*)lds;
#pragma unroll
    for (int rb = 0; rb < 4; ++rb)
#pragma unroll
        for (int rg = 0; rg < 4; ++rg) { float v = o[rb][rg] * o[rb][rg]; v += __shfl_xor(v, 1); v += __shfl_xor(v, 2); v += __shfl_xor(v, 4); v += __shfl_xor(v, 8);
            if (r16 == 0) part[wave * 64 + 16 * rb + 4 * quad + rg] = v; }
    __syncthreads();
    const float gw = p.gdn_norm[dv];
#pragma unroll
    for (int rb = 0; rb < 4; ++rb)
#pragma unroll
        for (int rg = 0; rg < 4; ++rg) { const int c = 16 * rb + 4 * quad + rg;
            const float tot = part[c] + part[64 + c] + part[128 + c] + part[192 + c] + part[256 + c] + part[320 + c] + part[384 + c] + part[448 + c];
            const float rstd = rsqrtf(tot * (1.f / 128.f) + 1e-6f);
            p.amix[(size_t)(row0 + c) * 2048 + 1024 + h * 128 + dv] = f2bf(o[rb][rg] * rstd * gw * silu_f(zv[rb][rg])); }
    __syncthreads();
}

__device__ __forceinline__ void ph5_gdnout(const Params& p, int row) {
    const int wave = threadIdx.x >> 6, lane = threadIdx.x & 63, h = wave;
    const float* o = p.ograw + (size_t)row * 1024 + h * 128; const float* z = p.P + (size_t)row * INCP + C_Z + h * 128;
    const float a = o[2 * lane], b = o[2 * lane + 1];
    const float ss = wave_sum(a * a + b * b);
    const float r = rsqrtf(ss * (1.f / 128.f) + 1e-6f);
    const float y0 = a * r * p.gdn_norm[2 * lane] * silu_f(z[2 * lane]), y1 = b * r * p.gdn_norm[2 * lane + 1] * silu_f(z[2 * lane + 1]);
    *(unsigned*)(p.amix + (size_t)row * 2048 + 1024 + h * 128 + 2 * lane) = (unsigned)f2bf(y0) | ((unsigned)f2bf(y1) << 16);
}

__device__ __forceinline__ void ph9_peer(const Params& p, int row, float* smem) {
    float* qs = smem;
    float* hs = qs + 2048;
    float* ssc = hs + 2048;
    float* s_half = ssc + 2048;
    int* i_half = (int*)(s_half + 256);
    float* wgt = (float*)(i_half + 256);
    int* eid = (int*)(wgt + 128);
    float* red = (float*)(eid + 128);
    int tid = threadIdx.x; asm volatile("" : "+v"(tid));
    const int wave = tid >> 6, lane = tid & 63;
    for (int i = tid; i < 2048; i += NTHR) { qs[i] = p.qp[(size_t)row * 2048 + i]; hs[i] = p.h2f[(size_t)row * 2048 + i]; }
    __syncthreads();
    for (int i = 0; i < 4; ++i) { const int idx = tid + NTHR * i, hp = idx >> 7, k = idx & 127, half = hp & 1;
        const float* kr = p.peer_keys + ((size_t)half * 128 + k) * 128; const float* qq = qs + (hp >> 1) * 256 + half * 128;
        float acc = 0.f; for (int d = 0; d < 128; d += 4) { const float4 kv = *(const float4*)(kr + d); acc += qq[d] * kv.x + qq[d + 1] * kv.y + qq[d + 2] * kv.z + qq[d + 3] * kv.w; }
        ssc[idx] = acc; }
    __syncthreads();
    for (int li = 0; li < 2; ++li) { const int hp = wave * 2 + li;
        float v0 = ssc[hp * 128 + lane], v1 = ssc[hp * 128 + 64 + lane];
        for (int r = 0; r < 16; ++r) {
            float bv = v0; int bi = lane; if (v1 > bv) { bv = v1; bi = lane + 64; }
            for (int o = 32; o > 0; o >>= 1) { const float ov = __shfl_xor(bv, o); const int oi = __shfl_xor(bi, o); if (ov > bv || (ov == bv && oi < bi)) { bv = ov; bi = oi; } }
            if (lane == 0) { s_half[hp * 16 + r] = bv; i_half[hp * 16 + r] = bi; }
            if (bi == lane) v0 = -INFINITY; if (bi == lane + 64) v1 = -INFINITY;
        } }
    __syncthreads();
    { const int h = wave; float cv[4];
#pragma unroll
      for (int c = 0; c < 4; ++c) { const int f = lane + 64 * c; cv[c] = s_half[(h * 2) * 16 + (f >> 4)] + s_half[(h * 2 + 1) * 16 + (f & 15)]; }
      float bs_mine = 0.f; int e_mine = 0;
      for (int r = 0; r < 16; ++r) {
          float bv = cv[0]; int bi = lane;
#pragma unroll
          for (int c = 1; c < 4; ++c) if (cv[c] > bv) { bv = cv[c]; bi = lane + 64 * c; }
          for (int o = 32; o > 0; o >>= 1) { const float ov = __shfl_xor(bv, o); const int oi = __shfl_xor(bi, o); if (ov > bv || (ov == bv && oi < bi)) { bv = ov; bi = oi; } }
          if (lane == r) { bs_mine = bv; e_mine = i_half[(h * 2) * 16 + (bi >> 4)] * 128 + i_half[(h * 2 + 1) * 16 + (bi & 15)]; }
#pragma unroll
          for (int c = 0; c < 4; ++c) if (lane + 64 * c == bi) cv[c] = -INFINITY;
      }
      float mx = lane < 16 ? bs_mine : -INFINITY; mx = wave_max(mx);
      const float ex = lane < 16 ? __expf(bs_mine - mx) : 0.f; const float den = wave_sum(ex);
      const float gate = ex / den;
      for (int r = 0; r < 16; ++r) { const int e = __shfl(e_mine, r); const float* ur = p.peer_u + (size_t)e * 2048;
          float acc = 0.f;
#pragma unroll
          for (int i = 0; i < 8; ++i) { const int c = i * 256 + lane * 4; const float4 uv = *(const float4*)(ur + c); acc += hs[c] * uv.x + hs[c + 1] * uv.y + hs[c + 2] * uv.z + hs[c + 3] * uv.w; }
          acc = wave_sum(acc);
          const float g = __shfl(gate, r);
          if (lane == 0) { wgt[h * 16 + r] = g * gelu_tanh(acc); eid[h * 16 + r] = e; } }
    }
    __syncthreads();
    float4 o = make_float4(0.f, 0.f, 0.f, 0.f);
    for (int j = 0; j < 128; ++j) { const float w = wgt[j]; const float4 vv = *(const float4*)(p.peer_v + (size_t)eid[j] * 2048 + tid * 4); o.x += w * vv.x; o.y += w * vv.y; o.z += w * vv.z; o.w += w * vv.w; }
    const int mrow = row < NP ? row / SEQ : 4 + (row - NP);
    const float4 g2 = *(const float4*)(p.mod + (size_t)mrow * 12288 + 10240 + tid * 4);
    const float4 xv = *(const float4*)(p.x1 + (size_t)row * 2048 + tid * 4);
    float4 x2; x2.x = xv.x + g2.x * o.x; x2.y = xv.y + g2.y * o.y; x2.z = xv.z + g2.z * o.z; x2.w = xv.w + g2.w * o.w;
    float ss = wave_sum(x2.x * x2.x + x2.y * x2.y + x2.z * x2.z + x2.w * x2.w);
    if (lane == 0) red[wave] = ss;
    __syncthreads();
    ss = red[0] + red[1] + red[2] + red[3] + red[4] + red[5] + red[6] + red[7];
    const float rstd = rsqrtf(ss * (1.f / 2048.f) + 1e-6f);
    const float4 fw = *(const float4*)(p.final_norm + tid * 4);
    float4 y; y.x = x2.x * rstd * fw.x; y.y = x2.y * rstd * fw.y; y.z = x2.z * rstd * fw.z; y.w = x2.w * rstd * fw.w;
    float* dst = row < NP ? p.out + O_YP + (size_t)row * 2048 : p.out + O_YS + (size_t)(row - NP) * 2048;
    *(float4*)(dst + tid * 4) = y;
    __syncthreads();
}


constexpr int PK_SH = 0, PK_IH = 16384, PK_EID = 32768, PK_GATE = 40960, PK_KH = 49152, PK_KL = 83968;
__device__ __forceinline__ void split8(const float4& a, const float4& b, bf16x8& hi, bf16x8& lo) {
    hi = pack8(a.x, a.y, a.z, a.w, b.x, b.y, b.z, b.w);
    const u32x4 hb = __builtin_bit_cast(u32x4, hi);
    lo = pack8(a.x - __uint_as_float(hb[0] << 16), a.y - __uint_as_float(hb[0] & 0xffff0000u), a.z - __uint_as_float(hb[1] << 16), a.w - __uint_as_float(hb[1] & 0xffff0000u),
               b.x - __uint_as_float(hb[2] << 16), b.y - __uint_as_float(hb[2] & 0xffff0000u), b.z - __uint_as_float(hb[3] << 16), b.w - __uint_as_float(hb[3] & 0xffff0000u));
}
__device__ __forceinline__ float dot8(const u32x4& a, const u32x4& b, float acc) {
#pragma unroll
    for (int k = 0; k < 4; ++k) { const unsigned ak = a[k], bk = b[k];
        acc = __builtin_amdgcn_fdot2_f32_bf16(__builtin_bit_cast(bf2_t, ak), __builtin_bit_cast(bf2_t, bk), acc, false); }
    return acc;
}

#ifndef PEER_DBG
#define PEER_DBG 0
#endif
__device__ __forceinline__ void peer_topk_naive(const Params& p, int row, int tk, unsigned char* lds) {
    float* qs = (float*)(lds + 65536);
    float* ssc = qs + 2048;
    float* s_half = ssc + 2048;
    int* i_half = (int*)(s_half + 256);
    int* eidL = (int*)(lds + PK_EID); float* gateL = (float*)(lds + PK_GATE);
    const int tid = threadIdx.x, wave = tid >> 6, lane = tid & 63;
    for (int i = tid; i < 2048; i += NTHR) qs[i] = p.qp[(size_t)row * 2048 + i];
    __syncthreads();
    for (int i = 0; i < 4; ++i) { const int idx = tid + NTHR * i, hp = idx >> 7, k = idx & 127, half = hp & 1;
        const float* kr = p.peer_keys + ((size_t)half * 128 + k) * 128; const float* qq = qs + (hp >> 1) * 256 + half * 128;
        float acc = 0.f; for (int d = 0; d < 128; d += 4) { const float4 kv = *(const float4*)(kr + d); acc += qq[d] * kv.x + qq[d + 1] * kv.y + qq[d + 2] * kv.z + qq[d + 3] * kv.w; }
        ssc[idx] = acc; }
    __syncthreads();
    for (int li = 0; li < 2; ++li) { const int hp = wave * 2 + li;
        float v0 = ssc[hp * 128 + lane], v1 = ssc[hp * 128 + 64 + lane];
        for (int r = 0; r < 16; ++r) {
            float bv = v0; int bi = lane; if (v1 > bv) { bv = v1; bi = lane + 64; }
            for (int o = 32; o > 0; o >>= 1) { const float ov = __shfl_xor(bv, o); const int oi = __shfl_xor(bi, o); if (ov > bv || (ov == bv && oi < bi)) { bv = ov; bi = oi; } }
            if (lane == 0) { s_half[hp * 16 + r] = bv; i_half[hp * 16 + r] = bi; }
            if (bi == lane) v0 = -INFINITY; if (bi == lane + 64) v1 = -INFINITY;
        } }
    __syncthreads();
    { const int h = wave; float cv[4];
#pragma unroll
      for (int c = 0; c < 4; ++c) { const int f = lane + 64 * c; cv[c] = s_half[(h * 2) * 16 + (f >> 4)] + s_half[(h * 2 + 1) * 16 + (f & 15)]; }
      float bs_mine = 0.f; int e_mine = 0;
      for (int r = 0; r < 16; ++r) {
          float bv = cv[0]; int bi = lane;
#pragma unroll
          for (int c = 1; c < 4; ++c) if (cv[c] > bv) { bv = cv[c]; bi = lane + 64 * c; }
          for (int o = 32; o > 0; o >>= 1) { const float ov = __shfl_xor(bv, o); const int oi = __shfl_xor(bi, o); if (ov > bv || (ov == bv && oi < bi)) { bv = ov; bi = oi; } }
          if (lane == r) { bs_mine = bv; e_mine = i_half[(h * 2) * 16 + (bi >> 4)] * 128 + i_half[(h * 2 + 1) * 16 + (bi & 15)]; }
#pragma unroll
          for (int c = 0; c < 4; ++c) if (lane + 64 * c == bi) cv[c] = -INFINITY;
      }
      float mx = lane < 16 ? bs_mine : -INFINITY; mx = wave_max(mx);
      const float ex = lane < 16 ? __expf(bs_mine - mx) : 0.f; const float den = wave_sum(ex);
      if (lane < 16) { eidL[tk * 128 + h * 16 + lane] = e_mine; gateL[tk * 128 + h * 16 + lane] = ex / den; }
    }
    __syncthreads();
}
template <bool LATE>
__device__ __forceinline__ void ph9_peer_fast(const Params& p, int u, unsigned char* lds) {
    int tid = threadIdx.x; asm volatile("" : "+v"(tid));
    const int wave = tid >> 6, lane = tid & 63, r16 = lane & 15, quad = lane >> 4;
    float* sh = (float*)(lds + PK_SH); int* ih = (int*)(lds + PK_IH); int* eidL = (int*)(lds + PK_EID); float* gateL = (float*)(lds + PK_GATE);
    const int tok0 = u * 16;
#if PEER_DBG == 1
    for (int tk = 0; tk < 16; ++tk) peer_topk_naive(p, tok0 + tk < NTOK ? tok0 + tk : NTOK - 1, tk, lds);
#else
    {
        const int row = tok0 + r16 < NTOK ? tok0 + r16 : NTOK - 1, head = wave;
        const int lbase = (wave * 16 + r16) * 32;
#pragma unroll 1
        for (int half = 0; half < 2; ++half) {
            bf16x8 qh[4], ql[4];
            const float* qrow = p.qp + (size_t)row * 2048 + head * 256 + half * 128 + 8 * quad;
#pragma unroll
            for (int ks = 0; ks < 4; ++ks) split8(*(const float4*)(qrow + 32 * ks), *(const float4*)(qrow + 32 * ks + 4), qh[ks], ql[ks]);
            __syncthreads();
#pragma unroll
            for (int i = 0; i < 4; ++i) { const int id = tid + 512 * i, kr = id >> 4, part = id & 15; const size_t go = (size_t)(half * 128 + kr) * 128 + part * 8;
                *(u32x4*)(lds + PK_KH + kr * 272 + part * 16) = *(const u32x4*)(p.kh + go); *(u32x4*)(lds + PK_KL + kr * 272 + part * 16) = *(const u32x4*)(p.kl + go); }
            __syncthreads();
            f32x4 acc[8];
#pragma unroll
            for (int kb = 0; kb < 8; ++kb) { acc[kb] = (f32x4){0.f, 0.f, 0.f, 0.f};
                const int ko = (16 * kb + r16) * 272 + quad * 16;
                bf16x8 ahv[4], alv[4];
#pragma unroll
                for (int ks = 0; ks < 4; ++ks) { ahv[ks] = *(const bf16x8*)(lds + PK_KH + ko + 64 * ks); alv[ks] = *(const bf16x8*)(lds + PK_KL + ko + 64 * ks); }
#pragma unroll
                for (int ks = 0; ks < 4; ++ks) { acc[kb] = MFMA16(ahv[ks], qh[ks], acc[kb]); acc[kb] = MFMA16(ahv[ks], ql[ks], acc[kb]); acc[kb] = MFMA16(alv[ks], qh[ks], acc[kb]); } }
#pragma unroll 1
            for (int r = 0; r < 16; ++r) {
                float bv = acc[0][0]; int bi = 4 * quad;
#pragma unroll
                for (int kb = 0; kb < 8; ++kb)
#pragma unroll
                    for (int rg = 0; rg < 4; ++rg) if (acc[kb][rg] > bv) { bv = acc[kb][rg]; bi = 16 * kb + 4 * quad + rg; }
#pragma unroll
                for (int o = 16; o <= 32; o <<= 1) { const float ov = __shfl_xor(bv, o); const int oi = __shfl_xor(bi, o); if (ov > bv || (ov == bv && oi < bi)) { bv = ov; bi = oi; } }
                if (quad == 0) { sh[lbase + half * 16 + r] = bv; ih[lbase + half * 16 + r] = bi; }
#pragma unroll
                for (int kb = 0; kb < 8; ++kb)
#pragma unroll
                    for (int rg = 0; rg < 4; ++rg) if (bi == 16 * kb + 4 * quad + rg) acc[kb][rg] = -INFINITY;
            }
        }
        __syncthreads();
        float s0v[4], cur[4]; int ptr[4];
#pragma unroll
        for (int ii = 0; ii < 4; ++ii) { s0v[ii] = sh[lbase + 4 * quad + ii]; ptr[ii] = 0; cur[ii] = s0v[ii] + sh[lbase + 16]; }
        float bs[16]; int be[16];
#pragma unroll
        for (int r = 0; r < 16; ++r) {
            float bv = cur[0]; int bi = 4 * quad, bj = ptr[0];
#pragma unroll
            for (int ii = 1; ii < 4; ++ii) if (cur[ii] > bv) { bv = cur[ii]; bi = 4 * quad + ii; bj = ptr[ii]; }
#pragma unroll
            for (int o = 16; o <= 32; o <<= 1) { const float ov = __shfl_xor(bv, o); const int oi = __shfl_xor(bi, o), oj = __shfl_xor(bj, o); if (ov > bv || (ov == bv && oi < bi)) { bv = ov; bi = oi; bj = oj; } }
            bs[r] = bv; be[r] = ih[lbase + bi] * 128 + ih[lbase + 16 + bj];
#pragma unroll
            for (int ii = 0; ii < 4; ++ii) if (bi == 4 * quad + ii) { ptr[ii] += 1; cur[ii] = ptr[ii] < 16 ? s0v[ii] + sh[lbase + 16 + (ptr[ii] & 15)] : -INFINITY; }
        }
        float den = 0.f; const float bmax = bs[0];
#pragma unroll
        for (int r = 0; r < 16; ++r) { bs[r] = __expf(bs[r] - bmax); den += bs[r]; }
        const float dinv = 1.f / den;
        if (quad == 0) {
#pragma unroll
            for (int r = 0; r < 16; ++r) { eidL[r16 * 128 + head * 16 + r] = be[r]; gateL[r16 * 128 + head * 16 + r] = bs[r] * dinv; } }
        if (quad == 0 && tok0 + r16 < NTOK) {
#pragma unroll
            for (int r = 0; r < 16; ++r) { int* pe = p.pk_eid + (size_t)(tok0 + r16) * 128 + head * 16 + r; float* pg = p.pk_gate + (size_t)(tok0 + r16) * 128 + head * 16 + r;
                if (LATE) { __hip_atomic_store(pe, be[r], __ATOMIC_RELAXED, __HIP_MEMORY_SCOPE_AGENT); __hip_atomic_store(pg, bs[r] * dinv, __ATOMIC_RELAXED, __HIP_MEMORY_SCOPE_AGENT); }
                else { *pe = be[r]; *pg = bs[r] * dinv; } } }
    }
#endif
    __syncthreads();
}

__device__ __forceinline__ float dot16_fp8(const u32x4& q, const float* h, float acc) {
    f32x2 a2 = (f32x2){acc, 0.f};
#pragma unroll
    for (int k = 0; k < 4; ++k) { const int w = (int)q[k]; const f32x2 lo = __builtin_amdgcn_cvt_pk_f32_fp8(w, false), hi = __builtin_amdgcn_cvt_pk_f32_fp8(w, true);
        a2 = __builtin_elementwise_fma(lo, (f32x2){h[4 * k], h[4 * k + 1]}, a2); a2 = __builtin_elementwise_fma(hi, (f32x2){h[4 * k + 2], h[4 * k + 3]}, a2); }
    return a2[0] + a2[1];
}
__device__ __forceinline__ void axpy16_fp8(const u32x4& q, float w, float* o) {
    const f32x2 w2 = (f32x2){w, w};
#pragma unroll
    for (int k = 0; k < 4; ++k) { const int x = (int)q[k]; const f32x2 lo = __builtin_amdgcn_cvt_pk_f32_fp8(x, false), hi = __builtin_amdgcn_cvt_pk_f32_fp8(x, true);
        const f32x2 a = __builtin_elementwise_fma(w2, lo, (f32x2){o[4 * k], o[4 * k + 1]}), b = __builtin_elementwise_fma(w2, hi, (f32x2){o[4 * k + 2], o[4 * k + 3]});
        o[4 * k] = a[0]; o[4 * k + 1] = a[1]; o[4 * k + 2] = b[0]; o[4 * k + 3] = b[1]; }
}
__device__ __forceinline__ void ph10_token(const Params& p, int row, int lane) {
    asm volatile("" : "+v"(lane));
    float hv[32];
    { const float* hr = p.h2f + (size_t)row * 2048 + lane * 16;
#pragma unroll
      for (int c = 0; c < 2; ++c)
#pragma unroll
          for (int k = 0; k < 4; ++k) { const float4 t = *(const float4*)(hr + c * 1024 + 4 * k); hv[c * 16 + 4 * k] = t.x; hv[c * 16 + 4 * k + 1] = t.y; hv[c * 16 + 4 * k + 2] = t.z; hv[c * 16 + 4 * k + 3] = t.w; } }
    const int e_lo = p.pk_eid[(size_t)row * 128 + lane], e_hi = p.pk_eid[(size_t)row * 128 + 64 + lane];
    const float g_lo = p.pk_gate[(size_t)row * 128 + lane], g_hi = p.pk_gate[(size_t)row * 128 + 64 + lane];
    float w_lo = 0.f, w_hi = 0.f;
#pragma unroll 1
    for (int j0 = 0; j0 < 128; j0 += 8) {
        u32x4 uv[8][2]; float su[8];
#pragma unroll
        for (int jj = 0; jj < 8; ++jj) { const int j = j0 + jj; const int e = __shfl(j < 64 ? e_lo : e_hi, j & 63); const unsigned char* ur = p.u8 + (size_t)e * 2048 + lane * 16;
            uv[jj][0] = *(const u32x4*)ur; uv[jj][1] = *(const u32x4*)(ur + 1024); su[jj] = p.us[e]; }
#pragma unroll
        for (int jj = 0; jj < 8; ++jj) { const int j = j0 + jj; float d = dot16_fp8(uv[jj][0], hv, 0.f); d = dot16_fp8(uv[jj][1], hv + 16, d);
            d = wave_sum_sw(d) * su[jj];
            const float w = __shfl(j < 64 ? g_lo : g_hi, j & 63) * gelu_tanh(d);
            if (lane == (j & 63)) { if (j < 64) w_lo = w; else w_hi = w; }
            __builtin_amdgcn_sched_barrier(0); }
    }
    float out[32];
#pragma unroll
    for (int k = 0; k < 32; ++k) out[k] = 0.f;
#pragma unroll 1
    for (int j0 = 0; j0 < 128; j0 += 4) {
        u32x4 vv[4][2]; float sv[4];
#pragma unroll
        for (int jj = 0; jj < 4; ++jj) { const int j = j0 + jj; const int e = __shfl(j < 64 ? e_lo : e_hi, j & 63); const unsigned char* vr = p.v8 + (size_t)e * 2048 + lane * 16;
            vv[jj][0] = *(const u32x4*)vr; vv[jj][1] = *(const u32x4*)(vr + 1024); sv[jj] = p.vs[e]; }
#pragma unroll
        for (int jj = 0; jj < 4; ++jj) { const int j = j0 + jj; const float w = __shfl(j < 64 ? w_lo : w_hi, j & 63) * sv[jj];
            axpy16_fp8(vv[jj][0], w, out); axpy16_fp8(vv[jj][1], w, out + 16); __builtin_amdgcn_sched_barrier(0); }
    }
    asm volatile("" : "+s"(row));
    const int mrow = row < NP ? row / SEQ : 4 + (row - NP);
    const float* g2 = p.mod + (size_t)mrow * 12288 + 10240 + lane * 16; const float* x1 = p.x1 + (size_t)row * 2048 + lane * 16;
    float ss = 0.f;
#pragma unroll
    for (int c = 0; c < 2; ++c)
#pragma unroll
        for (int k = 0; k < 16; k += 4) { const float4 xv = *(const float4*)(x1 + c * 1024 + k), gv = *(const float4*)(g2 + c * 1024 + k); float* o = out + c * 16 + k;
            o[0] = xv.x + gv.x * o[0]; o[1] = xv.y + gv.y * o[1]; o[2] = xv.z + gv.z * o[2]; o[3] = xv.w + gv.w * o[3];
            ss += o[0] * o[0] + o[1] * o[1] + o[2] * o[2] + o[3] * o[3]; }
    ss = wave_sum_sw(ss);
    const float rstd = rsqrtf(ss * (1.f / 2048.f) + 1e-6f);
    float* dst = (row < NP ? p.out + O_YP + (size_t)row * 2048 : p.out + O_YS + (size_t)(row - NP) * 2048) + lane * 16;
#pragma unroll
    for (int c = 0; c < 2; ++c)
#pragma unroll
        for (int k = 0; k < 16; k += 4) { const float4 fw = *(const float4*)(p.final_norm + lane * 16 + c * 1024 + k); const float* o = out + c * 16 + k;
            float4 y; y.x = o[0] * rstd * fw.x; y.y = o[1] * rstd * fw.y; y.z = o[2] * rstd * fw.z; y.w = o[3] * rstd * fw.w;
            *(float4*)(dst + c * 1024 + k) = y; }
}
__device__ __forceinline__ void ph10_gather(const Params& p, unsigned qword) {
    const int lane = threadIdx.x & 63;
    for (;;) {
        unsigned coff = qword; asm volatile("" : "+v"(coff));
        unsigned t = 0; if (lane == 0) t = atomicAdd(p.bar + coff, 1u);
        t = (unsigned)__builtin_amdgcn_readfirstlane((int)t);
        if (t >= (unsigned)NTOK) break;
        ph10_token(p, (int)t, lane);
    }
}


template <int CTRL> __device__ __forceinline__ float dpp_add(float v) { return v + __int_as_float(__builtin_amdgcn_update_dpp(0, __float_as_int(v), CTRL, 0xf, 0xf, true)); }
template <int PAT> __device__ __forceinline__ float swz_add(float v) { return v + __int_as_float(__builtin_amdgcn_ds_swizzle(__float_as_int(v), PAT)); }
struct SlabIds { int e_lo, e_hi; };
constexpr int QW_FLAG = 3900;
template <int TBL>
__device__ __forceinline__ SlabIds slab_ids(const Params& p, int t, int lane) {
    SlabIds s;
    if (TBL == 0 && t >= NP && gridDim.x >= 16) {
        for (unsigned sp = 0; sp < (1u << 22); ++sp) { if (__builtin_amdgcn_readfirstlane((int)__hip_atomic_load(p.bar + QW_FLAG, __ATOMIC_RELAXED, __HIP_MEMORY_SCOPE_AGENT)) != 0) break; __builtin_amdgcn_s_sleep(8); }
        s.e_lo = __hip_atomic_load(p.pk_eid + (size_t)t * 128 + lane, __ATOMIC_RELAXED, __HIP_MEMORY_SCOPE_AGENT); s.e_hi = __hip_atomic_load(p.pk_eid + (size_t)t * 128 + 64 + lane, __ATOMIC_RELAXED, __HIP_MEMORY_SCOPE_AGENT);
    } else { s.e_lo = p.pk_eid[(size_t)t * 128 + lane]; s.e_hi = p.pk_eid[(size_t)t * 128 + 64 + lane]; }
    return s;
}
template <int TBL> struct SlabRows { u32x4 rv[16]; u32x4 hq[2]; float w0, w1; };
template <int TBL>
__device__ __forceinline__ void slab_issue(const Params& p, int t, int slab, int lane, const SlabIds& id, SlabRows<TBL>& r) {
    if (TBL == 0) {
        const int gq = lane >> 3, c8 = lane & 7, kq = lane >> 4;
        const unsigned char* tab = p.u8 + (size_t)slab * (16384 * 128) + c8 * 16;
#pragma unroll
        for (int k = 0; k < 16; ++k) { const int e = __shfl(k < 8 ? id.e_lo : id.e_hi, (8 * k + gq) & 63); r.rv[k] = *(const u32x4*)(tab + (size_t)e * 128); }
        const unsigned char* hp = p.h2q + (size_t)t * 2048 + slab * 128 + kq * 32;
        r.hq[0] = *(const u32x4*)hp; r.hq[1] = *(const u32x4*)(hp + 16);
    } else {
        const int gq = lane >> 3, c8 = lane & 7;
        const unsigned char* tab = p.v8 + (size_t)slab * (16384 * 128) + c8 * 16;
#pragma unroll
        for (int k = 0; k < 16; ++k) { const int e = __shfl(k < 8 ? id.e_lo : id.e_hi, (8 * k + gq) & 63); r.rv[k] = *(const u32x4*)(tab + (size_t)e * 128); }
        { const unsigned char* wp = p.wq + (size_t)t * 128 + (lane >> 4) * 8;
          const i32x2 a0 = *(const i32x2*)wp, a1 = *(const i32x2*)(wp + 32), a2 = *(const i32x2*)(wp + 64), a3 = *(const i32x2*)(wp + 96);
          r.hq[0] = (u32x4){(unsigned)a0[0], (unsigned)a0[1], (unsigned)a1[0], (unsigned)a1[1]}; r.hq[1] = (u32x4){(unsigned)a2[0], (unsigned)a2[1], (unsigned)a3[0], (unsigned)a3[1]}; r.w0 = p.wsc[t]; r.w1 = 0.f; }
    }
}
__device__ __forceinline__ long pk64(unsigned lo, unsigned hi) { return (long)(((unsigned long long)hi << 32) | (unsigned long long)lo); }
template <int TBL>
__device__ __forceinline__ void slab_compute(const Params& p, int t, int slab, int lane, const SlabRows<TBL>& r, unsigned char* lds_w) {
    if (TBL == 0) {
        const int r16 = lane & 15, kq = lane >> 4, gq = lane >> 3, c8 = lane & 7;
        unsigned char* stg = lds_w;
        const long b0 = pk64(r.hq[0][0], r.hq[0][1]), b1 = pk64(r.hq[0][2], r.hq[0][3]), b2 = pk64(r.hq[1][0], r.hq[1][1]), b3 = pk64(r.hq[1][2], r.hq[1][3]);
        f32x4 sel = (f32x4){0.f, 0.f, 0.f, 0.f};
#pragma unroll
        for (int hf = 0; hf < 2; ++hf) {
#pragma unroll
            for (int k = 0; k < 8; ++k) *(u32x4*)(stg + (8 * k + gq) * 144 + c8 * 16) = r.rv[8 * hf + k];
            asm volatile("s_waitcnt lgkmcnt(0)" ::: "memory");
#pragma unroll
            for (int g2 = 0; g2 < 4; ++g2) { const int g = 4 * hf + g2;
                const u32x4 a0 = *(const u32x4*)(stg + (16 * g2 + r16) * 144 + kq * 32), a1 = *(const u32x4*)(stg + (16 * g2 + r16) * 144 + kq * 32 + 16);
                f32x4 acc = (f32x4){0.f, 0.f, 0.f, 0.f};
                acc = __builtin_amdgcn_mfma_f32_16x16x32_fp8_fp8(pk64(a0[0], a0[1]), b0, acc, 0, 0, 0);
                acc = __builtin_amdgcn_mfma_f32_16x16x32_fp8_fp8(pk64(a0[2], a0[3]), b1, acc, 0, 0, 0);
                acc = __builtin_amdgcn_mfma_f32_16x16x32_fp8_fp8(pk64(a1[0], a1[1]), b2, acc, 0, 0, 0);
                acc = __builtin_amdgcn_mfma_f32_16x16x32_fp8_fp8(pk64(a1[2], a1[3]), b3, acc, 0, 0, 0);
                if (r16 == g) sel = acc; }
            asm volatile("s_waitcnt lgkmcnt(0)" ::: "memory");
        }
        if (r16 < 8) *(f32x4*)(p.pd + ((size_t)slab * NTOK + t) * 128 + 16 * r16 + 4 * kq) = sel;
    } else {
        const int i16 = lane & 15, kq = lane >> 4, gq = lane >> 3, c8 = lane & 7;
        unsigned char* stg = lds_w;
        f32x4 acc[8];
#pragma unroll
        for (int cb = 0; cb < 8; ++cb) acc[cb] = (f32x4){0.f, 0.f, 0.f, 0.f};
#pragma unroll
        for (int hf = 0; hf < 2; ++hf) {
#pragma unroll
            for (int k = 0; k < 8; ++k) *(u32x4*)(stg + (8 * k + gq) * 144 + c8 * 16) = r.rv[8 * hf + k];
            asm volatile("s_waitcnt lgkmcnt(0)" ::: "memory");
#pragma unroll
            for (int s2 = 0; s2 < 2; ++s2) { const int s = 2 * hf + s2;
                const long a = pk64(r.hq[s >> 1][2 * (s & 1)], r.hq[s >> 1][2 * (s & 1) + 1]);
                const unsigned char* tb = stg + (32 * s2 + 8 * kq + (i16 >> 1)) * 144 + 8 * (i16 & 1);
#pragma unroll
                for (int cb = 0; cb < 8; ++cb) { const i32x2 bq = __builtin_amdgcn_ds_read_tr8_b64_v2i32((LAS i32x2*)(tb + 16 * cb));
                    acc[cb] = __builtin_amdgcn_mfma_f32_16x16x32_fp8_fp8(a, pk64((unsigned)bq[0], (unsigned)bq[1]), acc[cb], 0, 0, 0); } }
            asm volatile("s_waitcnt lgkmcnt(0)" ::: "memory");
        }
        if (lane < 16) { float* dst = p.po + (size_t)t * 2048 + slab * 128 + lane;
#pragma unroll
            for (int cb = 0; cb < 8; ++cb) dst[16 * cb] = acc[cb][0] * r.w0; }
    }
}
template <int TBL>
__device__ __forceinline__ void peer_slab_phase(const Params& p, int bx, int G, unsigned char* lds, bool skip_last) {
    int lane = threadIdx.x & 63; asm volatile("" : "+v"(lane));
    const int wave = threadIdx.x >> 6;
    const int x = bx & 7, nblk = ((G - x + 7) >> 3) - ((skip_last && x == ((G - 1) & 7)) ? 1 : 0), w = (bx >> 3) * 8 + wave, nw = nblk * 8;
    const int cw = w < NTOK ? (NTOK - w + nw - 1) / nw : 0, n = 2 * cw;
#define ITEM_T(i) (w + ((i) % cw) * nw)
#define ITEM_S(i) (x + 8 * ((i) / cw))
    if (n == 0) return;
    SlabRows<TBL> A, B; SlabIds ia, ib;
    ia = slab_ids<TBL>(p, ITEM_T(0), lane);
    ib = slab_ids<TBL>(p, ITEM_T(n > 1 ? 1 : 0), lane);
    slab_issue<TBL>(p, ITEM_T(0), ITEM_S(0), lane, ia, A);
#pragma unroll 1
    for (int i = 0; i < n; i += 2) {
        const int i1 = i + 1 < n ? i + 1 : n - 1, i2 = i + 2 < n ? i + 2 : n - 1, i3 = i + 3 < n ? i + 3 : n - 1;
        ia = slab_ids<TBL>(p, ITEM_T(i2), lane);
        slab_issue<TBL>(p, ITEM_T(i1), ITEM_S(i1), lane, ib, B);
        slab_compute<TBL>(p, ITEM_T(i), ITEM_S(i), lane, A, lds + wave * 9216);
        ib = slab_ids<TBL>(p, ITEM_T(i3), lane);
        slab_issue<TBL>(p, ITEM_T(i2), ITEM_S(i2), lane, ia, A);
        if (i + 1 < n) slab_compute<TBL>(p, ITEM_T(i1), ITEM_S(i1), lane, B, lds + wave * 9216);
    }
#undef ITEM_T
#undef ITEM_S
}
__device__ __forceinline__ void peer_w_phase(const Params& p, int bx, int G) {
    const int lane = threadIdx.x & 63, gw = bx * 8 + (threadIdx.x >> 6);
#pragma unroll 1
    for (int t = gw; t < NTOK; t += G * 8) {
        float wv[2];
#pragma unroll
        for (int hh = 0; hh < 2; ++hh) { const int pi = lane + 64 * hh; float d = 0.f;
#pragma unroll
            for (int s = 0; s < 16; ++s) d += p.pd[((size_t)s * NTOK + t) * 128 + pi];
            const int e = p.pk_eid[(size_t)t * 128 + pi];
            wv[hh] = p.pk_gate[(size_t)t * 128 + pi] * gelu_tanh(d * p.us[e]) * p.vs[e]; }
        const float am = wave_max(fmaxf(fabsf(wv[0]), fabsf(wv[1])));
        const float sc = am > 0.f ? am * (1.f / 440.f) : 1.f, inv = 1.f / sc;
        const int pk = __builtin_amdgcn_cvt_pk_fp8_f32(wv[0] * inv, wv[1] * inv, 0, false);
        p.wq[(size_t)t * 128 + lane] = (unsigned char)(pk & 0xff); p.wq[(size_t)t * 128 + 64 + lane] = (unsigned char)((pk >> 8) & 0xff);
        if (lane == 0) p.wsc[t] = sc;
    }
}
__device__ __forceinline__ void peer_final_phase(const Params& p, int bx, int G) {
    const int lane = threadIdx.x & 63, gw = bx * 8 + (threadIdx.x >> 6);
#pragma unroll 1
    for (int row = gw; row < NTOK; row += G * 8) {
        const int mrow = row < NP ? row / SEQ : 4 + (row - NP);
        const float* g2 = p.mod + (size_t)mrow * 12288 + 10240 + lane * 16; const float* x1 = p.x1 + (size_t)row * 2048 + lane * 16; const float* po = p.po + (size_t)row * 2048 + lane * 16;
        float out[32]; float ss = 0.f;
#pragma unroll
        for (int c = 0; c < 2; ++c)
#pragma unroll
            for (int k = 0; k < 16; k += 4) { const float4 xv = *(const float4*)(x1 + c * 1024 + k), gv = *(const float4*)(g2 + c * 1024 + k), ov = *(const float4*)(po + c * 1024 + k); float* o = out + c * 16 + k;
                o[0] = xv.x + gv.x * ov.x; o[1] = xv.y + gv.y * ov.y; o[2] = xv.z + gv.z * ov.z; o[3] = xv.w + gv.w * ov.w;
                ss += o[0] * o[0] + o[1] * o[1] + o[2] * o[2] + o[3] * o[3]; }
        ss = wave_sum_sw(ss);
        const float rstd = rsqrtf(ss * (1.f / 2048.f) + 1e-6f);
        float* dst = (row < NP ? p.out + O_YP + (size_t)row * 2048 : p.out + O_YS + (size_t)(row - NP) * 2048) + lane * 16;
#pragma unroll
        for (int c = 0; c < 2; ++c)
#pragma unroll
            for (int k = 0; k < 16; k += 4) { const float4 fw = *(const float4*)(p.final_norm + lane * 16 + c * 1024 + k); const float* o = out + c * 16 + k;
                float4 y; y.x = o[0] * rstd * fw.x; y.y = o[1] * rstd * fw.y; y.z = o[2] * rstd * fw.z; y.w = o[3] * rstd * fw.w;
                *(float4*)(dst + c * 1024 + k) = y; }
    }
}


constexpr int NF_T = 1024, NF_W = 64, NFILL = NF_W + 2 * NF_T + 2 * 2048, QW_HEAD = 3700, QW_DONE = 3800;
__device__ __forceinline__ void filler_unit(const Params& p, int f, unsigned char* lds) {
    if (f < NF_W) {
        const int b = f >> 3, j0 = (f & 7) * 64;
#pragma unroll
        for (int i = 0; i < 16; ++i) { const int idx = threadIdx.x + NTHR * i, j = j0 + (idx >> 7), c = (idx & 127) * 4;
            if (j < 511) *(float4*)(p.out + O_WKS + ((size_t)b * 512 + j) * 512 + c) = *(const float4*)(p.state_win + ((size_t)b * 512 + j + 1) * 512 + c); }
        return; }
    f -= NF_W;
    if (f < NF_T) ph0_transpose(p.w_out, p.wt_out, 2048, 32, f, (float*)lds);
    else if (f < 2 * NF_T) ph0_transpose(p.peer_wq, p.wt_q, 2048, 32, f - NF_T, (float*)lds);
    else if (f < 2 * NF_T + 2048) ph0_fp8(p.peer_u, p.u8, p.us, f - 2 * NF_T);
    else ph0_fp8(p.peer_v, p.v8, p.vs, f - 2 * NF_T - 2048);
}
template <bool DRAIN>
__device__ __forceinline__ void filler_bg(const Params& p, unsigned char* lds, int phase, int G) {
    volatile int* w = (volatile int*)(lds + LDS_BYTES - 64);
    __syncthreads();
    if (!DRAIN && threadIdx.x == 0) __hip_atomic_fetch_add(p.bar + QW_DONE + phase, 1u, __ATOMIC_RELAXED, __HIP_MEMORY_SCOPE_AGENT);
    for (;;) {
        if (threadIdx.x == 0) {
            int f = NFILL;
            const bool others_busy = DRAIN || __hip_atomic_load(p.bar + QW_DONE + phase, __ATOMIC_RELAXED, __HIP_MEMORY_SCOPE_AGENT) < (unsigned)G;
            if (others_busy) f = (int)__hip_atomic_fetch_add(p.bar + QW_HEAD, 1u, __ATOMIC_RELAXED, __HIP_MEMORY_SCOPE_AGENT);
            w[0] = f;
        }
        __syncthreads();
        const int f = w[0];
        __syncthreads();
        if (f >= NFILL) break;
        filler_unit(p, f, lds);
    }
}
#ifndef PROBE_DBL
#define PROBE_DBL 0
#endif
#ifndef PROBE_SUB
#define PROBE_SUB 0
#endif
#define PHASE_FN(k) __device__ __forceinline__ void phase##k(const Params& p, unsigned char* lds, const int bx, const int G, const int rep)
PHASE_FN(0) {
    float* smem = (float*)lds;
    constexpr int NA = 192, NT_IN = 32 * (INCP / 64), NC = 2 * 128 + 2 * 4, NK = 8, NTOT = NA + NT_IN + NC + NK;
    volatile int* qw = (volatile int*)(lds + LDS_BYTES - 64);
    const unsigned qhead = QW_HEAD + 32 + (unsigned)rep;
    for (;;) {
        __syncthreads();
        if (threadIdx.x == 0) qw[0] = (int)__hip_atomic_fetch_add(p.bar + qhead, 1u, __ATOMIC_RELAXED, __HIP_MEMORY_SCOPE_AGENT);
        __syncthreads();
        int u = qw[0];
        if (u >= NTOT) break;
        if (u < NA) { ph0_adaln(p, u, smem); continue; }
        u -= NA;
        if (u < NT_IN) { ph0_transpose(p.w_in, p.wt_in, INC, INCP / 64, u, smem); continue; }
        u -= NT_IN;
        if (u < NC) {
            if (u < 256) { const int s = u >> 7; ph0_transpose(p.cmp_w1 + (size_t)s * 4096 * 128, p.w1t + (size_t)s * 128 * 4096, 128, 2, u & 127, smem, 4096); }
            else { const int s = (u - 256) >> 2; ph0_transpose(p.cmp_w2 + (size_t)s * 128 * 128, p.w2t + (size_t)s * 128 * 128, 128, 2, (u - 256) & 3, smem, 128); }
            continue; }
        ph0_keys(p, u - NC);
    }
}
PHASE_FN(1) { for (int u = bx; u < MPAD / 8; u += G) norm_row<0>(p, u * 8 + (threadIdx.x >> 6)); }
PHASE_FN(2) {
    constexpr int MT = NP / 256, NG1 = MT * (INCP / 256);
    float* C = p.P; float* out = p.out; bf16_t* Qb = p.Qb; bf16_t* KVb = p.KVb;
    auto epiP = [C](int r, int c, float v) { __builtin_nontemporal_store(v, C + (size_t)r * INCP + c); };
    auto epiA = [Qb](int r, int c, float v) { Qb[(size_t)r * 1024 + c] = f2bf(v); };
    auto epiB = [out](int r, int c, float v) { out[O_CKP + (size_t)r * 512 + (c - C_KVC)] = v; };
    auto epiC = [out, KVb](int r, int c, float v) { out[O_SKP + (size_t)r * 512 + (c - C_KVS)] = v; KVb[(size_t)r * 1024 + (c - C_KVS)] = f2bf(v); };
    auto epiD = [out, KVb](int r, int c, float v) { KVb[(size_t)r * 1024 + (c - C_KVS)] = f2bf(v); const int t = r & (SEQ - 1);
        if (t >= SEQ - 512) out[O_WKP + ((size_t)(r >> 11) * 512 + (t - (SEQ - 512))) * 512 + (c - C_KVW)] = v; };
    volatile int* qw = (volatile int*)(lds + LDS_BYTES - 64);
    const unsigned qhead = QW_HEAD + 64 + (unsigned)rep * 64;
    for (;;) {
        __syncthreads();
        if (threadIdx.x == 0) qw[0] = (int)__hip_atomic_fetch_add(p.bar + qhead, 1u, __ATOMIC_RELAXED, __HIP_MEMORY_SCOPE_AGENT);
        __syncthreads();
        const int q = qw[0];
        if (q >= 128 + NG1 + INCP / 64) break;
        if (q < 128) cmp_tile<true>(p, q >> 1, q & 1, lds);
        else if (q < 128 + NG1) { const int g = q - 128, pn = g / MT, pm = g % MT;
            if (pn < 4) gemm_tile(p.h1, p.wt_in, 2048, pm * 256, pn * 256, (bf16_t*)lds, epiA);
            else if (pn < 6) gemm_tile(p.h1, p.wt_in, 2048, pm * 256, pn * 256, (bf16_t*)lds, epiB);
            else if (pn < 8) gemm_tile(p.h1, p.wt_in, 2048, pm * 256, pn * 256, (bf16_t*)lds, epiC);
            else if (pn < 10) gemm_tile(p.h1, p.wt_in, 2048, pm * 256, pn * 256, (bf16_t*)lds, epiD);
            else gemm_tile(p.h1, p.wt_in, 2048, pm * 256, pn * 256, (bf16_t*)lds, epiP); }
        else gemm_rows8<4>(p.h1 + (size_t)NP * 2048, p.wt_in, q - 128 - NG1, lds, epiP);
    }
    if (rep == 0) filler_bg<false>(p, lds, 2, G);
}
PHASE_FN(3) {
    float* smem = (float*)lds;
    constexpr int NQ3 = 8 + 1024 + NSB + NSB + NB * 3;
    volatile int* qw = (volatile int*)(lds + LDS_BYTES - 64);
    const unsigned qhead = QW_HEAD + 40 + (unsigned)rep;
    for (;;) {
        __syncthreads();
        if (threadIdx.x == 0) qw[0] = (int)__hip_atomic_fetch_add(p.bar + qhead, 1u, __ATOMIC_RELAXED, __HIP_MEMORY_SCOPE_AGENT);
        __syncthreads();
        int u = qw[0];
        if (u >= NQ3) break;
        if (u < 8) { cmp_tile<false>(p, u >> 1, u & 1, lds); continue; }
        u -= 8;
        if (u < 1024) { ph3_gdnA(p, u, lds); if (PROBE_SUB & 1) ph3_gdnA(p, u, lds); continue; }
        u -= 1024;
        if (u < NSB) { ph3_gdnprep(p, NP + u, smem); continue; }
        ph3_scatter(p, u - NSB);
    }
    if (rep == 0) filler_bg<false>(p, lds, 3, G);
}
PHASE_FN(4) {
    float* smem = (float*)lds;
    if (G >= 128) {
        if (bx < 64) { ph4_gdnB(p, bx, lds); if (PROBE_SUB & 8) ph4_gdnB(p, bx, lds); ph4_gdn(p, 32 + bx, smem); }
        else if (bx < 80) { ph4_nsa_sample(p, bx - 64, lds); if (PROBE_SUB & 32) ph4_nsa_sample(p, bx - 64, lds); }
        else { const int NB = G - 80, k = bx - 80;
            for (int pass = 0; pass * NB < 256; ++pass) { const int u = pass * NB + ((pass & 1) ? NB - 1 - k : k); if (u < 256) { ph4_nsa_fast(p, u, lds); if (PROBE_SUB & 16) ph4_nsa_fast(p, u, lds); } }
        }
    } else {
        for (int u = bx; u < 64; u += G) ph4_gdnB(p, u, lds);
        for (int u = 32 + bx; u < 96; u += G) ph4_gdn(p, u, smem);
        for (int u = bx; u < 256; u += G) ph4_nsa_fast(p, u, lds);
        for (int u = bx; u < 2 * NSB; u += G) ph4_nsa_sample(p, u, lds);
    }
    if (rep == 0) filler_bg<false>(p, lds, 4, G);
}
PHASE_FN(5) { for (int u = bx; u < 1024; u += G) ph5_gdnC(p, u, lds); for (int u = bx; u < NSB; u += G) ph5_gdnout(p, NP + u); if (rep == 0) filler_bg<true>(p, lds, 5, G); }
PHASE_FN(6) {
    float* C = p.acc2;
    auto epi = [C](int r, int c, float v) { C[(size_t)r * 2048 + c] = v; };
    constexpr int MT = NP / 256;
    for (int u = bx; u < MT * 8; u += G) { const int pn = u / MT, pm = u % MT; gemm_tile(p.amix, p.wt_out, 2048, pm * 256, pn * 256, (bf16_t*)lds, epi); }
    for (int c = bx; c < 128; c += G) gemm_rows8<1>(p.amix + (size_t)NP * 2048, p.wt_out, c, lds, epi);
}
PHASE_FN(7) { for (int u = bx; u < MPAD / 8; u += G) norm_row<1>(p, u * 8 + (threadIdx.x >> 6)); }
PHASE_FN(8) {
    float* C = p.qp;
    auto epi = [C](int r, int c, float v) { C[(size_t)r * 2048 + c] = v; };
    constexpr int MT = NP / 256;
    for (int u = bx; u < MT * 8; u += G) { const int pn = u / MT, pm = u % MT; gemm_tile(p.h2, p.wt_q, 2048, pm * 256, pn * 256, (bf16_t*)lds, epi); }
    for (int c = bx; c < 128; c += G) gemm_rows8<1>(p.h2 + (size_t)NP * 2048, p.wt_q, c, lds, epi);
}
PHASE_FN(9) { for (int u = bx; u < NP / 16 + ((G < 16) ? 1 : 0); u += G) ph9_peer_fast<false>(p, u, lds); }
PHASE_FN(10) {
    if (G >= 16 && bx == G - 1) {
        ph9_peer_fast<true>(p, NP / 16, lds);
        asm volatile("s_waitcnt vmcnt(0)" ::: "memory");
        __syncthreads();
        if (threadIdx.x == 0) __hip_atomic_store(p.bar + QW_FLAG, 1u, __ATOMIC_RELAXED, __HIP_MEMORY_SCOPE_AGENT);
    } else peer_slab_phase<0>(p, bx, G, lds, G >= 16);
}
PHASE_FN(11) { peer_w_phase(p, bx, G); }
PHASE_FN(12) { peer_slab_phase<1>(p, bx, G, lds, false); }
PHASE_FN(13) { peer_final_phase(p, bx, G); }

__global__ void __launch_bounds__(NTHR, 2) fwd(Params p) {
    extern __shared__ __attribute__((aligned(16))) unsigned char lds[];
    LAS unsigned* xbw = (LAS unsigned*)(lds + LDS_BYTES - 16);
    const int tid = threadIdx.x, G = gridDim.x, bx = blockIdx.x;
    if (tid < 4) xbw[tid] = 0u;
    __syncthreads();
    XcdBarrier bar; bar.bar = p.bar; bar.x = 0; bar.st = nullptr;
    const int lo = p.ph_lo, hi = p.ph_hi;
    if (hi - lo > 1) bar = xcd_barrier_post(p.bar, (volatile LAS unsigned*)xbw);
#define IN(k) (lo <= (k) && (k) < hi)
#ifndef PROBE_BAR
#define PROBE_BAR 0
#endif
#define SEAM(k) do { if (IN(k) && IN((k) + 1)) { xcd_barrier(bar); if (PROBE_BAR) xcd_barrier(bar); } } while (0)
#define RUN(k) do { if (IN(k)) { phase##k(p, lds, bx, G, 0); if ((PROBE_DBL >> (k)) & 1) { __syncthreads(); phase##k(p, lds, bx, G, 1); } } } while (0)
    RUN(0); SEAM(0);
    RUN(1); SEAM(1);
    RUN(2); SEAM(2);
    RUN(3); SEAM(3);
    RUN(4); SEAM(4);
    RUN(5); SEAM(5);
    RUN(6); SEAM(6);
    RUN(7); SEAM(7);
    RUN(8); SEAM(8);
    RUN(9); SEAM(9);
    RUN(10); SEAM(10);
    RUN(11); SEAM(11);
    RUN(12); SEAM(12);
    RUN(13);
}

extern "C" void kernel_launch(void* const* d_in, const int* in_sizes, int n_in, void* d_out, int out_size, void* d_ws, size_t ws_size, hipStream_t stream) {
    static int grid = 0;
    if (grid == 0) {
        int dev = 0, cus = 0;
        if (hipGetDevice(&dev) != hipSuccess || hipDeviceGetAttribute(&cus, hipDeviceAttributeMultiprocessorCount, dev) != hipSuccess) { fprintf(stderr, "kernel_launch: device query failed\n"); grid = -1; return; }
        if (hipFuncSetAttribute((const void*)fwd, hipFuncAttributeMaxDynamicSharedMemorySize, LDS_BYTES) != hipSuccess) { fprintf(stderr, "kernel_launch: hipFuncSetAttribute failed\n"); grid = -1; return; }
        int per_cu = 0;
        if (hipOccupancyMaxActiveBlocksPerMultiprocessor(&per_cu, (const void*)fwd, NTHR, LDS_BYTES) != hipSuccess || per_cu < 1) fprintf(stderr, "kernel_launch: occupancy query says %d\n", per_cu);
        (void)hipGetLastError();
        grid = cus;
    }
    if (grid < 0) return;
    Params p{};
    p.x_prompt = (const float*)d_in[0]; p.x_sample = (const float*)d_in[1]; p.cache_cmp = (const float*)d_in[2]; p.cache_sel = (const float*)d_in[3];
    p.state_win = (const float*)d_in[4]; p.state_conv = (const float*)d_in[5]; p.state_gdn = (const float*)d_in[6]; p.page_table = (const int*)d_in[7];
    p.c_prompt = (const float*)d_in[8]; p.c_sample = (const float*)d_in[9]; p.w_ada = (const float*)d_in[10]; p.b_ada = (const float*)d_in[11];
    p.norm_mix = (const float*)d_in[12]; p.norm_ffn = (const float*)d_in[13]; p.w_in = (const float*)d_in[14]; p.cmp_pe = (const float*)d_in[15];
    p.cmp_w1 = (const float*)d_in[16]; p.cmp_b1 = (const float*)d_in[17]; p.cmp_w2 = (const float*)d_in[18]; p.conv_w = (const float*)d_in[19];
    p.a_log = (const float*)d_in[20]; p.dt_bias = (const float*)d_in[21]; p.gdn_norm = (const float*)d_in[22]; p.w_out = (const float*)d_in[23];
    p.peer_wq = (const float*)d_in[24]; p.peer_keys = (const float*)d_in[25]; p.peer_u = (const float*)d_in[26]; p.peer_v = (const float*)d_in[27];
    p.final_norm = (const float*)d_in[28];
    p.out = (float*)d_out;
    unsigned char* ws = (unsigned char*)d_ws; size_t off = 0;
    auto take = [&](size_t bytes) { unsigned char* r = ws + off; off += (bytes + 255) & ~(size_t)255; return r; };
    p.bar = (unsigned*)take(16384);
    p.mod = (float*)take((size_t)12 * 12288 * 4);
    p.h1 = (bf16_t*)take((size_t)MPAD * 2048 * 2);
    p.wt_in = (bf16_t*)take((size_t)INCP * 2048 * 2);
    p.wt_out = (bf16_t*)take((size_t)2048 * 2048 * 2);
    p.wt_q = (bf16_t*)take((size_t)2048 * 2048 * 2);
    p.P = (float*)take((size_t)MPAD * INCP * 4);
    p.ckv_p = (float*)take((size_t)4 * 64 * 4 * 128 * 4);
    p.ckv_s = (float*)take((size_t)8 * 512 * 4 * 128 * 4);
    p.qkvn = (float*)take((size_t)NTOK * 3072 * 4);
    p.gbeta = (float*)take((size_t)NTOK * 8 * 4);
    p.gg = (float*)take((size_t)NTOK * 8 * 4);
    p.ograw = (float*)take((size_t)NTOK * 1024 * 4);
    p.amix = (bf16_t*)take((size_t)MPAD * 2048 * 2);
    p.acc2 = (float*)take((size_t)MPAD * 2048 * 4);
    p.x1 = (float*)take((size_t)NTOK * 2048 * 4);
    p.h2f = (float*)take((size_t)NTOK * 2048 * 4);
    p.h2 = (bf16_t*)take((size_t)MPAD * 2048 * 2);
    p.qp = (float*)take((size_t)MPAD * 2048 * 4);
    p.Qb = (bf16_t*)take((size_t)MPAD * 1024 * 2);
    p.gN = (bf16_t*)take((size_t)1024 * 16384 * 2); p.gBT = (bf16_t*)take((size_t)1024 * 16384 * 2); p.gQp = (bf16_t*)take((size_t)1024 * 8192 * 2);
    p.u8 = (unsigned char*)take((size_t)16384 * 2048); p.v8 = (unsigned char*)take((size_t)16384 * 2048); p.us = (float*)take(65536); p.vs = (float*)take(65536);
    p.pk_eid = (int*)take((size_t)NTOK * 128 * 4); p.pk_gate = (float*)take((size_t)NTOK * 128 * 4);
    p.pd = (float*)take((size_t)16 * NTOK * 128 * 4); p.wv = (float*)take((size_t)NTOK * 128 * 4); p.h2q = (unsigned char*)take((size_t)NTOK * 2048); p.po = (float*)take((size_t)NTOK * 2048 * 4); p.wq = (unsigned char*)take((size_t)NTOK * 128); p.wsc = (float*)take((size_t)NTOK * 4); p.kh = (bf16_t*)take(65536); p.kl = (bf16_t*)take(65536); p.w1t = (bf16_t*)take((size_t)2 * 128 * 4096 * 2); p.w2t = (bf16_t*)take((size_t)2 * 128 * 128 * 2);
    p.gOpT = (bf16_t*)take((size_t)1024 * 8192 * 2); p.gST = (bf16_t*)take((size_t)1024 * 16384 * 2); p.ggl = (float*)take(4096);
    p.KVb = (bf16_t*)take((size_t)MPAD * 1024 * 2);
    if (off > ws_size) { fprintf(stderr, "kernel_launch: workspace too small (%zu > %zu)\n", off, ws_size); return; }
    (void)hipMemsetAsync(p.bar, 0, 16384, stream);
    if (N_LAUNCHES == 1) { p.ph_lo = 0; p.ph_hi = NPH; hipLaunchKernelGGL(fwd, dim3(grid), dim3(NTHR), LDS_BYTES, stream, p); }
    else for (int li = 0; li < NPH; ++li) { p.ph_lo = li; p.ph_hi = li + 1; hipLaunchKernelGGL(fwd, dim3(grid), dim3(NTHR), LDS_BYTES, stream, p); }
    const hipError_t le = hipPeekAtLastError();
    if (le != hipSuccess) fprintf(stderr, "kernel_launch: launch failed: %s\n", hipGetErrorName(le));
}
```

```cpp
#include <hip/hip_runtime.h>
#include <stdint.h>
#include <stdio.h>

#ifndef N_LAUNCHES
#define N_LAUNCHES 1
#endif

typedef unsigned short bf16_t;
typedef short bf16x8 __attribute__((ext_vector_type(8)));
typedef float f32x4 __attribute__((ext_vector_type(4)));
typedef float f32x16 __attribute__((ext_vector_type(16)));
typedef unsigned u32x4 __attribute__((ext_vector_type(4)));
typedef unsigned u32x2 __attribute__((ext_vector_type(2)));
typedef __bf16 bf2_t __attribute__((ext_vector_type(2)));
typedef float f32x2 __attribute__((ext_vector_type(2)));
typedef int i32x2 __attribute__((ext_vector_type(2)));
#define MFMA32(a, b, c) __builtin_amdgcn_mfma_f32_32x32x16_bf16((a), (b), (c), 0, 0, 0)
#define MFMA16(a, b, c) __builtin_amdgcn_mfma_f32_16x16x32_bf16((a), (b), (c), 0, 0, 0)

constexpr int DM = 2048, SEQ = 2048, NB = 4, NSB = 8;
constexpr int NP = NB * SEQ;
constexpr int NTOK = NP + NSB;
constexpr int MPAD = 8448;
constexpr int INC = 6696, INCP = 6912;
constexpr int C_Q = 0, C_KVC = 1024, C_KVS = 1536, C_KVW = 2048, C_GTS = 2560, C_QKV = 2584, C_Z = 5656, C_BL = 6680, C_AL = 6688;
constexpr int PAST = 16384, NPAGES = 128;
constexpr int NPH = 14;
constexpr int LDS_BYTES = 147456;
constexpr int NTHR = 512;

struct Params {
    const float *x_prompt, *x_sample, *cache_cmp, *cache_sel, *state_win, *state_conv, *state_gdn;
    const int* page_table;
    const float *c_prompt, *c_sample, *w_ada, *b_ada, *norm_mix, *norm_ffn, *w_in, *cmp_pe, *cmp_w1, *cmp_b1, *cmp_w2,
        *conv_w, *a_log, *dt_bias, *gdn_norm, *w_out, *peer_wq, *peer_keys, *peer_u, *peer_v, *final_norm;
    float* out;
    unsigned* bar;
    float* mod;
    bf16_t* h1;
    bf16_t* wt_in;
    bf16_t* wt_out;
    bf16_t* wt_q;
    float* P;
    float* ckv_p;
    float* ckv_s;
    float* qkvn;
    float* gbeta;
    float* gg;
    float* ograw;
    bf16_t* amix;
    float* acc2;
    float* x1;
    float* h2f;
    bf16_t* h2;
    float* qp;
    bf16_t* Qb;
    bf16_t* gN;
    bf16_t* gBT;
    bf16_t* gQp;
    bf16_t* gOpT;
    bf16_t* gST;
    float* ggl;
    unsigned char* u8;
    unsigned char* v8;
    float* us;
    float* vs;
    int* pk_eid;
    float* pk_gate;
    float* pd;
    unsigned char* h2q;
    float* wv;
    float* po;
    unsigned char* wq;
    float* wsc;
    bf16_t* kh;
    bf16_t* kl;
    bf16_t* w1t;
    bf16_t* w2t;
    bf16_t* KVb;
    int ph_lo, ph_hi;
};

constexpr size_t O_YP = 0, O_YS = O_YP + (size_t)NP * DM, O_CKP = O_YS + (size_t)NSB * DM, O_CKS = O_CKP + (size_t)NP * 512,
                 O_SKP = O_CKS + NSB * 512, O_SKS = O_SKP + (size_t)NP * 512, O_WKP = O_SKS + NSB * 512, O_WKS = O_WKP + (size_t)NB * 512 * 512,
                 O_CVP = O_WKS + (size_t)NSB * 512 * 512, O_CVS = O_CVP + NB * 3 * 3072, O_GP = O_CVS + NSB * 3 * 3072,
                 O_GS = O_GP + (size_t)NB * 8 * 128 * 128, O_END = O_GS + (size_t)NSB * 8 * 128 * 128;

__device__ __forceinline__ bf16_t f2bf(float f) { unsigned u = __float_as_uint(f); u += 0x7fffu + ((u >> 16) & 1u); return (bf16_t)(u >> 16); }
__device__ __forceinline__ unsigned pk2(float a, float b) { return (unsigned)f2bf(a) | ((unsigned)f2bf(b) << 16); }
__device__ __forceinline__ float wave_sum(float v) { for (int o = 32; o > 0; o >>= 1) v += __shfl_xor(v, o); return v; }
__device__ __forceinline__ float wave_sum_sw(float v) {
    v += __int_as_float(__builtin_amdgcn_ds_swizzle(__float_as_int(v), (1 << 10) | 0x1f));
    v += __int_as_float(__builtin_amdgcn_ds_swizzle(__float_as_int(v), (2 << 10) | 0x1f));
    v += __int_as_float(__builtin_amdgcn_ds_swizzle(__float_as_int(v), (4 << 10) | 0x1f));
    v += __int_as_float(__builtin_amdgcn_ds_swizzle(__float_as_int(v), (8 << 10) | 0x1f));
    v += __int_as_float(__builtin_amdgcn_ds_swizzle(__float_as_int(v), (16 << 10) | 0x1f));
    const auto rr = __builtin_amdgcn_permlane32_swap(__float_as_uint(v), __float_as_uint(v), false, false);
    return __uint_as_float(rr[0]) + __uint_as_float(rr[1]);
}
__device__ __forceinline__ float wave_max(float v) { for (int o = 32; o > 0; o >>= 1) v = fmaxf(v, __shfl_xor(v, o)); return v; }
__device__ __forceinline__ float silu_f(float x) { return x / (1.f + __expf(-x)); }
__device__ __forceinline__ float sigmoid_f(float x) { return 1.f / (1.f + __expf(-x)); }
__device__ __forceinline__ float gelu_tanh(float x) { return 0.5f * x * (1.f + tanhf(0.7978845608028654f * (x + 0.044715f * x * x * x))); }
__device__ __forceinline__ float softplus_f(float x) { return x > 20.f ? x : log1pf(__expf(x)); }

#define XB_TMO      128
#define XB_XCNT(j)  (256  + 64 * (j))
#define XB_XSUB(j)  (1280 + 64 * (j))
#define XB_XGEN(j)  (2304 + 64 * (j))
#define XB_TOP      3328
#define XB_TOPGEN   3392
#define XCD_BAR_WORDS 3456
#define XB_SPIN_CAP (1u << 18)
#define LAS __attribute__((address_space(3)))
__device__ __forceinline__ unsigned xb_ld(unsigned* p)              { return __hip_atomic_load(p, __ATOMIC_RELAXED, __HIP_MEMORY_SCOPE_AGENT); }
__device__ __forceinline__ unsigned xb_add(unsigned* p, unsigned v) { return __hip_atomic_fetch_add(p, v, __ATOMIC_RELAXED, __HIP_MEMORY_SCOPE_AGENT); }
__device__ __forceinline__ unsigned xb_xcc_id() { return (unsigned)__builtin_amdgcn_s_getreg((3 << 11) | 20) & 0xFu; }
#define XB_SPIN(cond, bar) do { unsigned _sp = 0; while (cond) { __builtin_amdgcn_s_sleep(1); \
    if ((++_sp & 255u) == 0u) { if (xb_ld(&(bar)[XB_TMO])) break; if (_sp > XB_SPIN_CAP) { atomicAdd(&(bar)[XB_TMO], 1u); break; } } } } while (0)
struct XcdBarrier { unsigned* bar; unsigned x; volatile LAS unsigned* st; };
__device__ __forceinline__ XcdBarrier xcd_barrier_post(unsigned* bar, volatile LAS unsigned* st) {
    XcdBarrier b; b.bar = bar; b.x = xb_xcc_id(); b.st = st;
    if (threadIdx.x == 0) (void)xb_add(&bar[XB_XCNT(b.x)], 1u);
    return b;
}
__device__ __forceinline__ void xcd_barrier_complete(unsigned* bar, unsigned x, unsigned& nloc, unsigned& nx) {
    const unsigned G = gridDim.x * gridDim.y * gridDim.z;
    unsigned sum, cnt, mine, sp = 0u;
    for (;;) {
        sum = 0u; cnt = 0u; mine = 0u;
#pragma unroll
        for (unsigned j = 0; j < 16; ++j) { const unsigned c = xb_ld(&bar[XB_XCNT(j)]); sum += c; cnt += (c > 0u) ? 1u : 0u; mine = (j == x) ? c : mine; }
        if (sum == G) break;
        __builtin_amdgcn_s_sleep(1);
        if ((++sp & 255u) == 0u) { if (xb_ld(&bar[XB_TMO])) break; if (sp > XB_SPIN_CAP) { atomicAdd(&bar[XB_TMO], 1u); break; } }
    }
    nloc = mine > 0u ? mine : 1u; nx = cnt > 0u ? cnt : 1u;
}
__device__ __forceinline__ void xcd_barrier(const XcdBarrier& b) {
    asm volatile("s_waitcnt vmcnt(0)" ::: "memory");
    __syncthreads();
    if (threadIdx.x == 0) {
        unsigned* bar = b.bar;
        __builtin_amdgcn_s_waitcnt(0);
        unsigned nloc = b.st[0], nx = b.st[1];
        if (nloc == 0u) { xcd_barrier_complete(bar, b.x, nloc, nx); b.st[0] = nloc; b.st[1] = nx; }
        const unsigned old = xb_add(&bar[XB_XSUB(b.x)], 1u);
        const unsigned gen = old / nloc;
        if (old + 1u == (gen + 1u) * nloc) {
            __builtin_amdgcn_fence(__ATOMIC_RELEASE, "agent");
            asm volatile("s_waitcnt vmcnt(0)" ::: "memory");
            const unsigned og = xb_add(&bar[XB_TOP], 1u);
            const unsigned tg = og / nx;
            if (og + 1u == (tg + 1u) * nx) xb_add(&bar[XB_TOPGEN], 1u);
            else XB_SPIN(xb_ld(&bar[XB_TOPGEN]) == tg, bar);
            __builtin_amdgcn_fence(__ATOMIC_ACQUIRE, "agent");
            xb_add(&bar[XB_XGEN(b.x)], 1u);
            asm volatile("s_waitcnt vmcnt(0)" ::: "memory");
        } else {
            XB_SPIN(xb_ld(&bar[XB_XGEN(b.x)]) == gen, bar);
            __builtin_amdgcn_fence(__ATOMIC_ACQUIRE, "agent");
            asm volatile("s_waitcnt vmcnt(0)" ::: "memory");
        }
    }
    __syncthreads();
}

constexpr int BM = 256, BK = 64, HALF = 128, HT = HALF * BK;
__device__ __forceinline__ int lds_byte(int r, int c) { int st = (r >> 4) * 2 + (c >> 5), rr = r & 15, cc = c & 31, ob = rr * 64 + cc * 2; return st * 1024 + (ob ^ (((ob >> 9) & 1) << 5)); }
__device__ __forceinline__ void stage_rc(int b, int& R, int& C) { int st = b / 1024, sb = b % 1024, swz = sb ^ (((sb >> 9) & 1) << 5); R = (st >> 1) * 16 + swz / 64; C = (st & 1) * 32 + (swz % 64) / 2; }

template <class Epi>
__device__ __forceinline__ void gemm_tile(const bf16_t* __restrict__ A, const bf16_t* __restrict__ Bt, const int K, const int brow, const int bcol, bf16_t* shm, const Epi& epi) {
#define SA(b, h) (shm + ((b) * 2 + (h)) * HT)
#define SB(b, h) (shm + (4 + (b) * 2 + (h)) * HT)
#define STAGE_X(T, Pp, BASE, br, kt) do { long _g = (long)(br) * K + (long)(kt) * BK; \
    for (int _i = 0; _i < 2; ++_i) { int _b = (T) * 16 + _i * 8192; int _r, _c; stage_rc(_b, _r, _c); \
      __builtin_amdgcn_global_load_lds((const unsigned*)(BASE + _g + (long)_r * K + _c), (LAS unsigned*)((LAS char*)(Pp) + _b), 16, 0, 0); } } while (0)
#define STAGE(Pp, BASE, br, kt) STAGE_X(tx, Pp, BASE, br, kt)
#define LDA(dst, b, h) for (int m = 0; m < 4; ++m) for (int k = 0; k < 2; ++k) \
    dst[m][k] = *reinterpret_cast<const bf16x8*>((char*)SA(b, h) + lds_byte(wr * 64 + m * 16 + fr, k * 32 + fq * 8))
#define LDB(dst, b, h) for (int n = 0; n < 2; ++n) for (int k = 0; k < 2; ++k) \
    dst[n][k] = *reinterpret_cast<const bf16x8*>((char*)SB(b, h) + lds_byte(wc * 32 + n * 16 + fr, k * 32 + fq * 8))
#define MMA(ai, bj, At, Bt_) do { __builtin_amdgcn_s_setprio(1); \
    for (int m = 0; m < 4; ++m) for (int n = 0; n < 2; ++n) for (int k = 0; k < 2; ++k) \
      acc[ai][bj][m][n] = __builtin_amdgcn_mfma_f32_16x16x32_bf16(At[m][k], Bt_[n][k], acc[ai][bj][m][n], 0, 0, 0); \
    __builtin_amdgcn_s_setprio(0); } while (0)
#define WAIT_V(n) asm volatile("s_waitcnt vmcnt(" #n ")" ::: "memory")
#define WAIT_L(n) asm volatile("s_waitcnt lgkmcnt(" #n ")" ::: "memory")
#define BAR __builtin_amdgcn_s_barrier()
#define SCHED __builtin_amdgcn_sched_barrier(0)
    int tx = threadIdx.x; asm volatile("" : "+v"(tx));
    int wid = tx >> 6, lane = tx & 63, wr = wid >> 2, wc = wid & 3, fr = lane & 15, fq = lane >> 4;
    f32x4 acc[2][2][4][2] = {};
    bf16x8 At[4][2], B0[2][2], B1[2][2];
    const int nt = K / BK;
    STAGE(SB(0, 0), Bt, bcol, 0); STAGE(SA(0, 0), A, brow, 0);
    STAGE(SB(0, 1), Bt, bcol + HALF, 0); STAGE(SA(0, 1), A, brow + HALF, 0);
    if (wr == 1) BAR;
    WAIT_V(4); BAR;
    STAGE(SB(1, 0), Bt, bcol, 1); STAGE(SA(1, 0), A, brow, 1); STAGE(SB(1, 1), Bt, bcol + HALF, 1);
    WAIT_V(6); BAR;
    for (int t = 0; t < nt - 2; t += 2) {
        LDB(B0, 0, 0); SCHED; LDA(At, 0, 0); STAGE(SA(1, 1), A, brow + HALF, t + 1);
        WAIT_L(8); BAR; WAIT_L(0); MMA(0, 0, At, B0); BAR; SCHED;
        LDB(B1, 0, 1); STAGE(SB(0, 0), Bt, bcol, t + 2);
        BAR; WAIT_L(0); MMA(0, 1, At, B1); BAR;
        LDA(At, 0, 1); STAGE(SA(0, 0), A, brow, t + 2);
        BAR; WAIT_L(0); MMA(1, 0, At, B0); BAR; SCHED;
        STAGE(SB(0, 1), Bt, bcol + HALF, t + 2);
        WAIT_V(6); BAR; MMA(1, 1, At, B1); BAR;
        LDB(B0, 1, 0); SCHED; LDA(At, 1, 0); STAGE(SA(0, 1), A, brow + HALF, t + 2);
        WAIT_L(8); BAR; WAIT_L(0); MMA(0, 0, At, B0); BAR; SCHED;
        LDB(B1, 1, 1); STAGE(SB(1, 0), Bt, bcol, t + 3);
        BAR; WAIT_L(0); MMA(0, 1, At, B1); BAR;
        LDA(At, 1, 1); STAGE(SA(1, 0), A, brow, t + 3);
        BAR; WAIT_L(0); MMA(1, 0, At, B0); BAR; SCHED;
        STAGE(SB(1, 1), Bt, bcol + HALF, t + 3);
        WAIT_V(6); BAR; MMA(1, 1, At, B1); BAR;
    }
    int tz = threadIdx.x; asm volatile("" : "+v"(tz)); wid = tz >> 6; lane = tz & 63; wr = wid >> 2; wc = wid & 3; fr = lane & 15; fq = lane >> 4;
    { LDB(B0, 0, 0); WAIT_V(0); LDA(At, 0, 0); STAGE_X(tz, SA(1, 1), A, brow + HALF, nt - 1);
      BAR; WAIT_L(0); MMA(0, 0, At, B0); BAR;
      LDB(B1, 0, 1); BAR; WAIT_L(0); MMA(0, 1, At, B1); BAR;
      LDA(At, 0, 1); WAIT_V(4); BAR; WAIT_L(0); MMA(1, 0, At, B0); MMA(1, 1, At, B1); BAR; }
    { LDB(B0, 1, 0); LDA(At, 1, 0); WAIT_V(2); BAR; WAIT_L(0); MMA(0, 0, At, B0); BAR;
      LDB(B1, 1, 1); WAIT_V(0); BAR; WAIT_L(0); MMA(0, 1, At, B1); BAR;
      LDA(At, 1, 1); BAR; WAIT_L(0); MMA(1, 0, At, B0); MMA(1, 1, At, B1); BAR; }
    if (wr == 0) BAR;
#pragma unroll
    for (int ai = 0; ai < 2; ++ai)
#pragma unroll
        for (int bj = 0; bj < 2; ++bj)
#pragma unroll
            for (int m = 0; m < 4; ++m)
#pragma unroll
                for (int n = 0; n < 2; ++n)
#pragma unroll
                    for (int j = 0; j < 4; ++j) epi(brow + ai * HALF + wr * 64 + m * 16 + fq * 4 + j, bcol + bj * HALF + wc * 32 + n * 16 + fr, acc[ai][bj][m][n][j]);
    __syncthreads();
#undef SA
#undef SB
}


template <int NCB, class Epi>
__device__ __forceinline__ void gemm_rows8(const bf16_t* __restrict__ A, const bf16_t* __restrict__ Bt, int cu, unsigned char* lds, const Epi& epi) {
    int tid = threadIdx.x; asm volatile("" : "+v"(tid));
    const int wave = tid >> 6, lane = tid & 63, r16 = lane & 15, quad = lane >> 4, k0 = wave * 256;
    constexpr int NC = 16 * NCB;
    f32x4 acc[NCB];
#pragma unroll
    for (int cb = 0; cb < NCB; ++cb) acc[cb] = (f32x4){0.f, 0.f, 0.f, 0.f};
#pragma unroll
    for (int ks = 0; ks < 8; ++ks) {
        bf16x8 a = (bf16x8){0, 0, 0, 0, 0, 0, 0, 0};
        if (r16 < 8) a = *(const bf16x8*)(A + (size_t)r16 * 2048 + k0 + 32 * ks + 8 * quad);
#pragma unroll
        for (int cb = 0; cb < NCB; ++cb) { const bf16x8 b = *(const bf16x8*)(Bt + (size_t)(cu * NC + 16 * cb + r16) * 2048 + k0 + 32 * ks + 8 * quad); acc[cb] = MFMA16(a, b, acc[cb]); }
    }
    float* red = (float*)lds;
    if (quad < 2) {
#pragma unroll
        for (int cb = 0; cb < NCB; ++cb)
#pragma unroll
            for (int rg = 0; rg < 4; ++rg) red[(wave * 8 + 4 * quad + rg) * NC + 16 * cb + r16] = acc[cb][rg]; }
    __syncthreads();
    if (tid < 8 * NC) { const int row = tid / NC, col = tid % NC; float v = 0.f;
#pragma unroll
      for (int w = 0; w < 8; ++w) v += red[(w * 8 + row) * NC + col];
      epi(NP + row, cu * NC + col, v); }
    __syncthreads();
}
__device__ __forceinline__ void ph0_adaln(const Params& p, int u, float* smem) {
    float* sc = smem;
    float* red = smem + 12 * 2048;
    const int tid = threadIdx.x;
    for (int i = tid; i < 12 * 2048; i += NTHR) { const int r = i >> 11, k = i & 2047; const float c = r < 4 ? p.c_prompt[r * 2048 + k] : p.c_sample[(r - 4) * 2048 + k]; sc[i] = silu_f(c); }
    __syncthreads();
    const int col = u * 64 + (tid & 63), ks = tid >> 6;
    float a[12];
#pragma unroll
    for (int r = 0; r < 12; ++r) a[r] = 0.f;
    const float* w = p.w_ada + (size_t)(ks * 256) * 12288 + col;
#pragma unroll 1
    for (int k0 = 0; k0 < 256; k0 += 16) {
        float wv[16];
#pragma unroll
        for (int kk = 0; kk < 16; ++kk) wv[kk] = w[(size_t)(k0 + kk) * 12288];
#pragma unroll
        for (int kk = 0; kk < 16; ++kk)
#pragma unroll
            for (int r = 0; r < 12; ++r) a[r] += sc[r * 2048 + ks * 256 + k0 + kk] * wv[kk];
    }
#pragma unroll
    for (int r = 0; r < 12; ++r) red[(ks * 12 + r) * 64 + (tid & 63)] = a[r];
    __syncthreads();
    for (int i = tid; i < 12 * 64; i += NTHR) { const int r = i >> 6, c = i & 63; const int cc = u * 64 + c; float s = p.b_ada[cc];
#pragma unroll
        for (int k8 = 0; k8 < 8; ++k8) s += red[(k8 * 12 + r) * 64 + c];
        p.mod[r * 12288 + cc] = s; }
    __syncthreads();
}
__device__ __forceinline__ void ph0_transpose(const float* __restrict__ W, bf16_t* __restrict__ Wt, int Nreal, int ntn, int u, float* smem, int Kdim = 2048) {
    const int tk = u / ntn, tn = u % ntn, k0 = tk * 64, n0 = tn * 64, tid = threadIdx.x;
    for (int i = 0; i < 8; ++i) { const int idx = tid + NTHR * i, kk = idx >> 6, nn = idx & 63; smem[kk * 65 + nn] = (n0 + nn < Nreal) ? W[(size_t)(k0 + kk) * Nreal + n0 + nn] : 0.f; }
    __syncthreads();
    for (int i = 0; i < 8; ++i) { const int idx = tid + NTHR * i, nn = idx >> 6, kk = idx & 63; Wt[(size_t)(n0 + nn) * Kdim + k0 + kk] = f2bf(smem[kk * 65 + nn]); }
    __syncthreads();
}


__device__ __forceinline__ void ph0_cvt(const float* __restrict__ s, bf16_t* __restrict__ d, size_t u) {
    const size_t i = u * 4096 + (size_t)threadIdx.x * 8;
    const float4 a = *(const float4*)(s + i), b = *(const float4*)(s + i + 4);
    *(uint4*)(d + i) = make_uint4((unsigned)f2bf(a.x) | ((unsigned)f2bf(a.y) << 16), (unsigned)f2bf(a.z) | ((unsigned)f2bf(a.w) << 16), (unsigned)f2bf(b.x) | ((unsigned)f2bf(b.y) << 16), (unsigned)f2bf(b.z) | ((unsigned)f2bf(b.w) << 16));
}

__device__ __forceinline__ void ph0_fp8(const float* __restrict__ src, unsigned char* __restrict__ dst, float* __restrict__ scl, int u) {
    const int wave = threadIdx.x >> 6, lane = threadIdx.x & 63, r = u * 8 + wave;
    const float* s = src + (size_t)r * 2048 + lane * 16;
    float4 v[8]; float am = 0.f;
#pragma unroll
    for (int c = 0; c < 2; ++c)
#pragma unroll
        for (int k = 0; k < 4; ++k) { v[c * 4 + k] = *(const float4*)(s + c * 1024 + k * 4); const float4 t = v[c * 4 + k];
            am = fmaxf(am, fmaxf(fmaxf(fabsf(t.x), fabsf(t.y)), fmaxf(fabsf(t.z), fabsf(t.w)))); }
    am = wave_max(am);
    const float sc = fmaxf(am, 1e-30f) * (1.f / 440.f), inv = 1.f / sc;
#pragma unroll
    for (int c = 0; c < 2; ++c) { u32x4 w;
#pragma unroll
        for (int k = 0; k < 4; ++k) { const float4 t = v[c * 4 + k]; int pk = 0; pk = __builtin_amdgcn_cvt_pk_fp8_f32(t.x * inv, t.y * inv, pk, false); pk = __builtin_amdgcn_cvt_pk_fp8_f32(t.z * inv, t.w * inv, pk, true); w[k] = (unsigned)pk; }
        *(u32x4*)(dst + (size_t)(c * 8 + (lane >> 3)) * (16384 * 128) + (size_t)r * 128 + (lane & 7) * 16) = w; }
    if (lane == 0) scl[r] = sc;
}
__device__ __forceinline__ void ph0_keys(const Params& p, int u) {
    for (int k = 0; k < 8; ++k) { const int i = u * 4096 + threadIdx.x * 8 + k; const float x = p.peer_keys[i]; const bf16_t h = f2bf(x); p.kh[i] = h; p.kl[i] = f2bf(x - __uint_as_float((unsigned)h << 16)); }
}
template <int WHICH>
__device__ __forceinline__ void norm_row(const Params& p, int row) {
    const int lane = threadIdx.x & 63;
    bf16_t* dst = (WHICH == 0 ? p.h1 : p.h2) + (size_t)row * 2048;
    if (row >= NTOK) { for (int i = 0; i < 8; ++i) { const int c = i * 256 + lane * 4; *(uint2*)(dst + c) = make_uint2(0u, 0u); } return; }
    const int mrow = row < NP ? row / SEQ : 4 + (row - NP);
    const float* xr = row < NP ? p.x_prompt + (size_t)row * 2048 : p.x_sample + (size_t)(row - NP) * 2048;
    const float* mod = p.mod + (size_t)mrow * 12288;
    const float* nw = WHICH == 0 ? p.norm_mix : p.norm_ffn;
    float4 v[8]; float ss = 0.f;
#pragma unroll
    for (int i = 0; i < 8; ++i) { const int c = i * 256 + lane * 4; v[i] = *(const float4*)(xr + c);
        if (WHICH == 1) { const float4 a = *(const float4*)(p.acc2 + (size_t)row * 2048 + c); const float4 g = *(const float4*)(mod + 4096 + c);
            v[i].x += g.x * a.x; v[i].y += g.y * a.y; v[i].z += g.z * a.z; v[i].w += g.w * a.w; *(float4*)(p.x1 + (size_t)row * 2048 + c) = v[i]; }
        ss += v[i].x * v[i].x + v[i].y * v[i].y + v[i].z * v[i].z + v[i].w * v[i].w; }
    ss = wave_sum(ss);
    const float rstd = rsqrtf(ss * (1.f / 2048.f) + 1e-6f);
    const int osh = WHICH == 0 ? 0 : 6144, osc = WHICH == 0 ? 2048 : 8192;
#pragma unroll
    for (int i = 0; i < 8; ++i) { const int c = i * 256 + lane * 4;
        const float4 w = *(const float4*)(nw + c), sc = *(const float4*)(mod + osc + c), sh = *(const float4*)(mod + osh + c);
        float4 h; h.x = v[i].x * rstd * w.x * (1.f + sc.x) + sh.x; h.y = v[i].y * rstd * w.y * (1.f + sc.y) + sh.y; h.z = v[i].z * rstd * w.z * (1.f + sc.z) + sh.z; h.w = v[i].w * rstd * w.w * (1.f + sc.w) + sh.w;
        uint2 pk; pk.x = (unsigned)f2bf(h.x) | ((unsigned)f2bf(h.y) << 16); pk.y = (unsigned)f2bf(h.z) | ((unsigned)f2bf(h.w) << 16);
        *(uint2*)(dst + c) = pk;
        if (WHICH == 1) {
            int q8 = 0; q8 = __builtin_amdgcn_cvt_pk_fp8_f32(h.x, h.y, q8, false); q8 = __builtin_amdgcn_cvt_pk_fp8_f32(h.z, h.w, q8, true); *(int*)(p.h2q + (size_t)row * 2048 + c) = q8; } }
}

__device__ __forceinline__ void ph3_scatter(const Params& p, int u) {
    const int tid = threadIdx.x;
    if (u >= NSB) { const int b = (u - NSB) / 3, i = (u - NSB) % 3; const float* Pr = p.P + (size_t)(b * SEQ + SEQ - 3 + i) * INCP;
        for (int c = tid; c < 3072; c += NTHR) p.out[O_CVP + ((size_t)b * 3 + i) * 3072 + c] = Pr[C_QKV + c];
        return; }
    const int b = u, row = NP + b;
    const float* Pr = p.P + (size_t)row * INCP;
    { const int c = tid * 2; *(unsigned*)(p.Qb + (size_t)row * 1024 + c) = (unsigned)f2bf(Pr[C_Q + c]) | ((unsigned)f2bf(Pr[C_Q + c + 1]) << 16);
      *(unsigned*)(p.KVb + (size_t)row * 1024 + c) = (unsigned)f2bf(Pr[C_KVS + c]) | ((unsigned)f2bf(Pr[C_KVS + c + 1]) << 16); }
    p.out[O_CKS + b * 512 + tid] = Pr[C_KVC + tid];
    p.out[O_SKS + b * 512 + tid] = Pr[C_KVS + tid];
    p.out[O_WKS + ((size_t)b * 512 + 511) * 512 + tid] = Pr[C_KVW + tid];
    for (int i = 0; i < 3; ++i) for (int c = tid; c < 3072; c += NTHR) p.out[O_CVS + ((size_t)b * 3 + i) * 3072 + c] = i < 2 ? p.state_conv[((size_t)b * 3 + i + 1) * 3072 + c] : Pr[C_QKV + c];
}
constexpr int CP_A = 0, CP_B = 34816, CP_H = 69632;
template <bool SMP>
__device__ __forceinline__ void cmp_tile(const Params& p, int tile, int s, unsigned char* lds) {
    int tid = threadIdx.x; asm volatile("" : "+v"(tid));
    const int wave = tid >> 6, lane = tid & 63, r16 = lane & 15, quad = lane >> 4, wr = wave >> 1, wc = wave & 1;
    const int NC = SMP ? 512 : 64, STR = 512;
    const float* abase[8];
#pragma unroll
    for (int i = 0; i < 8; ++i) { const int id = tid + 512 * i, R = tile * 128 + (id >> 5), part = id & 31;
        const int h = R & 1, n = (R >> 1) & (NC - 1), b = R / (2 * NC);
        if (SMP) abase[i] = p.cache_cmp + ((size_t)p.page_table[b * NPAGES + (n >> 2)] * 128 + (n & 3) * 32) * 512 + s * 256 + h * 128 + part * 4;
        else abase[i] = p.out + O_CKP + (size_t)(b * SEQ + n * 32) * 512 + s * 256 + h * 128 + part * 4; }
    const float* pe = p.cmp_pe + (size_t)s * 4096 + ((tid & 31) * 4);
    const bf16_t* bsrc[4];
#pragma unroll
    for (int i = 0; i < 4; ++i) { const int id = tid + 512 * i; bsrc[i] = p.w1t + ((size_t)s * 128 + (id >> 4)) * 4096 + (id & 15) * 8; }
    float4 av[8]; u32x4 bv[4];
#pragma unroll
    for (int i = 0; i < 8; ++i) av[i] = *(const float4*)(abase[i]);
#pragma unroll
    for (int i = 0; i < 4; ++i) bv[i] = *(const u32x4*)(bsrc[i]);
    f32x4 acc[2][4];
#pragma unroll
    for (int a = 0; a < 2; ++a) for (int c = 0; c < 4; ++c) acc[a][c] = (f32x4){0.f, 0.f, 0.f, 0.f};
    unsigned char* Ab = lds + CP_A; unsigned char* Bb = lds + CP_B;
#pragma unroll 1
    for (int l = 0; l < 32; ++l) {
        { const float4 pv = *(const float4*)(pe + l * 128);
#pragma unroll
          for (int i = 0; i < 8; ++i) { const int id = tid + 512 * i; uint2 w; w.x = pk2(av[i].x + pv.x, av[i].y + pv.y); w.y = pk2(av[i].z + pv.z, av[i].w + pv.w);
              *(uint2*)(Ab + (id >> 5) * 272 + (id & 31) * 8) = w; } }
#pragma unroll
        for (int i = 0; i < 4; ++i) { const int id = tid + 512 * i; *(u32x4*)(Bb + (id >> 4) * 272 + (id & 15) * 16) = bv[i]; }
        __syncthreads();
        if (l + 1 < 32) {
#pragma unroll
            for (int i = 0; i < 8; ++i) av[i] = *(const float4*)(abase[i] + (size_t)(l + 1) * STR);
#pragma unroll
            for (int i = 0; i < 4; ++i) bv[i] = *(const u32x4*)(bsrc[i] + (l + 1) * 128); }
#pragma unroll
        for (int ks = 0; ks < 4; ++ks) { bf16x8 a[2], b[4];
#pragma unroll
            for (int rb = 0; rb < 2; ++rb) a[rb] = *(const bf16x8*)(Ab + (32 * wr + 16 * rb + r16) * 272 + (32 * ks + 8 * quad) * 2);
#pragma unroll
            for (int cb = 0; cb < 4; ++cb) b[cb] = *(const bf16x8*)(Bb + (64 * wc + 16 * cb + r16) * 272 + (32 * ks + 8 * quad) * 2);
#pragma unroll
            for (int rb = 0; rb < 2; ++rb)
#pragma unroll
                for (int cb = 0; cb < 4; ++cb) acc[rb][cb] = MFMA16(a[rb], b[cb], acc[rb][cb]); }
        __syncthreads();
    }
    unsigned char* H = lds + CP_H;
#pragma unroll
    for (int rb = 0; rb < 2; ++rb)
#pragma unroll
        for (int cb = 0; cb < 4; ++cb) { const int e = 64 * wc + 16 * cb + r16; const float b1 = p.cmp_b1[s * 128 + e];
#pragma unroll
            for (int rg = 0; rg < 4; ++rg) *(bf16_t*)(H + (32 * wr + 16 * rb + 4 * quad + rg) * 272 + e * 2) = f2bf(gelu_tanh(acc[rb][cb][rg] + b1)); }
    __syncthreads();
    float* dst = SMP ? p.ckv_s : p.ckv_p;
#pragma unroll
    for (int rb = 0; rb < 2; ++rb)
#pragma unroll
        for (int cb = 0; cb < 4; ++cb) { f32x4 o = (f32x4){0.f, 0.f, 0.f, 0.f}; const int d = 64 * wc + 16 * cb + r16;
#pragma unroll
            for (int ks = 0; ks < 4; ++ks) { const bf16x8 a = *(const bf16x8*)(H + (32 * wr + 16 * rb + r16) * 272 + (32 * ks + 8 * quad) * 2);
                const bf16x8 b = *(const bf16x8*)(p.w2t + ((size_t)s * 128 + d) * 128 + 32 * ks + 8 * quad); o = MFMA16(a, b, o); }
#pragma unroll
            for (int rg = 0; rg < 4; ++rg) { const int R = tile * 128 + 32 * wr + 16 * rb + 4 * quad + rg; const int h = R & 1, n = (R >> 1) & (NC - 1), b = R / (2 * NC);
                dst[((((size_t)b * NC + n) * 2 + s) * 2 + h) * 128 + d] = o[rg]; } }
    __syncthreads();
}
__device__ __forceinline__ void ph3_gdnprep(const Params& p, int row, float* smem) {
    float* cv = smem;
    const int tid = threadIdx.x;
    const float* Pr = p.P + (size_t)row * INCP;
    for (int c = tid; c < 3072; c += NTHR) {
        float acc = 0.f;
        if (row < NP) { const int t = row % SEQ;
#pragma unroll
            for (int i = 0; i < 4; ++i) { const int tt = t - 3 + i; if (tt >= 0) acc += p.P[(size_t)(row - 3 + i) * INCP + C_QKV + c] * p.conv_w[i * 3072 + c]; } }
        else { const int b = row - NP;
#pragma unroll
            for (int i = 0; i < 3; ++i) acc += p.state_conv[((size_t)b * 3 + i) * 3072 + c] * p.conv_w[i * 3072 + c];
            acc += Pr[C_QKV + c] * p.conv_w[3 * 3072 + c]; }
        cv[c] = silu_f(acc);
    }
    __syncthreads();
    const int wave = tid >> 6, lane = tid & 63;
    for (int hh = wave; hh < 16; hh += 8) {
        const float a = cv[hh * 128 + lane], b2 = cv[hh * 128 + 64 + lane];
        const float ss = wave_sum(a * a + b2 * b2);
        float r = rsqrtf(ss + 1e-6f); if (hh < 8) r *= 0.08838834764831845f;
        p.qkvn[(size_t)row * 3072 + hh * 128 + lane] = a * r; p.qkvn[(size_t)row * 3072 + hh * 128 + 64 + lane] = b2 * r;
    }
    for (int c = tid; c < 1024; c += NTHR) p.qkvn[(size_t)row * 3072 + 2048 + c] = cv[2048 + c];
    if (tid < 8) { p.gbeta[row * 8 + tid] = sigmoid_f(Pr[C_BL + tid]); p.gg[row * 8 + tid] = -__expf(p.a_log[tid]) * softplus_f(Pr[C_AL + tid] + p.dt_bias[tid]); }
    __syncthreads();
}

template <int BR, bool SMP>
__device__ __forceinline__ void nsa_key(const Params& p, int b, int tpos, int kvh, int j, const int* sel, int& pos, bool& valid, const float*& kp, const float*& vp) {
    if (BR == 0) {
        const int NC = SMP ? 512 : 64; pos = 32 * j + 31; valid = pos <= tpos;
        const float* base = (SMP ? p.ckv_s : p.ckv_p) + (((size_t)b * NC + j) * 4) * 128; kp = base + kvh * 128; vp = base + (2 + kvh) * 128;
    } else if (BR == 1) {
        const int blk = sel[j >> 6]; pos = blk * 64 + (j & 63); valid = pos <= tpos;
        const float* base;
        if (!SMP) base = p.P + (size_t)(b * SEQ + (valid ? pos : 0)) * INCP + C_KVS;
        else if (pos < PAST) base = p.cache_sel + ((size_t)p.page_table[b * NPAGES + (pos >> 7)] * 128 + (pos & 127)) * 512;
        else base = p.P + (size_t)(NP + b) * INCP + C_KVS;
        kp = base + kvh * 128; vp = base + 256 + kvh * 128;
    } else {
        const float* base;
        if (!SMP) { pos = tpos - 511 + j; valid = pos >= 0; base = p.P + (size_t)(b * SEQ + (valid ? pos : 0)) * INCP + C_KVW; }
        else { const int jj = j + 1; pos = PAST - 512 + jj; valid = true; base = jj < 512 ? p.state_win + ((size_t)b * 512 + jj) * 512 : p.P + (size_t)(NP + b) * INCP + C_KVW; }
        kp = base + kvh * 128; vp = base + 256 + kvh * 128;
    }
}
template <int BR, bool SMP>
__device__ __forceinline__ void nsa_branch(const Params& p, int b, int tpos, int kvh, int nkeys, const int* sel, const float* myq, float* mysc, float slope, int lane, float& r0, float& r1) {
    const float scale = 0.08838834764831845f;
    float mloc = -1e30f;
    for (int j0 = 0; j0 < nkeys; j0 += 64) {
        const int j = j0 + lane; float s = -1e30f;
        if (j < nkeys) {
            int pos; bool valid; const float *kp, *vp; nsa_key<BR, SMP>(p, b, tpos, kvh, j, sel, pos, valid, kp, vp);
            if (valid) { float dot = 0.f;
                for (int d = 0; d < 128; d += 4) { const float4 kv = *(const float4*)(kp + d); dot += myq[d] * kv.x + myq[d + 1] * kv.y + myq[d + 2] * kv.z + myq[d + 3] * kv.w; }
                s = dot * scale - slope * (float)(tpos - pos); }
            mysc[j] = s;
        }
        mloc = fmaxf(mloc, s);
    }
    const float m = wave_max(mloc);
    float lsum = 0.f;
    for (int j0 = 0; j0 < nkeys; j0 += 64) { const int j = j0 + lane; if (j < nkeys) { const float s = mysc[j]; const float e = s > -1e29f ? __expf(s - m) : 0.f; mysc[j] = e; lsum += e; } }
    const float l = wave_sum(lsum);
    const float linv = l > 0.f ? 1.f / l : 0.f;
    for (int j0 = 0; j0 < nkeys; j0 += 64) { const int j = j0 + lane; if (j < nkeys) mysc[j] *= linv; }
    float a0 = 0.f, a1 = 0.f;
    for (int j = 0; j < nkeys; ++j) {
        const float pj = mysc[j];
        if (pj != 0.f) { int pos; bool valid; const float *kp, *vp; nsa_key<BR, SMP>(p, b, tpos, kvh, j, sel, pos, valid, kp, vp);
            const float2 vv = *(const float2*)(vp + 2 * lane); a0 += pj * vv.x; a1 += pj * vv.y; }
    }
    r0 = a0; r1 = a1;
}
template <bool SMP>
__device__ __forceinline__ void ph4_nsa(const Params& p, int b, int t, float* smem) {
    float* q_s = smem;
    float* sc = smem + 1024;
    int* sel_s = (int*)(sc + 8 * 1024);
    const int tid = threadIdx.x, wave = tid >> 6, lane = tid & 63, hd = wave, kvh = wave >> 2;
    const int row = SMP ? NP + b : b * SEQ + t, tpos = SMP ? PAST : t;
    const float* Pr = p.P + (size_t)row * INCP;
    for (int i = tid; i < 1024; i += NTHR) q_s[i] = Pr[C_Q + i];
    __syncthreads();
    const float slope = exp2f(-(float)(hd + 1));
    float* mysc = sc + wave * 1024; const float* myq = q_s + hd * 128;
    const int NC = SMP ? 512 : 64;
    float c0, c1, s0, s1, w0, w1;
    nsa_branch<0, SMP>(p, b, tpos, kvh, NC, nullptr, myq, mysc, slope, lane, c0, c1);
    __syncthreads();
    const int cur = tpos >> 6, ncand = cur + 1, nsel = ncand < 16 ? ncand : 16;
    if ((wave & 3) == 0) {
        float val[5];
#pragma unroll
        for (int i = 0; i < 5; ++i) { const int blk = lane + 64 * i; float v = -INFINITY;
            if (blk < ncand) { const bool forced = blk == 0 || blk == cur || blk == cur - 1; float imp = 0.f;
                if (!forced) { for (int g = 0; g < 4; ++g) { const float* ps = sc + (kvh * 4 + g) * 1024; if (2 * blk < NC) imp += ps[2 * blk]; if (2 * blk + 1 < NC) imp += ps[2 * blk + 1]; } }
                v = forced ? 1e4f : imp; }
            val[i] = v; }
        for (int r = 0; r < nsel; ++r) {
            float bv = val[0]; int bi = lane;
#pragma unroll
            for (int i = 1; i < 5; ++i) if (val[i] > bv) { bv = val[i]; bi = lane + 64 * i; }
            for (int o = 32; o > 0; o >>= 1) { const float ov = __shfl_xor(bv, o); const int oi = __shfl_xor(bi, o); if (ov > bv || (ov == bv && oi < bi)) { bv = ov; bi = oi; } }
            if (lane == 0) sel_s[kvh * 16 + r] = bi;
#pragma unroll
            for (int i = 0; i < 5; ++i) if (lane + 64 * i == bi) val[i] = -INFINITY;
        }
    }
    __syncthreads();
    nsa_branch<1, SMP>(p, b, tpos, kvh, nsel * 64, sel_s + kvh * 16, myq, mysc, slope, lane, s0, s1);
    nsa_branch<2, SMP>(p, b, tpos, kvh, 512, nullptr, myq, mysc, slope, lane, w0, w1);
    const float g0 = sigmoid_f(Pr[C_GTS + hd * 3 + 0]), g1 = sigmoid_f(Pr[C_GTS + hd * 3 + 1]), g2 = sigmoid_f(Pr[C_GTS + hd * 3 + 2]);
    const float o0 = g0 * c0 + g1 * s0 + g2 * w0, o1 = g0 * c1 + g1 * s1 + g2 * w1;
    *(unsigned*)(p.amix + (size_t)row * 2048 + hd * 128 + 2 * lane) = (unsigned)f2bf(o0) | ((unsigned)f2bf(o1) << 16);
    __syncthreads();
}

constexpr int NSA_KT0 = 0, NSA_VS0 = 17408, NSA_KT1 = 37888, NSA_VS1 = 55296, NSA_IMP = 75776, NSA_SELM = NSA_IMP + 4 * 64 * 33 * 4, NSA_UNI = NSA_SELM + 256;
typedef short s16x4 __attribute__((ext_vector_type(4)));
__device__ __forceinline__ bf16x8 pack8(float x0, float x1, float x2, float x3, float x4, float x5, float x6, float x7) {
    u32x4 p;
    asm volatile("v_cvt_pk_bf16_f32 %0, %4, %5\n\tv_cvt_pk_bf16_f32 %1, %6, %7\n\tv_cvt_pk_bf16_f32 %2, %8, %9\n\tv_cvt_pk_bf16_f32 %3, %10, %11\n\ts_nop 1"
                 : "=&v"(p[0]), "=&v"(p[1]), "=&v"(p[2]), "=&v"(p[3]) : "v"(x0), "v"(x1), "v"(x2), "v"(x3), "v"(x4), "v"(x5), "v"(x6), "v"(x7));
    return __builtin_bit_cast(bf16x8, p);
}
__device__ __forceinline__ void nsa_fetch(const bf16_t* kbase, const bf16_t* vbase, int rs, int tid, uint4 (&kr)[2], uint4 (&vr)[2]) {
#pragma unroll
    for (int u = 0; u < 2; ++u) { const int c = tid + 512 * u; kr[u] = *(const uint4*)(kbase + (size_t)(c >> 4) * rs + (c & 15) * 8); vr[u] = *(const uint4*)(vbase + (size_t)(c >> 4) * rs + (c & 15) * 8); }
}
__device__ __forceinline__ void nsa_store(unsigned char* Kt, unsigned char* Vs, int tid, const uint4 (&kr)[2], const uint4 (&vr)[2]) {
#pragma unroll
    for (int u = 0; u < 2; ++u) { const int c = tid + 512 * u; *(uint4*)(Kt + (c >> 4) * 272 + (c & 15) * 16) = kr[u]; *(uint4*)(Vs + (c >> 4) * 320 + (c & 15) * 16) = vr[u]; }
}
template <int MODE>
__device__ __forceinline__ void nsa_tile(const unsigned char* Kt, const unsigned char* Vt, const bf16x8 (&qf)[8], int lane, int kb0, int t, float scl, float slp, bool sel, int edge,
                                         float& m, float& l, f32x16 (&O)[4], f32x16 (&S)[2], bf16x8 (&pf)[4]) {
    const int ql = lane & 31, h = lane >> 5;
#pragma unroll
    for (int b2 = 0; b2 < 2; ++b2) {
        f32x16 acc; for (int r = 0; r < 16; ++r) acc[r] = 0.f;
        bf16x8 kf[8];
#pragma unroll
        for (int s = 0; s < 8; ++s) kf[s] = *(const bf16x8*)(Kt + (32 * b2 + ql) * 272 + (16 * s + 8 * h) * 2);
#pragma unroll
        for (int s = 0; s < 8; ++s) acc = MFMA32(kf[s], qf[s], acc);
        S[b2] = acc;
    }
    float tmax = -1e30f;
    const int KS = MODE == 0 ? 32 : 1;
    const int d0 = MODE == 0 ? t - 31 - 128 * h : t - kb0 - 4 * h;
    const float nb0 = -slp * (float)d0, slk = slp * (float)KS;
#pragma unroll
    for (int b2 = 0; b2 < 2; ++b2)
#pragma unroll
        for (int r = 0; r < 16; ++r) {
            const int c = 32 * b2 + 8 * (r >> 2) + (r & 3);
            bool valid;
            if (MODE == 0) valid = d0 >= KS * c;
            else if (MODE == 1) valid = sel && (!(edge & 1) || d0 >= c);
            else valid = (!(edge & 1) || d0 >= c) && (!(edge & 2) || d0 < 512 + c);
            const float sc = __builtin_fmaf(S[b2][r], scl, __builtin_fmaf(slk, (float)c, nb0));
            const float sv = valid ? sc : -1e30f;
            S[b2][r] = sv; tmax = fmaxf(tmax, sv);
        }
    tmax = fmaxf(tmax, __shfl_xor(tmax, 32));
    const float mn = fmaxf(m, tmax);
    const float alpha = __builtin_amdgcn_exp2f(m - mn);
    m = mn;
    if (!__all(alpha == 1.f)) {
        l *= alpha;
#pragma unroll
        for (int d = 0; d < 4; ++d)
#pragma unroll
            for (int r = 0; r < 16; ++r) O[d][r] *= alpha;
    }
    float ls = 0.f;
#pragma unroll
    for (int b2 = 0; b2 < 2; ++b2)
#pragma unroll
        for (int r = 0; r < 16; ++r) { const float sv = S[b2][r]; const float pv = sv > -1e29f ? __builtin_amdgcn_exp2f(sv - mn) : 0.f; S[b2][r] = pv; ls += pv; }
    l += ls;
#pragma unroll
    for (int ks = 0; ks < 4; ++ks) { const int b2 = ks >> 1, s = ks & 1;
        pf[ks] = pack8(S[b2][8 * s], S[b2][8 * s + 1], S[b2][8 * s + 2], S[b2][8 * s + 3], S[b2][8 * s + 4], S[b2][8 * s + 5], S[b2][8 * s + 6], S[b2][8 * s + 7]); }
}
__device__ __forceinline__ void nsa_pv(const unsigned char* Vs, int lane, f32x16 (&O)[4], const bf16x8 (&pf)[4]) {
    const int g = lane >> 4, i16 = lane & 15, h = g >> 1;
    const unsigned char* vb = Vs + (4 * h + (i16 >> 2)) * 320 + (16 * (g & 1) + 4 * (i16 & 3)) * 2;
#pragma unroll
    for (int d = 0; d < 4; ++d) {
        s16x4 lo[4], hi[4];
#pragma unroll
        for (int ks = 0; ks < 4; ++ks) { lo[ks] = __builtin_amdgcn_ds_read_tr16_b64_v4i16((LAS s16x4*)(vb + (16 * ks) * 320 + 64 * d)); hi[ks] = __builtin_amdgcn_ds_read_tr16_b64_v4i16((LAS s16x4*)(vb + (16 * ks + 8) * 320 + 64 * d)); }
#pragma unroll
        for (int ks = 0; ks < 4; ++ks) { const bf16x8 av = __builtin_shufflevector(lo[ks], hi[ks], 0, 1, 2, 3, 4, 5, 6, 7); O[d] = MFMA32(av, pf[ks], O[d]); }
    }
}
template <bool FIRST>
__device__ __forceinline__ void nsa_flush(bf16_t* orow, int h, float f, f32x16 (&O)[4]) {
#pragma unroll
    for (int d = 0; d < 4; ++d)
#pragma unroll
        for (int rg = 0; rg < 4; ++rg) {
            uint2* dst = (uint2*)(orow + 32 * d + 8 * rg + 4 * h);
            float a0 = O[d][4 * rg] * f, a1 = O[d][4 * rg + 1] * f, a2 = O[d][4 * rg + 2] * f, a3 = O[d][4 * rg + 3] * f;
            if (!FIRST) { const uint2 old = *dst; a0 += __uint_as_float(old.x << 16); a1 += __uint_as_float(old.x & 0xffff0000u); a2 += __uint_as_float(old.y << 16); a3 += __uint_as_float(old.y & 0xffff0000u); }
            uint2 w; w.x = pk2(a0, a1); w.y = pk2(a2, a3); *dst = w;
            O[d][4 * rg] = 0.f; O[d][4 * rg + 1] = 0.f; O[d][4 * rg + 2] = 0.f; O[d][4 * rg + 3] = 0.f;
        }
}
__device__ __forceinline__ void ph4_nsa_fast(const Params& p, int u, unsigned char* lds) {
    int tid = threadIdx.x; asm volatile("" : "+v"(tid));
    const int wave = tid >> 6, lane = tid & 63, ql = lane & 31;
    const int i = 31 - (u >> 3), b = (u & 7) >> 1, kvh = u & 1;
    const int g = wave >> 1, qh = wave & 1, hd = kvh * 4 + g;
    const int t = i * 64 + qh * 32 + ql;
    const size_t row = (size_t)b * SEQ + t;
    float* imp = (float*)(lds + NSA_IMP); unsigned* selm = (unsigned*)(lds + NSA_SELM); unsigned* uni = (unsigned*)(lds + NSA_UNI);
    bf16x8 qf[8];
    { const bf16_t* qrow = p.Qb + row * 1024 + hd * 128 + 8 * (lane >> 5);
#pragma unroll
      for (int s = 0; s < 8; ++s) qf[s] = *(const bf16x8*)(qrow + 16 * s); }
    const float LOG2E = 1.4426950408889634f;
    const float scl = 0.08838834764831845f * LOG2E, slp = exp2f(-(float)(hd + 1)) * LOG2E;
    const float* Pr = p.P + row * INCP;
    const float g0 = sigmoid_f(Pr[C_GTS + hd * 3 + 0]), g1 = sigmoid_f(Pr[C_GTS + hd * 3 + 1]), g2 = sigmoid_f(Pr[C_GTS + hd * 3 + 2]);
    f32x16 O[4], S[2];
#pragma unroll
    for (int d = 0; d < 4; ++d) for (int r = 0; r < 16; ++r) O[d][r] = 0.f;
    bf16_t* orow = p.amix + row * 2048 + hd * 128;
    uint4 kr[2], vr[2];
    if (wave >= 4) __builtin_amdgcn_s_setprio(1);
    int cnt = 0;
#define KT(k) (lds + (((k) & 1) ? NSA_KT1 : NSA_KT0))
#define VS(k) (lds + (((k) & 1) ? NSA_VS1 : NSA_VS0))
    {
        const float* cb = p.ckv_p + (size_t)b * 64 * 512;
#pragma unroll
        for (int uu = 0; uu < 2; ++uu) { const int c = tid + 512 * uu, n = c >> 4, part = c & 15;
            const float4 a = *(const float4*)(cb + (size_t)n * 512 + kvh * 128 + part * 8), bq = *(const float4*)(cb + (size_t)n * 512 + kvh * 128 + part * 8 + 4);
            kr[uu] = make_uint4(pk2(a.x, a.y), pk2(a.z, a.w), pk2(bq.x, bq.y), pk2(bq.z, bq.w));
            const float4 c4 = *(const float4*)(cb + (size_t)n * 512 + 256 + kvh * 128 + part * 8), d4 = *(const float4*)(cb + (size_t)n * 512 + 256 + kvh * 128 + part * 8 + 4);
            vr[uu] = make_uint4(pk2(c4.x, c4.y), pk2(c4.z, c4.w), pk2(d4.x, d4.y), pk2(d4.z, d4.w)); }
        nsa_store(KT(cnt), VS(cnt), tid, kr, vr);
        __syncthreads();
        float m = -1e30f, l = 0.f;
        bf16x8 pf[4];
        nsa_tile<0>(KT(cnt), nullptr, qf, lane, 0, t, scl, slp, true, 0, m, l, O, S, pf);
        nsa_pv(VS(cnt), lane, O, pf);
        ++cnt;
        const float lt = l + __shfl_xor(l, 32);
        const float linv = lt > 0.f ? 1.f / lt : 0.f;
        float* ip = imp + (size_t)(g * 64 + qh * 32 + ql) * 33;
#pragma unroll
        for (int b2 = 0; b2 < 2; ++b2)
#pragma unroll
            for (int r = 0; r < 16; r += 2) { const int ko = 32 * b2 + 8 * (r >> 2) + 4 * (lane >> 5) + (r & 3); ip[ko >> 1] = (S[b2][r] + S[b2][r + 1]) * linv; }
        nsa_flush<true>(orow, lane >> 5, g0 * linv, O);
    }
    __syncthreads();
    {
        const int qq = tid >> 3, sub = tid & 7, ncand = i + 1;
        unsigned mask;
        if (ncand <= 16) mask = (1u << ncand) - 1u;
        else {
            float val[4];
#pragma unroll
            for (int c = 0; c < 4; ++c) { const int blk = sub + 8 * c; float v = -INFINITY;
                if (blk < ncand) { const bool forced = blk == 0 || blk == i || blk == i - 1;
                    v = forced ? 1e4f : imp[(0 * 64 + qq) * 33 + blk] + imp[(1 * 64 + qq) * 33 + blk] + imp[(2 * 64 + qq) * 33 + blk] + imp[(3 * 64 + qq) * 33 + blk]; }
                val[c] = v; }
            mask = 0u;
            for (int r = 0; r < 16; ++r) {
                float bv = val[0]; int bi = sub;
#pragma unroll
                for (int c = 1; c < 4; ++c) if (val[c] > bv) { bv = val[c]; bi = sub + 8 * c; }
#pragma unroll
                for (int o = 4; o > 0; o >>= 1) { const float ov = __shfl_xor(bv, o); const int oi = __shfl_xor(bi, o); if (ov > bv || (ov == bv && oi < bi)) { bv = ov; bi = oi; } }
                mask |= 1u << bi;
#pragma unroll
                for (int c = 0; c < 4; ++c) if (sub + 8 * c == bi) val[c] = -INFINITY;
            }
        }
        if (sub == 0) selm[qq] = mask;
    }
    __syncthreads();
    if (wave == 0) { unsigned um = selm[lane]; for (int o = 32; o > 0; o >>= 1) um |= __shfl_xor(um, o); if (lane == 0) uni[0] = um; }
    __syncthreads();
    const unsigned mymask = selm[qh * 32 + ql], umask = uni[0];
    {
        const bf16_t* kvb = p.KVb + (size_t)b * SEQ * 1024 + kvh * 128;
        float m = -1e30f, l = 0.f;
        int j = i;
        nsa_fetch(kvb + (size_t)j * 64 * 1024, kvb + (size_t)j * 64 * 1024 + 256, 1024, tid, kr, vr);
        nsa_store(KT(cnt), VS(cnt), tid, kr, vr);
        __syncthreads();
        while (j >= 0) {
            int jn = j - 1; while (jn >= 0 && !((umask >> jn) & 1u)) --jn;
            const bool sel = (mymask >> j) & 1u; const bool any = __any(sel);
            bf16x8 pf[4];
            if (any) nsa_tile<1>(KT(cnt), nullptr, qf, lane, j * 64, t, scl, slp, sel, j == i ? 1 : 0, m, l, O, S, pf);
            if (jn >= 0) nsa_fetch(kvb + (size_t)jn * 64 * 1024, kvb + (size_t)jn * 64 * 1024 + 256, 1024, tid, kr, vr);
            if (any) nsa_pv(VS(cnt), lane, O, pf);
            ++cnt;
            if (jn >= 0) nsa_store(KT(cnt), VS(cnt), tid, kr, vr);
            __syncthreads();
            j = jn;
        }
        const float lt = l + __shfl_xor(l, 32);
        nsa_flush<false>(orow, lane >> 5, lt > 0.f ? g1 / lt : 0.f, O);
    }
    {
        const bf16_t* kvb = p.KVb + (size_t)b * SEQ * 1024 + 512 + kvh * 128;
        float m = -1e30f, l = 0.f;
        const int jlo = i - 8 < 0 ? 0 : i - 8;
        int j = i;
        nsa_fetch(kvb + (size_t)j * 64 * 1024, kvb + (size_t)j * 64 * 1024 + 256, 1024, tid, kr, vr);
        nsa_store(KT(cnt), VS(cnt), tid, kr, vr);
        __syncthreads();
        while (j >= jlo) {
            bf16x8 pf[4];
            nsa_tile<2>(KT(cnt), nullptr, qf, lane, j * 64, t, scl, slp, true, (j == i ? 1 : 0) | (j == i - 8 ? 2 : 0), m, l, O, S, pf);
            if (j - 1 >= jlo) nsa_fetch(kvb + (size_t)(j - 1) * 64 * 1024, kvb + (size_t)(j - 1) * 64 * 1024 + 256, 1024, tid, kr, vr);
            nsa_pv(VS(cnt), lane, O, pf);
            ++cnt;
            if (j - 1 >= jlo) nsa_store(KT(cnt), VS(cnt), tid, kr, vr);
            __syncthreads();
            --j;
        }
        const float lt = l + __shfl_xor(l, 32);
        nsa_flush<false>(orow, lane >> 5, lt > 0.f ? g2 / lt : 0.f, O);
    }
#undef KT
#undef VS
    __builtin_amdgcn_s_setprio(0);
    __syncthreads();
}

constexpr int NS_Q = 0, NS_SC = 2048, NS_SEL = NS_SC + 4 * 2048 * 4, NS_RED = NS_SEL + 256;
__device__ __forceinline__ void ns_softmax(float* s, int lo, int hi, int lane, float mult) {
    float m = -1e30f;
    for (int j = lo + lane; j < hi; j += 64) m = fmaxf(m, s[j]);
    m = wave_max(m);
    float sum = 0.f;
    for (int j = lo + lane; j < hi; j += 64) { const float v = s[j]; const float e = v > -1e29f ? __expf(v - m) : 0.f; s[j] = e; sum += e; }
    sum = wave_sum(sum);
    const float f = sum > 0.f ? mult / sum : 0.f;
    for (int j = lo + lane; j < hi; j += 64) s[j] *= f;
}
__device__ __forceinline__ void ns_scores(const float* q_s, const float* kp, bool valid, int dist, int kvh, float* sc, int j) {
    float a0 = 0.f, a1 = 0.f, a2 = 0.f, a3 = 0.f;
    if (valid) {
#pragma unroll 16
        for (int d = 0; d < 128; d += 4) { const float4 kv = *(const float4*)(kp + d);
            a0 += q_s[d] * kv.x + q_s[d + 1] * kv.y + q_s[d + 2] * kv.z + q_s[d + 3] * kv.w;
            a1 += q_s[128 + d] * kv.x + q_s[128 + d + 1] * kv.y + q_s[128 + d + 2] * kv.z + q_s[128 + d + 3] * kv.w;
            a2 += q_s[256 + d] * kv.x + q_s[256 + d + 1] * kv.y + q_s[256 + d + 2] * kv.z + q_s[256 + d + 3] * kv.w;
            a3 += q_s[384 + d] * kv.x + q_s[384 + d + 1] * kv.y + q_s[384 + d + 2] * kv.z + q_s[384 + d + 3] * kv.w; }
    }
    const float scale = 0.08838834764831845f, fd = (float)dist;
    sc[0 * 2048 + j] = valid ? a0 * scale - exp2f(-(float)(kvh * 4 + 1)) * fd : -1e30f;
    sc[1 * 2048 + j] = valid ? a1 * scale - exp2f(-(float)(kvh * 4 + 2)) * fd : -1e30f;
    sc[2 * 2048 + j] = valid ? a2 * scale - exp2f(-(float)(kvh * 4 + 3)) * fd : -1e30f;
    sc[3 * 2048 + j] = valid ? a3 * scale - exp2f(-(float)(kvh * 4 + 4)) * fd : -1e30f;
}
__device__ __forceinline__ void ph4_nsa_sample(const Params& p, int u, unsigned char* lds) {
    int tid = threadIdx.x; asm volatile("" : "+v"(tid));
    const int wave = tid >> 6, lane = tid & 63, b = u >> 1, kvh = u & 1, row = NP + b, tpos = PAST;
    float* q_s = (float*)(lds + NS_Q); float* sc = (float*)(lds + NS_SC); int* sel_s = (int*)(lds + NS_SEL); float* red = (float*)(lds + NS_RED);
    const float* Pr = p.P + (size_t)row * INCP;
    q_s[tid] = Pr[C_Q + kvh * 512 + tid];
    __syncthreads();
    { int pos; bool valid; const float *kp, *vp; nsa_key<0, true>(p, b, tpos, kvh, tid, nullptr, pos, valid, kp, vp); ns_scores(q_s, kp, valid, tpos - pos, kvh, sc, tid); }
    __syncthreads();
    if (wave < 4) ns_softmax(sc + wave * 2048, 0, 512, lane, 1.f);
    __syncthreads();
    if (wave == 0) {
        const int cur = tpos >> 6, ncand = cur + 1;
        float val[5];
#pragma unroll
        for (int i = 0; i < 5; ++i) { const int blk = lane + 64 * i; float v = -INFINITY;
            if (blk < ncand) { const bool forced = blk == 0 || blk == cur || blk == cur - 1; float imp = 0.f;
                if (!forced) { for (int g = 0; g < 4; ++g) { if (2 * blk < 512) imp += sc[g * 2048 + 2 * blk]; if (2 * blk + 1 < 512) imp += sc[g * 2048 + 2 * blk + 1]; } }
                v = forced ? 1e4f : imp; }
            val[i] = v; }
        for (int r = 0; r < 16; ++r) {
            float bv = val[0]; int bi = lane;
#pragma unroll
            for (int i = 1; i < 5; ++i) if (val[i] > bv) { bv = val[i]; bi = lane + 64 * i; }
            for (int o = 32; o > 0; o >>= 1) { const float ov = __shfl_xor(bv, o); const int oi = __shfl_xor(bi, o); if (ov > bv || (ov == bv && oi < bi)) { bv = ov; bi = oi; } }
            if (lane == 0) sel_s[r] = bi;
#pragma unroll
            for (int i = 0; i < 5; ++i) if (lane + 64 * i == bi) val[i] = -INFINITY;
        }
    }
    __syncthreads();
#pragma unroll
    for (int i = 0; i < 3; ++i) { const int j = 512 + tid + 512 * i; int pos; bool valid; const float *kp, *vp;
        if (i < 2) nsa_key<1, true>(p, b, tpos, kvh, j - 512, sel_s, pos, valid, kp, vp); else nsa_key<2, true>(p, b, tpos, kvh, j - 1536, nullptr, pos, valid, kp, vp);
        ns_scores(q_s, kp, valid, tpos - pos, kvh, sc, j); }
    __syncthreads();
    { const int h = wave & 3, br = wave >> 2; const float gt = sigmoid_f(Pr[C_GTS + (kvh * 4 + h) * 3 + 1 + br]);
      ns_softmax(sc + h * 2048, br ? 1536 : 512, br ? 2048 : 1536, lane, gt);
      if (wave < 4) { const float g0 = sigmoid_f(Pr[C_GTS + (kvh * 4 + h) * 3]); for (int j = lane; j < 512; j += 64) sc[h * 2048 + j] *= g0; } }
    __syncthreads();
    { const int d4 = tid & 31, slice = tid >> 5;
      float4 a0 = make_float4(0.f, 0.f, 0.f, 0.f), a1 = a0, a2 = a0, a3 = a0;
#pragma unroll 16
      for (int i = 0; i < 128; ++i) { const int j = slice * 128 + i; int pos; bool valid; const float *kp, *vp;
          if (slice < 4) nsa_key<0, true>(p, b, tpos, kvh, j, nullptr, pos, valid, kp, vp);
          else if (slice < 12) nsa_key<1, true>(p, b, tpos, kvh, j - 512, sel_s, pos, valid, kp, vp);
          else nsa_key<2, true>(p, b, tpos, kvh, j - 1536, nullptr, pos, valid, kp, vp);
          const float4 v = *(const float4*)(vp + 4 * d4);
          const float w0 = sc[j], w1 = sc[2048 + j], w2 = sc[4096 + j], w3 = sc[6144 + j];
          a0.x += w0 * v.x; a0.y += w0 * v.y; a0.z += w0 * v.z; a0.w += w0 * v.w; a1.x += w1 * v.x; a1.y += w1 * v.y; a1.z += w1 * v.z; a1.w += w1 * v.w;
          a2.x += w2 * v.x; a2.y += w2 * v.y; a2.z += w2 * v.z; a2.w += w2 * v.w; a3.x += w3 * v.x; a3.y += w3 * v.y; a3.z += w3 * v.z; a3.w += w3 * v.w; }
      *(float4*)(red + (slice * 4 + 0) * 128 + 4 * d4) = a0; *(float4*)(red + (slice * 4 + 1) * 128 + 4 * d4) = a1;
      *(float4*)(red + (slice * 4 + 2) * 128 + 4 * d4) = a2; *(float4*)(red + (slice * 4 + 3) * 128 + 4 * d4) = a3; }
    __syncthreads();
    { const int h = tid >> 7, d = tid & 127; float o = 0.f;
#pragma unroll
      for (int s2 = 0; s2 < 16; ++s2) o += red[(s2 * 4 + h) * 128 + d];
      p.amix[(size_t)row * 2048 + (kvh * 4 + h) * 128 + d] = f2bf(o); }
    __syncthreads();
}
__device__ __forceinline__ void ph4_gdn(const Params& p, int u, float* smem) {
    float* qs = smem;
    float* ks = qs + 16 * 128;
    float* vs = ks + 16 * 128;
    float* ab = vs + 16 * 128;
    float* red = ab + 32;
    float* red2 = red + 512;
    const int tid = threadIdx.x, dv = tid & 127, grp = tid >> 7;
    const bool smp = u >= 32; const int v = smp ? u - 32 : u, b = v >> 3, h = v & 7;
    const int T = smp ? 1 : SEQ, row0 = smp ? NP + b : b * SEQ;
    float S[32];
#pragma unroll
    for (int i = 0; i < 32; ++i) S[i] = smp ? p.state_gdn[(((size_t)b * 8 + h) * 128 + grp * 32 + i) * 128 + dv] : 0.f;
    for (int t0 = 0; t0 < T; t0 += 16) {
        const int nst = (T - t0) < 16 ? (T - t0) : 16;
        __syncthreads();
        for (int i = tid; i < nst * 128; i += NTHR) { const int st = i >> 7, d = i & 127; const float* r = p.qkvn + (size_t)(row0 + t0 + st) * 3072 + h * 128 + d;
            qs[i] = r[0]; ks[i] = r[1024]; vs[i] = r[2048]; }
        if (tid < nst) { ab[tid * 2] = __expf(p.gg[(row0 + t0 + tid) * 8 + h]); ab[tid * 2 + 1] = p.gbeta[(row0 + t0 + tid) * 8 + h]; }
        __syncthreads();
        for (int st = 0; st < nst; ++st) {
            const float a = ab[st * 2], be = ab[st * 2 + 1];
            const float* kk = ks + st * 128 + grp * 32; const float* qq = qs + st * 128 + grp * 32;
            float part = 0.f;
#pragma unroll
            for (int i = 0; i < 32; ++i) part += kk[i] * S[i];
            red[grp * 128 + dv] = part;
            __syncthreads();
            const float kS = red[dv] + red[128 + dv] + red[256 + dv] + red[384 + dv];
            const float vn = be * (vs[st * 128 + dv] - a * kS);
            float op = 0.f;
#pragma unroll
            for (int i = 0; i < 32; ++i) { S[i] = a * S[i] + kk[i] * vn; op += qq[i] * S[i]; }
            red2[grp * 128 + dv] = op;
            __syncthreads();
            if (grp == 0) p.ograw[(size_t)(row0 + t0 + st) * 1024 + h * 128 + dv] = red2[dv] + red2[128 + dv] + red2[256 + dv] + red2[384 + dv];
        }
    }
    float* So = p.out + (smp ? O_GS : O_GP) + (((size_t)b * 8 + h) * 128) * 128;
#pragma unroll
    for (int i = 0; i < 32; ++i) So[(size_t)(grp * 32 + i) * 128 + dv] = S[i];
    __syncthreads();
}


constexpr int GA_Q = 0, GA_K = 17408, GA_T = GA_K, GA_VBT = 34816, GA_KBGT = 53248, GA_KDT = 71680, GA_QK = 90112, GA_AF = 99328, GA_WT = 99328, GA_UT = 117760, GA_SC = 136192;
__device__ __forceinline__ uint2 pack4(const f32x4& v) { uint2 w; w.x = pk2(v[0], v[1]); w.y = pk2(v[2], v[3]); return w; }
__device__ __forceinline__ void ph3_gdnA(const Params& p, int u, unsigned char* lds) {
    int tid = threadIdx.x; asm volatile("" : "+v"(tid));
    const int wave = tid >> 6, lane = tid & 63, r16 = lane & 15, quad = lane >> 4;
    const int n = u & 31, h = (u >> 5) & 7, b = u >> 8;
    const int row0 = b * SEQ + n * 64;
    float* sc_beta = (float*)(lds + GA_SC); float* sc_G = sc_beta + 64; float* sc_eG = sc_G + 64; float* sc_eGl = sc_eG + 64;
    if (tid < 64) {
        const float* Pr = p.P + (size_t)(row0 + tid) * INCP;
        const float be = sigmoid_f(Pr[C_BL + h]);
        float g = -__expf(p.a_log[h]) * softplus_f(Pr[C_AL + h] + p.dt_bias[h]);
        for (int o = 1; o < 64; o <<= 1) { const float tt = __shfl_up(g, o); if (lane >= o) g += tt; }
        const float Gl = __shfl(g, 63);
        sc_beta[tid] = be; sc_G[tid] = g; sc_eG[tid] = __expf(g); sc_eGl[tid] = __expf(Gl - g);
    }
    __syncthreads();
    {
        float cw[6][4];
#pragma unroll
        for (int e = 0; e < 6; ++e) { const int col = (e >> 1) * 1024 + h * 128 + lane + 64 * (e & 1);
#pragma unroll
            for (int i = 0; i < 4; ++i) cw[e][i] = p.conv_w[i * 3072 + col]; }
        float raw[11][6];
#pragma unroll
        for (int r = 0; r < 11; ++r) { const int tt = n * 64 + wave * 8 - 3 + r;
#pragma unroll
            for (int e = 0; e < 6; ++e) { const int col = C_QKV + (e >> 1) * 1024 + h * 128 + lane + 64 * (e & 1);
                raw[r][e] = tt >= 0 ? p.P[(size_t)(row0 + wave * 8 - 3 + r) * INCP + col] : 0.f; } }
#pragma unroll
        for (int ii = 0; ii < 8; ++ii) {
            const int c = wave * 8 + ii;
            float val[6];
#pragma unroll
            for (int e = 0; e < 6; ++e) { float acc = 0.f;
#pragma unroll
                for (int i = 0; i < 4; ++i) acc += raw[ii + i][e] * cw[e][i];
                val[e] = silu_f(acc); }
            const float rq = rsqrtf(wave_sum_sw(val[0] * val[0] + val[1] * val[1]) + 1e-6f) * 0.08838834764831845f;
            const float rk = rsqrtf(wave_sum_sw(val[2] * val[2] + val[3] * val[3]) + 1e-6f);
            const float be = sc_beta[c], eG = sc_eG[c], eGl = sc_eGl[c];
#pragma unroll
            for (int e2 = 0; e2 < 2; ++e2) { const int ch = lane + 64 * e2; const float kv = val[2 + e2] * rk;
                *(bf16_t*)(lds + GA_Q + c * 272 + ch * 2) = f2bf(val[e2] * rq);
                *(bf16_t*)(lds + GA_K + c * 272 + ch * 2) = f2bf(kv);
                *(bf16_t*)(lds + GA_KBGT + ch * 144 + c * 2) = f2bf(kv * be * eG);
                *(bf16_t*)(lds + GA_KDT + ch * 144 + c * 2) = f2bf(kv * eGl);
                *(bf16_t*)(lds + GA_VBT + ch * 144 + c * 2) = f2bf(val[4 + e2] * be); }
        }
    }
    __syncthreads();
    {
        const int sel = wave >> 2, rb = wave & 3;
        const unsigned char* Ab = lds + (sel ? GA_Q : GA_K) + (16 * rb + r16) * 272 + quad * 16;
        f32x4 acc[4];
#pragma unroll
        for (int cb = 0; cb < 4; ++cb) acc[cb] = (f32x4){0.f, 0.f, 0.f, 0.f};
#pragma unroll
        for (int ks = 0; ks < 4; ++ks) { const bf16x8 a = *(const bf16x8*)(Ab + ks * 64);
#pragma unroll
            for (int cb = 0; cb < 4; ++cb) { const bf16x8 bb = *(const bf16x8*)(lds + GA_K + (16 * cb + r16) * 272 + quad * 16 + ks * 64); acc[cb] = MFMA16(a, bb, acc[cb]); } }
        float* AF = (float*)(lds + GA_AF);
#pragma unroll
        for (int cb = 0; cb < 4; ++cb)
#pragma unroll
            for (int rg = 0; rg < 4; ++rg) { const int c = 16 * rb + 4 * quad + rg, m = 16 * cb + r16;
                const float dec = m <= c ? __expf(sc_G[c] - sc_G[m]) : 0.f;
                if (sel == 0) AF[c * 64 + m] = m < c ? sc_beta[c] * acc[cb][rg] * dec : 0.f;
                else *(bf16_t*)(lds + GA_QK + c * 144 + m * 2) = f2bf(acc[cb][rg] * dec); }
    }
    __syncthreads();
    if (wave == 0) {
        int zoff = 0; asm volatile("" : "+v"(zoff));
        const float* AF = (const float*)(lds + GA_AF) + zoff;
        float tc[64];
#pragma unroll
        for (int c = 0; c < 64; ++c) {
            f32x4 ar[16];
#pragma unroll
            for (int q = 0; q < (c + 3) / 4; ++q) ar[q] = *(const f32x4*)(AF + c * 64 + 4 * q);
            float acc = (c == lane) ? 1.f : 0.f, acc1 = 0.f;
#pragma unroll
            for (int m = 0; m < c; ++m) { if (m & 1) acc1 -= ar[m >> 2][m & 3] * tc[m]; else acc -= ar[m >> 2][m & 3] * tc[m]; }
            tc[c] = acc + acc1; }
#pragma unroll
        for (int c = 0; c < 64; ++c) *(bf16_t*)(lds + GA_T + c * 144 + lane * 2) = f2bf(tc[c]);
    }
    __syncthreads();
    {
        const int isW = wave >> 2;
        const unsigned char* Bs = lds + (isW ? GA_KBGT : GA_VBT); unsigned char* Ds = lds + (isW ? GA_WT : GA_UT);
#pragma unroll
        for (int cbi = 0; cbi < 2; ++cbi) { const int cb = (wave & 3) * 2 + cbi;
            bf16x8 bfr[2];
#pragma unroll
            for (int ks = 0; ks < 2; ++ks) bfr[ks] = *(const bf16x8*)(Bs + (16 * cb + r16) * 144 + ks * 64 + quad * 16);
#pragma unroll
            for (int rb = 0; rb < 4; ++rb) { f32x4 acc = (f32x4){0.f, 0.f, 0.f, 0.f};
#pragma unroll
                for (int ks = 0; ks < 2; ++ks) { const bf16x8 a = *(const bf16x8*)(lds + GA_T + (16 * rb + r16) * 144 + ks * 64 + quad * 16); acc = MFMA16(a, bfr[ks], acc); }
                *(uint2*)(Ds + (16 * cb + r16) * 144 + (16 * rb + 4 * quad) * 2) = pack4(acc); } }
    }
    __syncthreads();
    {
        bf16_t* gN = p.gN + (size_t)u * 16384; bf16_t* gBT = p.gBT + (size_t)u * 16384; bf16_t* gQp = p.gQp + (size_t)u * 8192; bf16_t* gOpT = p.gOpT + (size_t)u * 8192;
        {
            const bool isB = wave >= 4;
            const unsigned char* As = lds + (isB ? GA_KDT : GA_WT); const unsigned char* Bs = lds + (isB ? GA_UT : GA_KDT);
            bf16_t* dst = isB ? gBT : gN;
#pragma unroll
            for (int cbi = 0; cbi < 2; ++cbi) { const int cb = (wave & 3) * 2 + cbi;
                bf16x8 bfr[2];
#pragma unroll
                for (int ks = 0; ks < 2; ++ks) bfr[ks] = *(const bf16x8*)(Bs + (16 * cb + r16) * 144 + ks * 64 + quad * 16);
#pragma unroll
                for (int rb = 0; rb < 8; ++rb) { f32x4 acc = (f32x4){0.f, 0.f, 0.f, 0.f};
#pragma unroll
                    for (int ks = 0; ks < 2; ++ks) { const bf16x8 a = *(const bf16x8*)(As + (16 * rb + r16) * 144 + ks * 64 + quad * 16); acc = MFMA16(a, bfr[ks], acc); }
                    *(uint2*)(dst + (size_t)(16 * cb + r16) * 128 + 16 * rb + 4 * quad) = pack4(acc); } }
        }
        {
            bf16x8 afr[2];
#pragma unroll
            for (int ks = 0; ks < 2; ++ks) afr[ks] = *(const bf16x8*)(lds + GA_WT + (16 * wave + r16) * 144 + ks * 64 + quad * 16);
#pragma unroll
            for (int cb = 0; cb < 4; ++cb) { f32x4 acc = (f32x4){0.f, 0.f, 0.f, 0.f};
#pragma unroll
                for (int ks = 0; ks < 2; ++ks) { const bf16x8 bb = *(const bf16x8*)(lds + GA_QK + (16 * cb + r16) * 144 + ks * 64 + quad * 16); acc = MFMA16(afr[ks], bb, acc); }
                const int c = 16 * cb + r16, dk0 = 16 * wave + 4 * quad; const float eG = sc_eG[c];
                const uint2 qv = *(const uint2*)(lds + GA_Q + c * 272 + dk0 * 2);
                f32x4 o; o[0] = __uint_as_float(qv.x << 16) * eG - acc[0]; o[1] = __uint_as_float(qv.x & 0xffff0000u) * eG - acc[1]; o[2] = __uint_as_float(qv.y << 16) * eG - acc[2]; o[3] = __uint_as_float(qv.y & 0xffff0000u) * eG - acc[3];
                *(uint2*)(gQp + (size_t)c * 128 + dk0) = pack4(o); }
        }
        {
            bf16x8 bfr[2];
#pragma unroll
            for (int ks = 0; ks < 2; ++ks) bfr[ks] = *(const bf16x8*)(lds + GA_UT + (16 * wave + r16) * 144 + ks * 64 + quad * 16);
#pragma unroll
            for (int rb = 0; rb < 4; ++rb) { f32x4 acc = (f32x4){0.f, 0.f, 0.f, 0.f};
#pragma unroll
                for (int ks = 0; ks < 2; ++ks) { const bf16x8 a = *(const bf16x8*)(lds + GA_QK + (16 * rb + r16) * 144 + ks * 64 + quad * 16); acc = MFMA16(a, bfr[ks], acc); }
                *(uint2*)(gOpT + (size_t)(16 * wave + r16) * 64 + 16 * rb + 4 * quad) = pack4(acc); }
        }
        if (tid == 0) p.ggl[u] = sc_eG[63];
    }
    __syncthreads();
}
constexpr int GB_N0 = 0, GB_N1 = 34816;
struct GBSet { u32x4 nreg[4]; u32x2 breg[8]; };
__device__ __forceinline__ void gb_load(const Params& p, size_t ci, int tid, int dv, int quad, GBSet& s) {
    const bf16_t* gN = p.gN + ci * 16384; const bf16_t* gB = p.gBT + ci * 16384;
#pragma unroll
    for (int i = 0; i < 4; ++i) s.nreg[i] = *(const u32x4*)(gN + (size_t)(tid + 512 * i) * 8);
    if (tid < 256) {
#pragma unroll
        for (int rb = 0; rb < 8; ++rb) s.breg[rb] = *(const u32x2*)(gB + (size_t)dv * 128 + 16 * rb + 4 * quad); }
}
__device__ __forceinline__ void gb_step(const Params& p, int u, int n, float gl, unsigned char* lds, int tid, int r16, int quad, int dv, GBSet& s, f32x4 (&S)[8]) {
    const size_t ci = (size_t)u * 32 + n;
    const bool owner = tid < 256;
    bf16_t* gS = p.gST + ci * 16384 + (size_t)dv * 128 + 4 * quad;
    if (owner) {
#pragma unroll
        for (int rb = 0; rb < 8; ++rb) *(uint2*)(gS + 16 * rb) = pack4(S[rb]); }
    bf16x8 bfr[4];
#pragma unroll
    for (int ks = 0; ks < 4; ++ks) bfr[ks] = pack8(S[2 * ks][0], S[2 * ks][1], S[2 * ks][2], S[2 * ks][3], S[2 * ks + 1][0], S[2 * ks + 1][1], S[2 * ks + 1][2], S[2 * ks + 1][3]);
    unsigned char* buf = lds + ((n & 1) ? GB_N1 : GB_N0);
#pragma unroll
    for (int i = 0; i < 4; ++i) { const int idx = tid + 512 * i; *(u32x4*)(buf + (idx >> 4) * 272 + (idx & 15) * 16) = s.nreg[i]; }
    f32x4 Bv[8];
#pragma unroll
    for (int rb = 0; rb < 8; ++rb) { Bv[rb][0] = __uint_as_float(s.breg[rb].x << 16); Bv[rb][1] = __uint_as_float(s.breg[rb].x & 0xffff0000u); Bv[rb][2] = __uint_as_float(s.breg[rb].y << 16); Bv[rb][3] = __uint_as_float(s.breg[rb].y & 0xffff0000u); }
    __syncthreads();
    gb_load(p, (size_t)u * 32 + (n + 2 < 32 ? n + 2 : 31), tid, dv, quad, s);
    if (owner)
#pragma unroll
    for (int rb = 0; rb < 8; ++rb) { f32x4 acc = (f32x4){0.f, 0.f, 0.f, 0.f};
        u32x4 av[4];
#pragma unroll
        for (int ks = 0; ks < 4; ++ks) { const unsigned char* ap = buf + (16 * rb + r16) * 272 + (32 * ks + 4 * quad) * 2;
            const uint2 lo = *(const uint2*)ap, hi = *(const uint2*)(ap + 32); av[ks][0] = lo.x; av[ks][1] = lo.y; av[ks][2] = hi.x; av[ks][3] = hi.y; }
#pragma unroll
        for (int ks = 0; ks < 4; ++ks) acc = MFMA16(__builtin_bit_cast(bf16x8, av[ks]), bfr[ks], acc);
#pragma unroll
        for (int rg = 0; rg < 4; ++rg) S[rb][rg] = gl * S[rb][rg] + Bv[rb][rg] - acc[rg]; }
}
__device__ __forceinline__ void ph4_gdnB(const Params& p, int uu, unsigned char* lds) {
    const int u = uu >> 1, half = uu & 1;
    const int tid = threadIdx.x, wave = tid >> 6, lane = tid & 63, r16 = lane & 15, quad = lane >> 4, dv = 64 * half + 16 * (wave & 3) + r16;
    f32x4 S[8];
#pragma unroll
    for (int rb = 0; rb < 8; ++rb) S[rb] = (f32x4){0.f, 0.f, 0.f, 0.f};
    GBSet A, B;
    gb_load(p, (size_t)u * 32, tid, dv, quad, A);
    gb_load(p, (size_t)u * 32 + 1, tid, dv, quad, B);
    const float glv = p.ggl[(size_t)u * 32 + (lane & 31)];
#pragma unroll 1
    for (int n = 0; n < 32; n += 2) {
        gb_step(p, u, n, __shfl(glv, n), lds, tid, r16, quad, dv, A, S);
        gb_step(p, u, n + 1, __shfl(glv, n + 1), lds, tid, r16, quad, dv, B, S);
    }
    float* So = p.out + O_GP + (size_t)u * 16384;
    if (tid < 256) {
#pragma unroll
        for (int rb = 0; rb < 8; ++rb)
#pragma unroll
            for (int rg = 0; rg < 4; ++rg) So[(size_t)(16 * rb + 4 * quad + rg) * 128 + dv] = S[rb][rg]; }
    __syncthreads();
}
__device__ __forceinline__ void ph5_gdnC(const Params& p, int u, unsigned char* lds) {
    const int tid = threadIdx.x, wave = tid >> 6, lane = tid & 63, r16 = lane & 15, quad = lane >> 4, dv = 16 * wave + r16;
    const int n = u & 31, h = (u >> 5) & 7, b = u >> 8, row0 = b * SEQ + n * 64;
    const bf16_t* Qp = p.gQp + (size_t)u * 8192; const bf16_t* ST = p.gST + (size_t)u * 16384; const bf16_t* OpT = p.gOpT + (size_t)u * 8192;
    bf16x8 bfr[4];
#pragma unroll
    for (int ks = 0; ks < 4; ++ks) bfr[ks] = *(const bf16x8*)(ST + (size_t)dv * 128 + 32 * ks + 8 * quad);
    float zv[4][4];
#pragma unroll
    for (int rb = 0; rb < 4; ++rb)
#pragma unroll
        for (int rg = 0; rg < 4; ++rg) zv[rb][rg] = p.P[(size_t)(row0 + 16 * rb + 4 * quad + rg) * INCP + C_Z + h * 128 + dv];
    f32x4 o[4];
#pragma unroll
    for (int rb = 0; rb < 4; ++rb) { f32x4 acc = (f32x4){0.f, 0.f, 0.f, 0.f};
#pragma unroll
        for (int ks = 0; ks < 4; ++ks) { const bf16x8 a = *(const bf16x8*)(Qp + (size_t)(16 * rb + r16) * 128 + 32 * ks + 8 * quad); acc = MFMA16(a, bfr[ks], acc); }
        const uint2 op = *(const uint2*)(OpT + (size_t)dv * 64 + 16 * rb + 4 * quad);
        acc[0] += __uint_as_float(op.x << 16); acc[1] += __uint_as_float(op.x & 0xffff0000u); acc[2] += __uint_as_float(op.y << 16); acc[3] += __uint_as_float(op.y & 0xffff0000u);
        o[rb] = acc; }
    float* part = (float*)lds;
#pragma unroll
    for (int rb = 0; rb < 4; ++rb)
#pragma unroll
        for (int rg = 0; rg < 4; ++rg) { float v = o[rb][rg] * o[rb][rg]; v += __shfl_xor(v, 1); v += __shfl_xor(v, 2); v += __shfl_xor(v, 4); v += __shfl_xor(v, 8);
            if (r16 == 0) part[wave * 64 + 16 * rb + 4 * quad + rg] = v; }
    __syncthreads();
    const float gw = p.gdn_norm[dv];
#pragma unroll
    for (int rb = 0; rb < 4; ++rb)
#pragma unroll
        for (int rg = 0; rg < 4; ++rg) { const int c = 16 * rb + 4 * quad + rg;
            const float tot = part[c] + part[64 + c] + part[128 + c] + part[192 + c] + part[256 + c] + part[320 + c] + part[384 + c] + part[448 + c];
            const float rstd = rsqrtf(tot * (1.f / 128.f) + 1e-6f);
            p.amix[(size_t)(row0 + c) * 2048 + 1024 + h * 128 + dv] = f2bf(o[rb][rg] * rstd * gw * silu_f(zv[rb][rg])); }
    __syncthreads();
}

__device__ __forceinline__ void ph5_gdnout(const Params& p, int row) {
    const int wave = threadIdx.x >> 6, lane = threadIdx.x & 63, h = wave;
    const float* o = p.ograw + (size_t)row * 1024 + h * 128; const float* z = p.P + (size_t)row * INCP + C_Z + h * 128;
    const float a = o[2 * lane], b = o[2 * lane + 1];
    const float ss = wave_sum(a * a + b * b);
    const float r = rsqrtf(ss * (1.f / 128.f) + 1e-6f);
    const float y0 = a * r * p.gdn_norm[2 * lane] * silu_f(z[2 * lane]), y1 = b * r * p.gdn_norm[2 * lane + 1] * silu_f(z[2 * lane + 1]);
    *(unsigned*)(p.amix + (size_t)row * 2048 + 1024 + h * 128 + 2 * lane) = (unsigned)f2bf(y0) | ((unsigned)f2bf(y1) << 16);
}

__device__ __forceinline__ void ph9_peer(const Params& p, int row, float* smem) {
    float* qs = smem;
    float* hs = qs + 2048;
    float* ssc = hs + 2048;
    float* s_half = ssc + 2048;
    int* i_half = (int*)(s_half + 256);
    float* wgt = (float*)(i_half + 256);
    int* eid = (int*)(wgt + 128);
    float* red = (float*)(eid + 128);
    int tid = threadIdx.x; asm volatile("" : "+v"(tid));
    const int wave = tid >> 6, lane = tid & 63;
    for (int i = tid; i < 2048; i += NTHR) { qs[i] = p.qp[(size_t)row * 2048 + i]; hs[i] = p.h2f[(size_t)row * 2048 + i]; }
    __syncthreads();
    for (int i = 0; i < 4; ++i) { const int idx = tid + NTHR * i, hp = idx >> 7, k = idx & 127, half = hp & 1;
        const float* kr = p.peer_keys + ((size_t)half * 128 + k) * 128; const float* qq = qs + (hp >> 1) * 256 + half * 128;
        float acc = 0.f; for (int d = 0; d < 128; d += 4) { const float4 kv = *(const float4*)(kr + d); acc += qq[d] * kv.x + qq[d + 1] * kv.y + qq[d + 2] * kv.z + qq[d + 3] * kv.w; }
        ssc[idx] = acc; }
    __syncthreads();
    for (int li = 0; li < 2; ++li) { const int hp = wave * 2 + li;
        float v0 = ssc[hp * 128 + lane], v1 = ssc[hp * 128 + 64 + lane];
        for (int r = 0; r < 16; ++r) {
            float bv = v0; int bi = lane; if (v1 > bv) { bv = v1; bi = lane + 64; }
            for (int o = 32; o > 0; o >>= 1) { const float ov = __shfl_xor(bv, o); const int oi = __shfl_xor(bi, o); if (ov > bv || (ov == bv && oi < bi)) { bv = ov; bi = oi; } }
            if (lane == 0) { s_half[hp * 16 + r] = bv; i_half[hp * 16 + r] = bi; }
            if (bi == lane) v0 = -INFINITY; if (bi == lane + 64) v1 = -INFINITY;
        } }
    __syncthreads();
    { const int h = wave; float cv[4];
#pragma unroll
      for (int c = 0; c < 4; ++c) { const int f = lane + 64 * c; cv[c] = s_half[(h * 2) * 16 + (f >> 4)] + s_half[(h * 2 + 1) * 16 + (f & 15)]; }
      float bs_mine = 0.f; int e_mine = 0;
      for (int r = 0; r < 16; ++r) {
          float bv = cv[0]; int bi = lane;
#pragma unroll
          for (int c = 1; c < 4; ++c) if (cv[c] > bv) { bv = cv[c]; bi = lane + 64 * c; }
          for (int o = 32; o > 0; o >>= 1) { const float ov = __shfl_xor(bv, o); const int oi = __shfl_xor(bi, o); if (ov > bv || (ov == bv && oi < bi)) { bv = ov; bi = oi; } }
          if (lane == r) { bs_mine = bv; e_mine = i_half[(h * 2) * 16 + (bi >> 4)] * 128 + i_half[(h * 2 + 1) * 16 + (bi & 15)]; }
#pragma unroll
          for (int c = 0; c < 4; ++c) if (lane + 64 * c == bi) cv[c] = -INFINITY;
      }
      float mx = lane < 16 ? bs_mine : -INFINITY; mx = wave_max(mx);
      const float ex = lane < 16 ? __expf(bs_mine - mx) : 0.f; const float den = wave_sum(ex);
      const float gate = ex / den;
      for (int r = 0; r < 16; ++r) { const int e = __shfl(e_mine, r); const float* ur = p.peer_u + (size_t)e * 2048;
          float acc = 0.f;
#pragma unroll
          for (int i = 0; i < 8; ++i) { const int c = i * 256 + lane * 4; const float4 uv = *(const float4*)(ur + c); acc += hs[c] * uv.x + hs[c + 1] * uv.y + hs[c + 2] * uv.z + hs[c + 3] * uv.w; }
          acc = wave_sum(acc);
          const float g = __shfl(gate, r);
          if (lane == 0) { wgt[h * 16 + r] = g * gelu_tanh(acc); eid[h * 16 + r] = e; } }
    }
    __syncthreads();
    float4 o = make_float4(0.f, 0.f, 0.f, 0.f);
    for (int j = 0; j < 128; ++j) { const float w = wgt[j]; const float4 vv = *(const float4*)(p.peer_v + (size_t)eid[j] * 2048 + tid * 4); o.x += w * vv.x; o.y += w * vv.y; o.z += w * vv.z; o.w += w * vv.w; }
    const int mrow = row < NP ? row / SEQ : 4 + (row - NP);
    const float4 g2 = *(const float4*)(p.mod + (size_t)mrow * 12288 + 10240 + tid * 4);
    const float4 xv = *(const float4*)(p.x1 + (size_t)row * 2048 + tid * 4);
    float4 x2; x2.x = xv.x + g2.x * o.x; x2.y = xv.y + g2.y * o.y; x2.z = xv.z + g2.z * o.z; x2.w = xv.w + g2.w * o.w;
    float ss = wave_sum(x2.x * x2.x + x2.y * x2.y + x2.z * x2.z + x2.w * x2.w);
    if (lane == 0) red[wave] = ss;
    __syncthreads();
    ss = red[0] + red[1] + red[2] + red[3] + red[4] + red[5] + red[6] + red[7];
    const float rstd = rsqrtf(ss * (1.f / 2048.f) + 1e-6f);
    const float4 fw = *(const float4*)(p.final_norm + tid * 4);
    float4 y; y.x = x2.x * rstd * fw.x; y.y = x2.y * rstd * fw.y; y.z = x2.z * rstd * fw.z; y.w = x2.w * rstd * fw.w;
    float* dst = row < NP ? p.out + O_YP + (size_t)row * 2048 : p.out + O_YS + (size_t)(row - NP) * 2048;
    *(float4*)(dst + tid * 4) = y;
    __syncthreads();
}


constexpr int PK_SH = 0, PK_IH = 16384, PK_EID = 32768, PK_GATE = 40960, PK_KH = 49152, PK_KL = 83968;
__device__ __forceinline__ void split8(const float4& a, const float4& b, bf16x8& hi, bf16x8& lo) {
    hi = pack8(a.x, a.y, a.z, a.w, b.x, b.y, b.z, b.w);
    const u32x4 hb = __builtin_bit_cast(u32x4, hi);
    lo = pack8(a.x - __uint_as_float(hb[0] << 16), a.y - __uint_as_float(hb[0] & 0xffff0000u), a.z - __uint_as_float(hb[1] << 16), a.w - __uint_as_float(hb[1] & 0xffff0000u),
               b.x - __uint_as_float(hb[2] << 16), b.y - __uint_as_float(hb[2] & 0xffff0000u), b.z - __uint_as_float(hb[3] << 16), b.w - __uint_as_float(hb[3] & 0xffff0000u));
}
__device__ __forceinline__ float dot8(const u32x4& a, const u32x4& b, float acc) {
#pragma unroll
    for (int k = 0; k < 4; ++k) { const unsigned ak = a[k], bk = b[k];
        acc = __builtin_amdgcn_fdot2_f32_bf16(__builtin_bit_cast(bf2_t, ak), __builtin_bit_cast(bf2_t, bk), acc, false); }
    return acc;
}

#ifndef PEER_DBG
#define PEER_DBG 0
#endif
__device__ __forceinline__ void peer_topk_naive(const Params& p, int row, int tk, unsigned char* lds) {
    float* qs = (float*)(lds + 65536);
    float* ssc = qs + 2048;
    float* s_half = ssc + 2048;
    int* i_half = (int*)(s_half + 256);
    int* eidL = (int*)(lds + PK_EID); float* gateL = (float*)(lds + PK_GATE);
    const int tid = threadIdx.x, wave = tid >> 6, lane = tid & 63;
    for (int i = tid; i < 2048; i += NTHR) qs[i] = p.qp[(size_t)row * 2048 + i];
    __syncthreads();
    for (int i = 0; i < 4; ++i) { const int idx = tid + NTHR * i, hp = idx >> 7, k = idx & 127, half = hp & 1;
        const float* kr = p.peer_keys + ((size_t)half * 128 + k) * 128; const float* qq = qs + (hp >> 1) * 256 + half * 128;
        float acc = 0.f; for (int d = 0; d < 128; d += 4) { const float4 kv = *(const float4*)(kr + d); acc += qq[d] * kv.x + qq[d + 1] * kv.y + qq[d + 2] * kv.z + qq[d + 3] * kv.w; }
        ssc[idx] = acc; }
    __syncthreads();
    for (int li = 0; li < 2; ++li) { const int hp = wave * 2 + li;
        float v0 = ssc[hp * 128 + lane], v1 = ssc[hp * 128 + 64 + lane];
        for (int r = 0; r < 16; ++r) {
            float bv = v0; int bi = lane; if (v1 > bv) { bv = v1; bi = lane + 64; }
            for (int o = 32; o > 0; o >>= 1) { const float ov = __shfl_xor(bv, o); const int oi = __shfl_xor(bi, o); if (ov > bv || (ov == bv && oi < bi)) { bv = ov; bi = oi; } }
            if (lane == 0) { s_half[hp * 16 + r] = bv; i_half[hp * 16 + r] = bi; }
            if (bi == lane) v0 = -INFINITY; if (bi == lane + 64) v1 = -INFINITY;
        } }
    __syncthreads();
    { const int h = wave; float cv[4];
#pragma unroll
      for (int c = 0; c < 4; ++c) { const int f = lane + 64 * c; cv[c] = s_half[(h * 2) * 16 + (f >> 4)] + s_half[(h * 2 + 1) * 16 + (f & 15)]; }
      float bs_mine = 0.f; int e_mine = 0;
      for (int r = 0; r < 16; ++r) {
          float bv = cv[0]; int bi = lane;
#pragma unroll
          for (int c = 1; c < 4; ++c) if (cv[c] > bv) { bv = cv[c]; bi = lane + 64 * c; }
          for (int o = 32; o > 0; o >>= 1) { const float ov = __shfl_xor(bv, o); const int oi = __shfl_xor(bi, o); if (ov > bv || (ov == bv && oi < bi)) { bv = ov; bi = oi; } }
          if (lane == r) { bs_mine = bv; e_mine = i_half[(h * 2) * 16 + (bi >> 4)] * 128 + i_half[(h * 2 + 1) * 16 + (bi & 15)]; }
#pragma unroll
          for (int c = 0; c < 4; ++c) if (lane + 64 * c == bi) cv[c] = -INFINITY;
      }
      float mx = lane < 16 ? bs_mine : -INFINITY; mx = wave_max(mx);
      const float ex = lane < 16 ? __expf(bs_mine - mx) : 0.f; const float den = wave_sum(ex);
      if (lane < 16) { eidL[tk * 128 + h * 16 + lane] = e_mine; gateL[tk * 128 + h * 16 + lane] = ex / den; }
    }
    __syncthreads();
}
template <bool LATE>
__device__ __forceinline__ void ph9_peer_fast(const Params& p, int u, unsigned char* lds) {
    int tid = threadIdx.x; asm volatile("" : "+v"(tid));
    const int wave = tid >> 6, lane = tid & 63, r16 = lane & 15, quad = lane >> 4;
    float* sh = (float*)(lds + PK_SH); int* ih = (int*)(lds + PK_IH); int* eidL = (int*)(lds + PK_EID); float* gateL = (float*)(lds + PK_GATE);
    const int tok0 = u * 16;
#if PEER_DBG == 1
    for (int tk = 0; tk < 16; ++tk) peer_topk_naive(p, tok0 + tk < NTOK ? tok0 + tk : NTOK - 1, tk, lds);
#else
    {
        const int row = tok0 + r16 < NTOK ? tok0 + r16 : NTOK - 1, head = wave;
        const int lbase = (wave * 16 + r16) * 32;
#pragma unroll 1
        for (int half = 0; half < 2; ++half) {
            bf16x8 qh[4], ql[4];
            const float* qrow = p.qp + (size_t)row * 2048 + head * 256 + half * 128 + 8 * quad;
#pragma unroll
            for (int ks = 0; ks < 4; ++ks) split8(*(const float4*)(qrow + 32 * ks), *(const float4*)(qrow + 32 * ks + 4), qh[ks], ql[ks]);
            __syncthreads();
#pragma unroll
            for (int i = 0; i < 4; ++i) { const int id = tid + 512 * i, kr = id >> 4, part = id & 15; const size_t go = (size_t)(half * 128 + kr) * 128 + part * 8;
                *(u32x4*)(lds + PK_KH + kr * 272 + part * 16) = *(const u32x4*)(p.kh + go); *(u32x4*)(lds + PK_KL + kr * 272 + part * 16) = *(const u32x4*)(p.kl + go); }
            __syncthreads();
            f32x4 acc[8];
#pragma unroll
            for (int kb = 0; kb < 8; ++kb) { acc[kb] = (f32x4){0.f, 0.f, 0.f, 0.f};
                const int ko = (16 * kb + r16) * 272 + quad * 16;
                bf16x8 ahv[4], alv[4];
#pragma unroll
                for (int ks = 0; ks < 4; ++ks) { ahv[ks] = *(const bf16x8*)(lds + PK_KH + ko + 64 * ks); alv[ks] = *(const bf16x8*)(lds + PK_KL + ko + 64 * ks); }
#pragma unroll
                for (int ks = 0; ks < 4; ++ks) { acc[kb] = MFMA16(ahv[ks], qh[ks], acc[kb]); acc[kb] = MFMA16(ahv[ks], ql[ks], acc[kb]); acc[kb] = MFMA16(alv[ks], qh[ks], acc[kb]); } }
#pragma unroll 1
            for (int r = 0; r < 16; ++r) {
                float bv = acc[0][0]; int bi = 4 * quad;
#pragma unroll
                for (int kb = 0; kb < 8; ++kb)
#pragma unroll
                    for (int rg = 0; rg < 4; ++rg) if (acc[kb][rg] > bv) { bv = acc[kb][rg]; bi = 16 * kb + 4 * quad + rg; }
#pragma unroll
                for (int o = 16; o <= 32; o <<= 1) { const float ov = __shfl_xor(bv, o); const int oi = __shfl_xor(bi, o); if (ov > bv || (ov == bv && oi < bi)) { bv = ov; bi = oi; } }
                if (quad == 0) { sh[lbase + half * 16 + r] = bv; ih[lbase + half * 16 + r] = bi; }
#pragma unroll
                for (int kb = 0; kb < 8; ++kb)
#pragma unroll
                    for (int rg = 0; rg < 4; ++rg) if (bi == 16 * kb + 4 * quad + rg) acc[kb][rg] = -INFINITY;
            }
        }
        __syncthreads();
        float s0v[4], cur[4]; int ptr[4];
#pragma unroll
        for (int ii = 0; ii < 4; ++ii) { s0v[ii] = sh[lbase + 4 * quad + ii]; ptr[ii] = 0; cur[ii] = s0v[ii] + sh[lbase + 16]; }
        float bs[16]; int be[16];
#pragma unroll
        for (int r = 0; r < 16; ++r) {
            float bv = cur[0]; int bi = 4 * quad, bj = ptr[0];
#pragma unroll
            for (int ii = 1; ii < 4; ++ii) if (cur[ii] > bv) { bv = cur[ii]; bi = 4 * quad + ii; bj = ptr[ii]; }
#pragma unroll
            for (int o = 16; o <= 32; o <<= 1) { const float ov = __shfl_xor(bv, o); const int oi = __shfl_xor(bi, o), oj = __shfl_xor(bj, o); if (ov > bv || (ov == bv && oi < bi)) { bv = ov; bi = oi; bj = oj; } }
            bs[r] = bv; be[r] = ih[lbase + bi] * 128 + ih[lbase + 16 + bj];
#pragma unroll
            for (int ii = 0; ii < 4; ++ii) if (bi == 4 * quad + ii) { ptr[ii] += 1; cur[ii] = ptr[ii] < 16 ? s0v[ii] + sh[lbase + 16 + (ptr[ii] & 15)] : -INFINITY; }
        }
        float den = 0.f; const float bmax = bs[0];
#pragma unroll
        for (int r = 0; r < 16; ++r) { bs[r] = __expf(bs[r] - bmax); den += bs[r]; }
        const float dinv = 1.f / den;
        if (quad == 0) {
#pragma unroll
            for (int r = 0; r < 16; ++r) { eidL[r16 * 128 + head * 16 + r] = be[r]; gateL[r16 * 128 + head * 16 + r] = bs[r] * dinv; } }
        if (quad == 0 && tok0 + r16 < NTOK) {
#pragma unroll
            for (int r = 0; r < 16; ++r) { int* pe = p.pk_eid + (size_t)(tok0 + r16) * 128 + head * 16 + r; float* pg = p.pk_gate + (size_t)(tok0 + r16) * 128 + head * 16 + r;
                if (LATE) { __hip_atomic_store(pe, be[r], __ATOMIC_RELAXED, __HIP_MEMORY_SCOPE_AGENT); __hip_atomic_store(pg, bs[r] * dinv, __ATOMIC_RELAXED, __HIP_MEMORY_SCOPE_AGENT); }
                else { *pe = be[r]; *pg = bs[r] * dinv; } } }
    }
#endif
    __syncthreads();
}

__device__ __forceinline__ float dot16_fp8(const u32x4& q, const float* h, float acc) {
    f32x2 a2 = (f32x2){acc, 0.f};
#pragma unroll
    for (int k = 0; k < 4; ++k) { const int w = (int)q[k]; const f32x2 lo = __builtin_amdgcn_cvt_pk_f32_fp8(w, false), hi = __builtin_amdgcn_cvt_pk_f32_fp8(w, true);
        a2 = __builtin_elementwise_fma(lo, (f32x2){h[4 * k], h[4 * k + 1]}, a2); a2 = __builtin_elementwise_fma(hi, (f32x2){h[4 * k + 2], h[4 * k + 3]}, a2); }
    return a2[0] + a2[1];
}
__device__ __forceinline__ void axpy16_fp8(const u32x4& q, float w, float* o) {
    const f32x2 w2 = (f32x2){w, w};
#pragma unroll
    for (int k = 0; k < 4; ++k) { const int x = (int)q[k]; const f32x2 lo = __builtin_amdgcn_cvt_pk_f32_fp8(x, false), hi = __builtin_amdgcn_cvt_pk_f32_fp8(x, true);
        const f32x2 a = __builtin_elementwise_fma(w2, lo, (f32x2){o[4 * k], o[4 * k + 1]}), b = __builtin_elementwise_fma(w2, hi, (f32x2){o[4 * k + 2], o[4 * k + 3]});
        o[4 * k] = a[0]; o[4 * k + 1] = a[1]; o[4 * k + 2] = b[0]; o[4 * k + 3] = b[1]; }
}
__device__ __forceinline__ void ph10_token(const Params& p, int row, int lane) {
    asm volatile("" : "+v"(lane));
    float hv[32];
    { const float* hr = p.h2f + (size_t)row * 2048 + lane * 16;
#pragma unroll
      for (int c = 0; c < 2; ++c)
#pragma unroll
          for (int k = 0; k < 4; ++k) { const float4 t = *(const float4*)(hr + c * 1024 + 4 * k); hv[c * 16 + 4 * k] = t.x; hv[c * 16 + 4 * k + 1] = t.y; hv[c * 16 + 4 * k + 2] = t.z; hv[c * 16 + 4 * k + 3] = t.w; } }
    const int e_lo = p.pk_eid[(size_t)row * 128 + lane], e_hi = p.pk_eid[(size_t)row * 128 + 64 + lane];
    const float g_lo = p.pk_gate[(size_t)row * 128 + lane], g_hi = p.pk_gate[(size_t)row * 128 + 64 + lane];
    float w_lo = 0.f, w_hi = 0.f;
#pragma unroll 1
    for (int j0 = 0; j0 < 128; j0 += 8) {
        u32x4 uv[8][2]; float su[8];
#pragma unroll
        for (int jj = 0; jj < 8; ++jj) { const int j = j0 + jj; const int e = __shfl(j < 64 ? e_lo : e_hi, j & 63); const unsigned char* ur = p.u8 + (size_t)e * 2048 + lane * 16;
            uv[jj][0] = *(const u32x4*)ur; uv[jj][1] = *(const u32x4*)(ur + 1024); su[jj] = p.us[e]; }
#pragma unroll
        for (int jj = 0; jj < 8; ++jj) { const int j = j0 + jj; float d = dot16_fp8(uv[jj][0], hv, 0.f); d = dot16_fp8(uv[jj][1], hv + 16, d);
            d = wave_sum_sw(d) * su[jj];
            const float w = __shfl(j < 64 ? g_lo : g_hi, j & 63) * gelu_tanh(d);
            if (lane == (j & 63)) { if (j < 64) w_lo = w; else w_hi = w; }
            __builtin_amdgcn_sched_barrier(0); }
    }
    float out[32];
#pragma unroll
    for (int k = 0; k < 32; ++k) out[k] = 0.f;
#pragma unroll 1
    for (int j0 = 0; j0 < 128; j0 += 4) {
        u32x4 vv[4][2]; float sv[4];
#pragma unroll
        for (int jj = 0; jj < 4; ++jj) { const int j = j0 + jj; const int e = __shfl(j < 64 ? e_lo : e_hi, j & 63); const unsigned char* vr = p.v8 + (size_t)e * 2048 + lane * 16;
            vv[jj][0] = *(const u32x4*)vr; vv[jj][1] = *(const u32x4*)(vr + 1024); sv[jj] = p.vs[e]; }
#pragma unroll
        for (int jj = 0; jj < 4; ++jj) { const int j = j0 + jj; const float w = __shfl(j < 64 ? w_lo : w_hi, j & 63) * sv[jj];
            axpy16_fp8(vv[jj][0], w, out); axpy16_fp8(vv[jj][1], w, out + 16); __builtin_amdgcn_sched_barrier(0); }
    }
    asm volatile("" : "+s"(row));
    const int mrow = row < NP ? row / SEQ : 4 + (row - NP);
    const float* g2 = p.mod + (size_t)mrow * 12288 + 10240 + lane * 16; const float* x1 = p.x1 + (size_t)row * 2048 + lane * 16;
    float ss = 0.f;
#pragma unroll
    for (int c = 0; c < 2; ++c)
#pragma unroll
        for (int k = 0; k < 16; k += 4) { const float4 xv = *(const float4*)(x1 + c * 1024 + k), gv = *(const float4*)(g2 + c * 1024 + k); float* o = out + c * 16 + k;
            o[0] = xv.x + gv.x * o[0]; o[1] = xv.y + gv.y * o[1]; o[2] = xv.z + gv.z * o[2]; o[3] = xv.w + gv.w * o[3];
            ss += o[0] * o[0] + o[1] * o[1] + o[2] * o[2] + o[3] * o[3]; }
    ss = wave_sum_sw(ss);
    const float rstd = rsqrtf(ss * (1.f / 2048.f) + 1e-6f);
    float* dst = (row < NP ? p.out + O_YP + (size_t)row * 2048 : p.out + O_YS + (size_t)(row - NP) * 2048) + lane * 16;
#pragma unroll
    for (int c = 0; c < 2; ++c)
#pragma unroll
        for (int k = 0; k < 16; k += 4) { const float4 fw = *(const float4*)(p.final_norm + lane * 16 + c * 1024 + k); const float* o = out + c * 16 + k;
            float4 y; y.x = o[0] * rstd * fw.x; y.y = o[1] * rstd * fw.y; y.z = o[2] * rstd * fw.z; y.w = o[3] * rstd * fw.w;
            *(float4*)(dst + c * 1024 + k) = y; }
}
__device__ __forceinline__ void ph10_gather(const Params& p, unsigned qword) {
    const int lane = threadIdx.x & 63;
    for (;;) {
        unsigned coff = qword; asm volatile("" : "+v"(coff));
        unsigned t = 0; if (lane == 0) t = atomicAdd(p.bar + coff, 1u);
        t = (unsigned)__builtin_amdgcn_readfirstlane((int)t);
        if (t >= (unsigned)NTOK) break;
        ph10_token(p, (int)t, lane);
    }
}


template <int CTRL> __device__ __forceinline__ float dpp_add(float v) { return v + __int_as_float(__builtin_amdgcn_update_dpp(0, __float_as_int(v), CTRL, 0xf, 0xf, true)); }
template <int PAT> __device__ __forceinline__ float swz_add(float v) { return v + __int_as_float(__builtin_amdgcn_ds_swizzle(__float_as_int(v), PAT)); }
struct SlabIds { int e_lo, e_hi; };
constexpr int QW_FLAG = 3900;
template <int TBL>
__device__ __forceinline__ SlabIds slab_ids(const Params& p, int t, int lane) {
    SlabIds s;
    if (TBL == 0 && t >= NP && gridDim.x >= 16) {
        for (unsigned sp = 0; sp < (1u << 22); ++sp) { if (__builtin_amdgcn_readfirstlane((int)__hip_atomic_load(p.bar + QW_FLAG, __ATOMIC_RELAXED, __HIP_MEMORY_SCOPE_AGENT)) != 0) break; __builtin_amdgcn_s_sleep(8); }
        s.e_lo = __hip_atomic_load(p.pk_eid + (size_t)t * 128 + lane, __ATOMIC_RELAXED, __HIP_MEMORY_SCOPE_AGENT); s.e_hi = __hip_atomic_load(p.pk_eid + (size_t)t * 128 + 64 + lane, __ATOMIC_RELAXED, __HIP_MEMORY_SCOPE_AGENT);
    } else { s.e_lo = p.pk_eid[(size_t)t * 128 + lane]; s.e_hi = p.pk_eid[(size_t)t * 128 + 64 + lane]; }
    return s;
}
template <int TBL> struct SlabRows { u32x4 rv[16]; u32x4 hq[2]; float w0, w1; };
template <int TBL>
__device__ __forceinline__ void slab_issue(const Params& p, int t, int slab, int lane, const SlabIds& id, SlabRows<TBL>& r) {
    if (TBL == 0) {
        const int gq = lane >> 3, c8 = lane & 7, kq = lane >> 4;
        const unsigned char* tab = p.u8 + (size_t)slab * (16384 * 128) + c8 * 16;
#pragma unroll
        for (int k = 0; k < 16; ++k) { const int e = __shfl(k < 8 ? id.e_lo : id.e_hi, (8 * k + gq) & 63); r.rv[k] = *(const u32x4*)(tab + (size_t)e * 128); }
        const unsigned char* hp = p.h2q + (size_t)t * 2048 + slab * 128 + kq * 32;
        r.hq[0] = *(const u32x4*)hp; r.hq[1] = *(const u32x4*)(hp + 16);
    } else {
        const int gq = lane >> 3, c8 = lane & 7;
        const unsigned char* tab = p.v8 + (size_t)slab * (16384 * 128) + c8 * 16;
#pragma unroll
        for (int k = 0; k < 16; ++k) { const int e = __shfl(k < 8 ? id.e_lo : id.e_hi, (8 * k + gq) & 63); r.rv[k] = *(const u32x4*)(tab + (size_t)e * 128); }
        { const unsigned char* wp = p.wq + (size_t)t * 128 + (lane >> 4) * 8;
          const i32x2 a0 = *(const i32x2*)wp, a1 = *(const i32x2*)(wp + 32), a2 = *(const i32x2*)(wp + 64), a3 = *(const i32x2*)(wp + 96);
          r.hq[0] = (u32x4){(unsigned)a0[0], (unsigned)a0[1], (unsigned)a1[0], (unsigned)a1[1]}; r.hq[1] = (u32x4){(unsigned)a2[0], (unsigned)a2[1], (unsigned)a3[0], (unsigned)a3[1]}; r.w0 = p.wsc[t]; r.w1 = 0.f; }
    }
}
__device__ __forceinline__ long pk64(unsigned lo, unsigned hi) { return (long)(((unsigned long long)hi << 32) | (unsigned long long)lo); }
template <int TBL>
__device__ __forceinline__ void slab_compute(const Params& p, int t, int slab, int lane, const SlabRows<TBL>& r, unsigned char* lds_w) {
    if (TBL == 0) {
        const int r16 = lane & 15, kq = lane >> 4, gq = lane >> 3, c8 = lane & 7;
        unsigned char* stg = lds_w;
        const long b0 = pk64(r.hq[0][0], r.hq[0][1]), b1 = pk64(r.hq[0][2], r.hq[0][3]), b2 = pk64(r.hq[1][0], r.hq[1][1]), b3 = pk64(r.hq[1][2], r.hq[1][3]);
        f32x4 sel = (f32x4){0.f, 0.f, 0.f, 0.f};
#pragma unroll
        for (int hf = 0; hf < 2; ++hf) {
#pragma unroll
            for (int k = 0; k < 8; ++k) *(u32x4*)(stg + (8 * k + gq) * 144 + c8 * 16) = r.rv[8 * hf + k];
            asm volatile("s_waitcnt lgkmcnt(0)" ::: "memory");
#pragma unroll
            for (int g2 = 0; g2 < 4; ++g2) { const int g = 4 * hf + g2;
                const u32x4 a0 = *(const u32x4*)(stg + (16 * g2 + r16) * 144 + kq * 32), a1 = *(const u32x4*)(stg + (16 * g2 + r16) * 144 + kq * 32 + 16);
                f32x4 acc = (f32x4){0.f, 0.f, 0.f, 0.f};
                acc = __builtin_amdgcn_mfma_f32_16x16x32_fp8_fp8(pk64(a0[0], a0[1]), b0, acc, 0, 0, 0);
                acc = __builtin_amdgcn_mfma_f32_16x16x32_fp8_fp8(pk64(a0[2], a0[3]), b1, acc, 0, 0, 0);
                acc = __builtin_amdgcn_mfma_f32_16x16x32_fp8_fp8(pk64(a1[0], a1[1]), b2, acc, 0, 0, 0);
                acc = __builtin_amdgcn_mfma_f32_16x16x32_fp8_fp8(pk64(a1[2], a1[3]), b3, acc, 0, 0, 0);
                if (r16 == g) sel = acc; }
            asm volatile("s_waitcnt lgkmcnt(0)" ::: "memory");
        }
        if (r16 < 8) *(f32x4*)(p.pd + ((size_t)slab * NTOK + t) * 128 + 16 * r16 + 4 * kq) = sel;
    } else {
        const int i16 = lane & 15, kq = lane >> 4, gq = lane >> 3, c8 = lane & 7;
        unsigned char* stg = lds_w;
        f32x4 acc[8];
#pragma unroll
        for (int cb = 0; cb < 8; ++cb) acc[cb] = (f32x4){0.f, 0.f, 0.f, 0.f};
#pragma unroll
        for (int hf = 0; hf < 2; ++hf) {
#pragma unroll
            for (int k = 0; k < 8; ++k) *(u32x4*)(stg + (8 * k + gq) * 144 + c8 * 16) = r.rv[8 * hf + k];
            asm volatile("s_waitcnt lgkmcnt(0)" ::: "memory");
#pragma unroll
            for (int s2 = 0; s2 < 2; ++s2) { const int s = 2 * hf + s2;
                const long a = pk64(r.hq[s >> 1][2 * (s & 1)], r.hq[s >> 1][2 * (s & 1) + 1]);
                const unsigned char* tb = stg + (32 * s2 + 8 * kq + (i16 >> 1)) * 144 + 8 * (i16 & 1);
#pragma unroll
                for (int cb = 0; cb < 8; ++cb) { const i32x2 bq = __builtin_amdgcn_ds_read_tr8_b64_v2i32((LAS i32x2*)(tb + 16 * cb));
                    acc[cb] = __builtin_amdgcn_mfma_f32_16x16x32_fp8_fp8(a, pk64((unsigned)bq[0], (unsigned)bq[1]), acc[cb], 0, 0, 0); } }
            asm volatile("s_waitcnt lgkmcnt(0)" ::: "memory");
        }
        if (lane < 16) { float* dst = p.po + (size_t)t * 2048 + slab * 128 + lane;
#pragma unroll
            for (int cb = 0; cb < 8; ++cb) dst[16 * cb] = acc[cb][0] * r.w0; }
    }
}
template <int TBL>
__device__ __forceinline__ void peer_slab_phase(const Params& p, int bx, int G, unsigned char* lds, bool skip_last) {
    int lane = threadIdx.x & 63; asm volatile("" : "+v"(lane));
    const int wave = threadIdx.x >> 6;
    const int x = bx & 7, nblk = ((G - x + 7) >> 3) - ((skip_last && x == ((G - 1) & 7)) ? 1 : 0), w = (bx >> 3) * 8 + wave, nw = nblk * 8;
    const int cw = w < NTOK ? (NTOK - w + nw - 1) / nw : 0, n = 2 * cw;
#define ITEM_T(i) (w + ((i) % cw) * nw)
#define ITEM_S(i) (x + 8 * ((i) / cw))
    if (n == 0) return;
    SlabRows<TBL> A, B; SlabIds ia, ib;
    ia = slab_ids<TBL>(p, ITEM_T(0), lane);
    ib = slab_ids<TBL>(p, ITEM_T(n > 1 ? 1 : 0), lane);
    slab_issue<TBL>(p, ITEM_T(0), ITEM_S(0), lane, ia, A);
#pragma unroll 1
    for (int i = 0; i < n; i += 2) {
        const int i1 = i + 1 < n ? i + 1 : n - 1, i2 = i + 2 < n ? i + 2 : n - 1, i3 = i + 3 < n ? i + 3 : n - 1;
        ia = slab_ids<TBL>(p, ITEM_T(i2), lane);
        slab_issue<TBL>(p, ITEM_T(i1), ITEM_S(i1), lane, ib, B);
        slab_compute<TBL>(p, ITEM_T(i), ITEM_S(i), lane, A, lds + wave * 9216);
        ib = slab_ids<TBL>(p, ITEM_T(i3), lane);
        slab_issue<TBL>(p, ITEM_T(i2), ITEM_S(i2), lane, ia, A);
        if (i + 1 < n) slab_compute<TBL>(p, ITEM_T(i1), ITEM_S(i1), lane, B, lds + wave * 9216);
    }
#undef ITEM_T
#undef ITEM_S
}
__device__ __forceinline__ void peer_w_phase(const Params& p, int bx, int G) {
    const int lane = threadIdx.x & 63, gw = bx * 8 + (threadIdx.x >> 6);
#pragma unroll 1
    for (int t = gw; t < NTOK; t += G * 8) {
        float wv[2];
#pragma unroll
        for (int hh = 0; hh < 2; ++hh) { const int pi = lane + 64 * hh; float d = 0.f;
#pragma unroll
            for (int s = 0; s < 16; ++s) d += p.pd[((size_t)s * NTOK + t) * 128 + pi];
            const int e = p.pk_eid[(size_t)t * 128 + pi];
            wv[hh] = p.pk_gate[(size_t)t * 128 + pi] * gelu_tanh(d * p.us[e]) * p.vs[e]; }
        const float am = wave_max(fmaxf(fabsf(wv[0]), fabsf(wv[1])));
        const float sc = am > 0.f ? am * (1.f / 440.f) : 1.f, inv = 1.f / sc;
        const int pk = __builtin_amdgcn_cvt_pk_fp8_f32(wv[0] * inv, wv[1] * inv, 0, false);
        p.wq[(size_t)t * 128 + lane] = (unsigned char)(pk & 0xff); p.wq[(size_t)t * 128 + 64 + lane] = (unsigned char)((pk >> 8) & 0xff);
        if (lane == 0) p.wsc[t] = sc;
    }
}
__device__ __forceinline__ void peer_final_phase(const Params& p, int bx, int G) {
    const int lane = threadIdx.x & 63, gw = bx * 8 + (threadIdx.x >> 6);
#pragma unroll 1
    for (int row = gw; row < NTOK; row += G * 8) {
        const int mrow = row < NP ? row / SEQ : 4 + (row - NP);
        const float* g2 = p.mod + (size_t)mrow * 12288 + 10240 + lane * 16; const float* x1 = p.x1 + (size_t)row * 2048 + lane * 16; const float* po = p.po + (size_t)row * 2048 + lane * 16;
        float out[32]; float ss = 0.f;
#pragma unroll
        for (int c = 0; c < 2; ++c)
#pragma unroll
            for (int k = 0; k < 16; k += 4) { const float4 xv = *(const float4*)(x1 + c * 1024 + k), gv = *(const float4*)(g2 + c * 1024 + k), ov = *(const float4*)(po + c * 1024 + k); float* o = out + c * 16 + k;
                o[0] = xv.x + gv.x * ov.x; o[1] = xv.y + gv.y * ov.y; o[2] = xv.z + gv.z * ov.z; o[3] = xv.w + gv.w * ov.w;
                ss += o[0] * o[0] + o[1] * o[1] + o[2] * o[2] + o[3] * o[3]; }
        ss = wave_sum_sw(ss);
        const float rstd = rsqrtf(ss * (1.f / 2048.f) + 1e-6f);
        float* dst = (row < NP ? p.out + O_YP + (size_t)row * 2048 : p.out + O_YS + (size_t)(row - NP) * 2048) + lane * 16;
#pragma unroll
        for (int c = 0; c < 2; ++c)
#pragma unroll
            for (int k = 0; k < 16; k += 4) { const float4 fw = *(const float4*)(p.final_norm + lane * 16 + c * 1024 + k); const float* o = out + c * 16 + k;
                float4 y; y.x = o[0] * rstd * fw.x; y.y = o[1] * rstd * fw.y; y.z = o[2] * rstd * fw.z; y.w = o[3] * rstd * fw.w;
                *(float4*)(dst + c * 1024 + k) = y; }
    }
}


constexpr int NF_T = 1024, NF_W = 64, NFILL = NF_W + 2 * NF_T + 2 * 2048, QW_HEAD = 3700, QW_DONE = 3800;
__device__ __forceinline__ void filler_unit(const Params& p, int f, unsigned char* lds) {
    if (f < NF_W) {
        const int b = f >> 3, j0 = (f & 7) * 64;
#pragma unroll
        for (int i = 0; i < 16; ++i) { const int idx = threadIdx.x + NTHR * i, j = j0 + (idx >> 7), c = (idx & 127) * 4;
            if (j < 511) *(float4*)(p.out + O_WKS + ((size_t)b * 512 + j) * 512 + c) = *(const float4*)(p.state_win + ((size_t)b * 512 + j + 1) * 512 + c); }
        return; }
    f -= NF_W;
    if (f < NF_T) ph0_transpose(p.w_out, p.wt_out, 2048, 32, f, (float*)lds);
    else if (f < 2 * NF_T) ph0_transpose(p.peer_wq, p.wt_q, 2048, 32, f - NF_T, (float*)lds);
    else if (f < 2 * NF_T + 2048) ph0_fp8(p.peer_u, p.u8, p.us, f - 2 * NF_T);
    else ph0_fp8(p.peer_v, p.v8, p.vs, f - 2 * NF_T - 2048);
}
template <bool DRAIN>
__device__ __forceinline__ void filler_bg(const Params& p, unsigned char* lds, int phase, int G) {
    volatile int* w = (volatile int*)(lds + LDS_BYTES - 64);
    __syncthreads();
    if (!DRAIN && threadIdx.x == 0) __hip_atomic_fetch_add(p.bar + QW_DONE + phase, 1u, __ATOMIC_RELAXED, __HIP_MEMORY_SCOPE_AGENT);
    for (;;) {
        if (threadIdx.x == 0) {
            int f = NFILL;
            const bool others_busy = DRAIN || __hip_atomic_load(p.bar + QW_DONE + phase, __ATOMIC_RELAXED, __HIP_MEMORY_SCOPE_AGENT) < (unsigned)G;
            if (others_busy) f = (int)__hip_atomic_fetch_add(p.bar + QW_HEAD, 1u, __ATOMIC_RELAXED, __HIP_MEMORY_SCOPE_AGENT);
            w[0] = f;
        }
        __syncthreads();
        const int f = w[0];
        __syncthreads();
        if (f >= NFILL) break;
        filler_unit(p, f, lds);
    }
}
#ifndef PROBE_DBL
#define PROBE_DBL 0
#endif
#ifndef PROBE_SUB
#define PROBE_SUB 0
#endif
#define PHASE_FN(k) __device__ __forceinline__ void phase##k(const Params& p, unsigned char* lds, const int bx, const int G, const int rep)
PHASE_FN(0) {
    float* smem = (float*)lds;
    constexpr int NA = 192, NT_IN = 32 * (INCP / 64), NC = 2 * 128 + 2 * 4, NK = 8, NTOT = NA + NT_IN + NC + NK;
    volatile int* qw = (volatile int*)(lds + LDS_BYTES - 64);
    const unsigned qhead = QW_HEAD + 32 + (unsigned)rep;
    for (;;) {
        __syncthreads();
        if (threadIdx.x == 0) qw[0] = (int)__hip_atomic_fetch_add(p.bar + qhead, 1u, __ATOMIC_RELAXED, __HIP_MEMORY_SCOPE_AGENT);
        __syncthreads();
        int u = qw[0];
        if (u >= NTOT) break;
        if (u < NA) { ph0_adaln(p, u, smem); continue; }
        u -= NA;
        if (u < NT_IN) { ph0_transpose(p.w_in, p.wt_in, INC, INCP / 64, u, smem); continue; }
        u -= NT_IN;
        if (u < NC) {
            if (u < 256) { const int s = u >> 7; ph0_transpose(p.cmp_w1 + (size_t)s * 4096 * 128, p.w1t + (size_t)s * 128 * 4096, 128, 2, u & 127, smem, 4096); }
            else { const int s = (u - 256) >> 2; ph0_transpose(p.cmp_w2 + (size_t)s * 128 * 128, p.w2t + (size_t)s * 128 * 128, 128, 2, (u - 256) & 3, smem, 128); }
            continue; }
        ph0_keys(p, u - NC);
    }
}
PHASE_FN(1) { for (int u = bx; u < MPAD / 8; u += G) norm_row<0>(p, u * 8 + (threadIdx.x >> 6)); }
PHASE_FN(2) {
    constexpr int MT = NP / 256, NG1 = MT * (INCP / 256);
    float* C = p.P; float* out = p.out; bf16_t* Qb = p.Qb; bf16_t* KVb = p.KVb;
    auto epiP = [C](int r, int c, float v) { __builtin_nontemporal_store(v, C + (size_t)r * INCP + c); };
    auto epiA = [Qb](int r, int c, float v) { Qb[(size_t)r * 1024 + c] = f2bf(v); };
    auto epiB = [out](int r, int c, float v) { out[O_CKP + (size_t)r * 512 + (c - C_KVC)] = v; };
    auto epiC = [out, KVb](int r, int c, float v) { out[O_SKP + (size_t)r * 512 + (c - C_KVS)] = v; KVb[(size_t)r * 1024 + (c - C_KVS)] = f2bf(v); };
    auto epiD = [out, KVb](int r, int c, float v) { KVb[(size_t)r * 1024 + (c - C_KVS)] = f2bf(v); const int t = r & (SEQ - 1);
        if (t >= SEQ - 512) out[O_WKP + ((size_t)(r >> 11) * 512 + (t - (SEQ - 512))) * 512 + (c - C_KVW)] = v; };
    volatile int* qw = (volatile int*)(lds + LDS_BYTES - 64);
    const unsigned qhead = QW_HEAD + 64 + (unsigned)rep * 64;
    for (;;) {
        __syncthreads();
        if (threadIdx.x == 0) qw[0] = (int)__hip_atomic_fetch_add(p.bar + qhead, 1u, __ATOMIC_RELAXED, __HIP_MEMORY_SCOPE_AGENT);
        __syncthreads();
        const int q = qw[0];
        if (q >= 128 + NG1 + INCP / 64) break;
        if (q < 128) cmp_tile<true>(p, q >> 1, q & 1, lds);
        else if (q < 128 + NG1) { const int g = q - 128, pn = g / MT, pm = g % MT;
            if (pn < 4) gemm_tile(p.h1, p.wt_in, 2048, pm * 256, pn * 256, (bf16_t*)lds, epiA);
            else if (pn < 6) gemm_tile(p.h1, p.wt_in, 2048, pm * 256, pn * 256, (bf16_t*)lds, epiB);
            else if (pn < 8) gemm_tile(p.h1, p.wt_in, 2048, pm * 256, pn * 256, (bf16_t*)lds, epiC);
            else if (pn < 10) gemm_tile(p.h1, p.wt_in, 2048, pm * 256, pn * 256, (bf16_t*)lds, epiD);
            else gemm_tile(p.h1, p.wt_in, 2048, pm * 256, pn * 256, (bf16_t*)lds, epiP); }
        else gemm_rows8<4>(p.h1 + (size_t)NP * 2048, p.wt_in, q - 128 - NG1, lds, epiP);
    }
    if (rep == 0) filler_bg<false>(p, lds, 2, G);
}
PHASE_FN(3) {
    float* smem = (float*)lds;
    constexpr int NQ3 = 8 + 1024 + NSB + NSB + NB * 3;
    volatile int* qw = (volatile int*)(lds + LDS_BYTES - 64);
    const unsigned qhead = QW_HEAD + 40 + (unsigned)rep;
    for (;;) {
        __syncthreads();
        if (threadIdx.x == 0) qw[0] = (int)__hip_atomic_fetch_add(p.bar + qhead, 1u, __ATOMIC_RELAXED, __HIP_MEMORY_SCOPE_AGENT);
        __syncthreads();
        int u = qw[0];
        if (u >= NQ3) break;
        if (u < 8) { cmp_tile<false>(p, u >> 1, u & 1, lds); continue; }
        u -= 8;
        if (u < 1024) { ph3_gdnA(p, u, lds); if (PROBE_SUB & 1) ph3_gdnA(p, u, lds); continue; }
        u -= 1024;
        if (u < NSB) { ph3_gdnprep(p, NP + u, smem); continue; }
        ph3_scatter(p, u - NSB);
    }
    if (rep == 0) filler_bg<false>(p, lds, 3, G);
}
PHASE_FN(4) {
    float* smem = (float*)lds;
    if (G >= 128) {
        if (bx < 64) { ph4_gdnB(p, bx, lds); if (PROBE_SUB & 8) ph4_gdnB(p, bx, lds); ph4_gdn(p, 32 + bx, smem); }
        else if (bx < 80) { ph4_nsa_sample(p, bx - 64, lds); if (PROBE_SUB & 32) ph4_nsa_sample(p, bx - 64, lds); }
        else { const int NB = G - 80, k = bx - 80;
            for (int pass = 0; pass * NB < 256; ++pass) { const int u = pass * NB + ((pass & 1) ? NB - 1 - k : k); if (u < 256) { ph4_nsa_fast(p, u, lds); if (PROBE_SUB & 16) ph4_nsa_fast(p, u, lds); } }
        }
    } else {
        for (int u = bx; u < 64; u += G) ph4_gdnB(p, u, lds);
        for (int u = 32 + bx; u < 96; u += G) ph4_gdn(p, u, smem);
        for (int u = bx; u < 256; u += G) ph4_nsa_fast(p, u, lds);
        for (int u = bx; u < 2 * NSB; u += G) ph4_nsa_sample(p, u, lds);
    }
    if (rep == 0) filler_bg<false>(p, lds, 4, G);
}
PHASE_FN(5) { for (int u = bx; u < 1024; u += G) ph5_gdnC(p, u, lds); for (int u = bx; u < NSB; u += G) ph5_gdnout(p, NP + u); if (rep == 0) filler_bg<true>(p, lds, 5, G); }
PHASE_FN(6) {
    float* C = p.acc2;
    auto epi = [C](int r, int c, float v) { C[(size_t)r * 2048 + c] = v; };
    constexpr int MT = NP / 256;
    for (int u = bx; u < MT * 8; u += G) { const int pn = u / MT, pm = u % MT; gemm_tile(p.amix, p.wt_out, 2048, pm * 256, pn * 256, (bf16_t*)lds, epi); }
    for (int c = bx; c < 128; c += G) gemm_rows8<1>(p.amix + (size_t)NP * 2048, p.wt_out, c, lds, epi);
}
PHASE_FN(7) { for (int u = bx; u < MPAD / 8; u += G) norm_row<1>(p, u * 8 + (threadIdx.x >> 6)); }
PHASE_FN(8) {
    float* C = p.qp;
    auto epi = [C](int r, int c, float v) { C[(size_t)r * 2048 + c] = v; };
    constexpr int MT = NP / 256;
    for (int u = bx; u < MT * 8; u += G) { const int pn = u / MT, pm = u % MT; gemm_tile(p.h2, p.wt_q, 2048, pm * 256, pn * 256, (bf16_t*)lds, epi); }
    for (int c = bx; c < 128; c += G) gemm_rows8<1>(p.h2 + (size_t)NP * 2048, p.wt_q, c, lds, epi);
}
PHASE_FN(9) { for (int u = bx; u < NP / 16 + ((G < 16) ? 1 : 0); u += G) ph9_peer_fast<false>(p, u, lds); }
PHASE_FN(10) {
    if (G >= 16 && bx == G - 1) {
        ph9_peer_fast<true>(p, NP / 16, lds);
        asm volatile("s_waitcnt vmcnt(0)" ::: "memory");
        __syncthreads();
        if (threadIdx.x == 0) __hip_atomic_store(p.bar + QW_FLAG, 1u, __ATOMIC_RELAXED, __HIP_MEMORY_SCOPE_AGENT);
    } else peer_slab_phase<0>(p, bx, G, lds, G >= 16);
}
PHASE_FN(11) { peer_w_phase(p, bx, G); }
PHASE_FN(12) { peer_slab_phase<1>(p, bx, G, lds, false); }
PHASE_FN(13) { peer_final_phase(p, bx, G); }

__global__ void __launch_bounds__(NTHR, 2) fwd(Params p) {
    extern __shared__ __attribute__((aligned(16))) unsigned char lds[];
    LAS unsigned* xbw = (LAS unsigned*)(lds + LDS_BYTES - 16);
    const int tid = threadIdx.x, G = gridDim.x, bx = blockIdx.x;
    if (tid < 4) xbw[tid] = 0u;
    __syncthreads();
    XcdBarrier bar; bar.bar = p.bar; bar.x = 0; bar.st = nullptr;
    const int lo = p.ph_lo, hi = p.ph_hi;
    if (hi - lo > 1) bar = xcd_barrier_post(p.bar, (volatile LAS unsigned*)xbw);
#define IN(k) (lo <= (k) && (k) < hi)
#ifndef PROBE_BAR
#define PROBE_BAR 0
#endif
#define SEAM(k) do { if (IN(k) && IN((k) + 1)) { xcd_barrier(bar); if (PROBE_BAR) xcd_barrier(bar); } } while (0)
#define RUN(k) do { if (IN(k)) { phase##k(p, lds, bx, G, 0); if ((PROBE_DBL >> (k)) & 1) { __syncthreads(); phase##k(p, lds, bx, G, 1); } } } while (0)
    RUN(0); SEAM(0);
    RUN(1); SEAM(1);
    RUN(2); SEAM(2);
    RUN(3); SEAM(3);
    RUN(4); SEAM(4);
    RUN(5); SEAM(5);
    RUN(6); SEAM(6);
    RUN(7); SEAM(7);
    RUN(8); SEAM(8);
    RUN(9); SEAM(9);
    RUN(10); SEAM(10);
    RUN(11); SEAM(11);
    RUN(12); SEAM(12);
    RUN(13);
}

extern "C" void kernel_launch(void* const* d_in, const int* in_sizes, int n_in, void* d_out, int out_size, void* d_ws, size_t ws_size, hipStream_t stream) {
    static int grid = 0;
    if (grid == 0) {
        int dev = 0, cus = 0;
        if (hipGetDevice(&dev) != hipSuccess || hipDeviceGetAttribute(&cus, hipDeviceAttributeMultiprocessorCount, dev) != hipSuccess) { fprintf(stderr, "kernel_launch: device query failed\n"); grid = -1; return; }
        if (hipFuncSetAttribute((const void*)fwd, hipFuncAttributeMaxDynamicSharedMemorySize, LDS_BYTES) != hipSuccess) { fprintf(stderr, "kernel_launch: hipFuncSetAttribute failed\n"); grid = -1; return; }
        int per_cu = 0;
        if (hipOccupancyMaxActiveBlocksPerMultiprocessor(&per_cu, (const void*)fwd, NTHR, LDS_BYTES) != hipSuccess || per_cu < 1) fprintf(stderr, "kernel_launch: occupancy query says %d\n", per_cu);
        (void)hipGetLastError();
        grid = cus;
    }
    if (grid < 0) return;
    Params p{};
    p.x_prompt = (const float*)d_in[0]; p.x_sample = (const float*)d_in[1]; p.cache_cmp = (const float*)d_in[2]; p.cache_sel = (const float*)d_in[3];
    p.state_win = (const float*)d_in[4]; p.state_conv = (const float*)d_in[5]; p.state_gdn = (const float*)d_in[6]; p.page_table = (const int*)d_in[7];
    p.c_prompt = (const float*)d_in[8]; p.c_sample = (const float*)d_in[9]; p.w_ada = (const float*)d_in[10]; p.b_ada = (const float*)d_in[11];
    p.norm_mix = (const float*)d_in[12]; p.norm_ffn = (const float*)d_in[13]; p.w_in = (const float*)d_in[14]; p.cmp_pe = (const float*)d_in[15];
    p.cmp_w1 = (const float*)d_in[16]; p.cmp_b1 = (const float*)d_in[17]; p.cmp_w2 = (const float*)d_in[18]; p.conv_w = (const float*)d_in[19];
    p.a_log = (const float*)d_in[20]; p.dt_bias = (const float*)d_in[21]; p.gdn_norm = (const float*)d_in[22]; p.w_out = (const float*)d_in[23];
    p.peer_wq = (const float*)d_in[24]; p.peer_keys = (const float*)d_in[25]; p.peer_u = (const float*)d_in[26]; p.peer_v = (const float*)d_in[27];
    p.final_norm = (const float*)d_in[28];
    p.out = (float*)d_out;
    unsigned char* ws = (unsigned char*)d_ws; size_t off = 0;
    auto take = [&](size_t bytes) { unsigned char* r = ws + off; off += (bytes + 255) & ~(size_t)255; return r; };
    p.bar = (unsigned*)take(16384);
    p.mod = (float*)take((size_t)12 * 12288 * 4);
    p.h1 = (bf16_t*)take((size_t)MPAD * 2048 * 2);
    p.wt_in = (bf16_t*)take((size_t)INCP * 2048 * 2);
    p.wt_out = (bf16_t*)take((size_t)2048 * 2048 * 2);
    p.wt_q = (bf16_t*)take((size_t)2048 * 2048 * 2);
    p.P = (float*)take((size_t)MPAD * INCP * 4);
    p.ckv_p = (float*)take((size_t)4 * 64 * 4 * 128 * 4);
    p.ckv_s = (float*)take((size_t)8 * 512 * 4 * 128 * 4);
    p.qkvn = (float*)take((size_t)NTOK * 3072 * 4);
    p.gbeta = (float*)take((size_t)NTOK * 8 * 4);
    p.gg = (float*)take((size_t)NTOK * 8 * 4);
    p.ograw = (float*)take((size_t)NTOK * 1024 * 4);
    p.amix = (bf16_t*)take((size_t)MPAD * 2048 * 2);
    p.acc2 = (float*)take((size_t)MPAD * 2048 * 4);
    p.x1 = (float*)take((size_t)NTOK * 2048 * 4);
    p.h2f = (float*)take((size_t)NTOK * 2048 * 4);
    p.h2 = (bf16_t*)take((size_t)MPAD * 2048 * 2);
    p.qp = (float*)take((size_t)MPAD * 2048 * 4);
    p.Qb = (bf16_t*)take((size_t)MPAD * 1024 * 2);
    p.gN = (bf16_t*)take((size_t)1024 * 16384 * 2); p.gBT = (bf16_t*)take((size_t)1024 * 16384 * 2); p.gQp = (bf16_t*)take((size_t)1024 * 8192 * 2);
    p.u8 = (unsigned char*)take((size_t)16384 * 2048); p.v8 = (unsigned char*)take((size_t)16384 * 2048); p.us = (float*)take(65536); p.vs = (float*)take(65536);
    p.pk_eid = (int*)take((size_t)NTOK * 128 * 4); p.pk_gate = (float*)take((size_t)NTOK * 128 * 4);
    p.pd = (float*)take((size_t)16 * NTOK * 128 * 4); p.wv = (float*)take((size_t)NTOK * 128 * 4); p.h2q = (unsigned char*)take((size_t)NTOK * 2048); p.po = (float*)take((size_t)NTOK * 2048 * 4); p.wq = (unsigned char*)take((size_t)NTOK * 128); p.wsc = (float*)take((size_t)NTOK * 4); p.kh = (bf16_t*)take(65536); p.kl = (bf16_t*)take(65536); p.w1t = (bf16_t*)take((size_t)2 * 128 * 4096 * 2); p.w2t = (bf16_t*)take((size_t)2 * 128 * 128 * 2);
    p.gOpT = (bf16_t*)take((size_t)1024 * 8192 * 2); p.gST = (bf16_t*)take((size_t)1024 * 16384 * 2); p.ggl = (float*)take(4096);
    p.KVb = (bf16_t*)take((size_t)MPAD * 1024 * 2);
    if (off > ws_size) { fprintf(stderr, "kernel_launch: workspace too small (%zu > %zu)\n", off, ws_size); return; }
    (void)hipMemsetAsync(p.bar, 0, 16384, stream);
    if (N_LAUNCHES == 1) { p.ph_lo = 0; p.ph_hi = NPH; hipLaunchKernelGGL(fwd, dim3(grid), dim3(NTHR), LDS_BYTES, stream, p); }
    else for (int li = 0; li < NPH; ++li) { p.ph_lo = li; p.ph_hi = li + 1; hipLaunchKernelGGL(fwd, dim3(grid), dim3(NTHR), LDS_BYTES, stream, p); }
    const hipError_t le = hipPeekAtLastError();
    if (le != hipSuccess) fprintf(stderr, "kernel_launch: launch failed: %s\n", hipGetErrorName(le));
}
```

```cpp
#include <hip/hip_runtime.h>
#include <stdint.h>
#include <stdio.h>

#ifndef N_LAUNCHES
#define N_LAUNCHES 1
#endif

typedef unsigned short bf16_t;
typedef short bf16x8 __attribute__((ext_vector_type(8)));
typedef float f32x4 __attribute__((ext_vector_type(4)));
typedef float f32x16 __attribute__((ext_vector_type(16)));
typedef unsigned u32x4 __attribute__((ext_vector_type(4)));
typedef unsigned u32x2 __attribute__((ext_vector_type(2)));
typedef __bf16 bf2_t __attribute__((ext_vector_type(2)));
typedef float f32x2 __attribute__((ext_vector_type(2)));
typedef int i32x2 __attribute__((ext_vector_type(2)));
#define MFMA32(a, b, c) __builtin_amdgcn_mfma_f32_32x32x16_bf16((a), (b), (c), 0, 0, 0)
#define MFMA16(a, b, c) __builtin_amdgcn_mfma_f32_16x16x32_bf16((a), (b), (c), 0, 0, 0)

constexpr int DM = 2048, SEQ = 2048, NB = 4, NSB = 8;
constexpr int NP = NB * SEQ;
constexpr int NTOK = NP + NSB;
constexpr int MPAD = 8448;
constexpr int INC = 6696, INCP = 6912;
constexpr int C_Q = 0, C_KVC = 1024, C_KVS = 1536, C_KVW = 2048, C_GTS = 2560, C_QKV = 2584, C_Z = 5656, C_BL = 6680, C_AL = 6688;
constexpr int PAST = 16384, NPAGES = 128;
constexpr int NPH = 14;
constexpr int LDS_BYTES = 147456;
constexpr int NTHR = 512;

struct Params {
    const float *x_prompt, *x_sample, *cache_cmp, *cache_sel, *state_win, *state_conv, *state_gdn;
    const int* page_table;
    const float *c_prompt, *c_sample, *w_ada, *b_ada, *norm_mix, *norm_ffn, *w_in, *cmp_pe, *cmp_w1, *cmp_b1, *cmp_w2,
        *conv_w, *a_log, *dt_bias, *gdn_norm, *w_out, *peer_wq, *peer_keys, *peer_u, *peer_v, *final_norm;
    float* out;
    unsigned* bar;
    float* mod;
    bf16_t* h1;
    bf16_t* wt_in;
    bf16_t* wt_out;
    bf16_t* wt_q;
    float* P;
    float* ckv_p;
    float* ckv_s;
    float* qkvn;
    float* gbeta;
    float* gg;
    float* ograw;
    bf16_t* amix;
    float* acc2;
    float* x1;
    float* h2f;
    bf16_t* h2;
    float* qp;
    bf16_t* Qb;
    bf16_t* gN;
    bf16_t* gBT;
    bf16_t* gQp;
    bf16_t* gOpT;
    bf16_t* gST;
    float* ggl;
    unsigned char* u8;
    unsigned char* v8;
    float* us;
    float* vs;
    int* pk_eid;
    float* pk_gate;
    float* pd;
    unsigned char* h2q;
    float* wv;
    float* po;
    unsigned char* wq;
    float* wsc;
    bf16_t* kh;
    bf16_t* kl;
    bf16_t* w1t;
    bf16_t* w2t;
    bf16_t* KVb;
    int ph_lo, ph_hi;
};

constexpr size_t O_YP = 0, O_YS = O_YP + (size_t)NP * DM, O_CKP = O_YS + (size_t)NSB * DM, O_CKS = O_CKP + (size_t)NP * 512,
                 O_SKP = O_CKS + NSB * 512, O_SKS = O_SKP + (size_t)NP * 512, O_WKP = O_SKS + NSB * 512, O_WKS = O_WKP + (size_t)NB * 512 * 512,
                 O_CVP = O_WKS + (size_t)NSB * 512 * 512, O_CVS = O_CVP + NB * 3 * 3072, O_GP = O_CVS + NSB * 3 * 3072,
                 O_GS = O_GP + (size_t)NB * 8 * 128 * 128, O_END = O_GS + (size_t)NSB * 8 * 128 * 128;

__device__ __forceinline__ bf16_t f2bf(float f) { unsigned u = __float_as_uint(f); u += 0x7fffu + ((u >> 16) & 1u); return (bf16_t)(u >> 16); }
__device__ __forceinline__ unsigned pk2(float a, float b) { return (unsigned)f2bf(a) | ((unsigned)f2bf(b) << 16); }
__device__ __forceinline__ float wave_sum(float v) { for (int o = 32; o > 0; o >>= 1) v += __shfl_xor(v, o); return v; }
__device__ __forceinline__ float wave_sum_sw(float v) {
    v += __int_as_float(__builtin_amdgcn_ds_swizzle(__float_as_int(v), (1 << 10) | 0x1f));
    v += __int_as_float(__builtin_amdgcn_ds_swizzle(__float_as_int(v), (2 << 10) | 0x1f));
    v += __int_as_float(__builtin_amdgcn_ds_swizzle(__float_as_int(v), (4 << 10) | 0x1f));
    v += __int_as_float(__builtin_amdgcn_ds_swizzle(__float_as_int(v), (8 << 10) | 0x1f));
    v += __int_as_float(__builtin_amdgcn_ds_swizzle(__float_as_int(v), (16 << 10) | 0x1f));
    const auto rr = __builtin_amdgcn_permlane32_swap(__float_as_uint(v), __float_as_uint(v), false, false);
    return __uint_as_float(rr[0]) + __uint_as_float(rr[1]);
}
__device__ __forceinline__ float wave_max(float v) { for (int o = 32; o > 0; o >>= 1) v = fmaxf(v, __shfl_xor(v, o)); return v; }
__device__ __forceinline__ float silu_f(float x) { return x / (1.f + __expf(-x)); }
__device__ __forceinline__ float sigmoid_f(float x) { return 1.f / (1.f + __expf(-x)); }
__device__ __forceinline__ float gelu_tanh(float x) { return 0.5f * x * (1.f + tanhf(0.7978845608028654f * (x + 0.044715f * x * x * x))); }
__device__ __forceinline__ float softplus_f(float x) { return x > 20.f ? x : log1pf(__expf(x)); }

#define XB_TMO      128
#define XB_XCNT(j)  (256  + 64 * (j))
#define XB_XSUB(j)  (1280 + 64 * (j))
#define XB_XGEN(j)  (2304 + 64 * (j))
#define XB_TOP      3328
#define XB_TOPGEN   3392
#define XCD_BAR_WORDS 3456
#define XB_SPIN_CAP (1u << 18)
#define LAS __attribute__((address_space(3)))
__device__ __forceinline__ unsigned xb_ld(unsigned* p)              { return __hip_atomic_load(p, __ATOMIC_RELAXED, __HIP_MEMORY_SCOPE_AGENT); }
__device__ __forceinline__ unsigned xb_add(unsigned* p, unsigned v) { return __hip_atomic_fetch_add(p, v, __ATOMIC_RELAXED, __HIP_MEMORY_SCOPE_AGENT); }
__device__ __forceinline__ unsigned xb_xcc_id() { return (unsigned)__builtin_amdgcn_s_getreg((3 << 11) | 20) & 0xFu; }
#define XB_SPIN(cond, bar) do { unsigned _sp = 0; while (cond) { __builtin_amdgcn_s_sleep(1); \
    if ((++_sp & 255u) == 0u) { if (xb_ld(&(bar)[XB_TMO])) break; if (_sp > XB_SPIN_CAP) { atomicAdd(&(bar)[XB_TMO], 1u); break; } } } } while (0)
struct XcdBarrier { unsigned* bar; unsigned x; volatile LAS unsigned* st; };
__device__ __forceinline__ XcdBarrier xcd_barrier_post(unsigned* bar, volatile LAS unsigned* st) {
    XcdBarrier b; b.bar = bar; b.x = xb_xcc_id(); b.st = st;
    if (threadIdx.x == 0) (void)xb_add(&bar[XB_XCNT(b.x)], 1u);
    return b;
}
__device__ __forceinline__ void xcd_barrier_complete(unsigned* bar, unsigned x, unsigned& nloc, unsigned& nx) {
    const unsigned G = gridDim.x * gridDim.y * gridDim.z;
    unsigned sum, cnt, mine, sp = 0u;
    for (;;) {
        sum = 0u; cnt = 0u; mine = 0u;
#pragma unroll
        for (unsigned j = 0; j < 16; ++j) { const unsigned c = xb_ld(&bar[XB_XCNT(j)]); sum += c; cnt += (c > 0u) ? 1u : 0u; mine = (j == x) ? c : mine; }
        if (sum == G) break;
        __builtin_amdgcn_s_sleep(1);
        if ((++sp & 255u) == 0u) { if (xb_ld(&bar[XB_TMO])) break; if (sp > XB_SPIN_CAP) { atomicAdd(&bar[XB_TMO], 1u); break; } }
    }
    nloc = mine > 0u ? mine : 1u; nx = cnt > 0u ? cnt : 1u;
}
__device__ __forceinline__ void xcd_barrier(const XcdBarrier& b) {
    asm volatile("s_waitcnt vmcnt(0)" ::: "memory");
    __syncthreads();
    if (threadIdx.x == 0) {
        unsigned* bar = b.bar;
        __builtin_amdgcn_s_waitcnt(0);
        unsigned nloc = b.st[0], nx = b.st[1];
        if (nloc == 0u) { xcd_barrier_complete(bar, b.x, nloc, nx); b.st[0] = nloc; b.st[1] = nx; }
        const unsigned old = xb_add(&bar[XB_XSUB(b.x)], 1u);
        const unsigned gen = old / nloc;
        if (old + 1u == (gen + 1u) * nloc) {
            __builtin_amdgcn_fence(__ATOMIC_RELEASE, "agent");
            asm volatile("s_waitcnt vmcnt(0)" ::: "memory");
            const unsigned og = xb_add(&bar[XB_TOP], 1u);
            const unsigned tg = og / nx;
            if (og + 1u == (tg + 1u) * nx) xb_add(&bar[XB_TOPGEN], 1u);
            else XB_SPIN(xb_ld(&bar[XB_TOPGEN]) == tg, bar);
            __builtin_amdgcn_fence(__ATOMIC_ACQUIRE, "agent");
            xb_add(&bar[XB_XGEN(b.x)], 1u);
            asm volatile("s_waitcnt vmcnt(0)" ::: "memory");
        } else {
            XB_SPIN(xb_ld(&bar[XB_XGEN(b.x)]) == gen, bar);
            __builtin_amdgcn_fence(__ATOMIC_ACQUIRE, "agent");
            asm volatile("s_waitcnt vmcnt(0)" ::: "memory");
        }
    }
    __syncthreads();
}

constexpr int BM = 256, BK = 64, HALF = 128, HT = HALF * BK;
__device__ __forceinline__ int lds_byte(int r, int c) { int st = (r >> 4) * 2 + (c >> 5), rr = r & 15, cc = c & 31, ob = rr * 64 + cc * 2; return st * 1024 + (ob ^ (((ob >> 9) & 1) << 5)); }
__device__ __forceinline__ void stage_rc(int b, int& R, int& C) { int st = b / 1024, sb = b % 1024, swz = sb ^ (((sb >> 9) & 1) << 5); R = (st >> 1) * 16 + swz / 64; C = (st & 1) * 32 + (swz % 64) / 2; }

template <class Epi>
__device__ __forceinline__ void gemm_tile(const bf16_t* __restrict__ A, const bf16_t* __restrict__ Bt, const int K, const int brow, const int bcol, bf16_t* shm, const Epi& epi) {
#define SA(b, h) (shm + ((b) * 2 + (h)) * HT)
#define SB(b, h) (shm + (4 + (b) * 2 + (h)) * HT)
#define STAGE_X(T, Pp, BASE, br, kt) do { long _g = (long)(br) * K + (long)(kt) * BK; \
    for (int _i = 0; _i < 2; ++_i) { int _b = (T) * 16 + _i * 8192; int _r, _c; stage_rc(_b, _r, _c); \
      __builtin_amdgcn_global_load_lds((const unsigned*)(BASE + _g + (long)_r * K + _c), (LAS unsigned*)((LAS char*)(Pp) + _b), 16, 0, 0); } } while (0)
#define STAGE(Pp, BASE, br, kt) STAGE_X(tx, Pp, BASE, br, kt)
#define LDA(dst, b, h) for (int m = 0; m < 4; ++m) for (int k = 0; k < 2; ++k) \
    dst[m][k] = *reinterpret_cast<const bf16x8*>((char*)SA(b, h) + lds_byte(wr * 64 + m * 16 + fr, k * 32 + fq * 8))
#define LDB(dst, b, h) for (int n = 0; n < 2; ++n) for (int k = 0; k < 2; ++k) \
    dst[n][k] = *reinterpret_cast<const bf16x8*>((char*)SB(b, h) + lds_byte(wc * 32 + n * 16 + fr, k * 32 + fq * 8))
#define MMA(ai, bj, At, Bt_) do { __builtin_amdgcn_s_setprio(1); \
    for (int m = 0; m < 4; ++m) for (int n = 0; n < 2; ++n) for (int k = 0; k < 2; ++k) \
      acc[ai][bj][m][n] = __builtin_amdgcn_mfma_f32_16x16x32_bf16(At[m][k], Bt_[n][k], acc[ai][bj][m][n], 0, 0, 0); \
    __builtin_amdgcn_s_setprio(0); } while (0)
#define WAIT_V(n) asm volatile("s_waitcnt vmcnt(" #n ")" ::: "memory")
#define WAIT_L(n) asm volatile("s_waitcnt lgkmcnt(" #n ")" ::: "memory")
#define BAR __builtin_amdgcn_s_barrier()
#define SCHED __builtin_amdgcn_sched_barrier(0)
    int tx = threadIdx.x; asm volatile("" : "+v"(tx));
    int wid = tx >> 6, lane = tx & 63, wr = wid >> 2, wc = wid & 3, fr = lane & 15, fq = lane >> 4;
    f32x4 acc[2][2][4][2] = {};
    bf16x8 At[4][2], B0[2][2], B1[2][2];
    const int nt = K / BK;
    STAGE(SB(0, 0), Bt, bcol, 0); STAGE(SA(0, 0), A, brow, 0);
    STAGE(SB(0, 1), Bt, bcol + HALF, 0); STAGE(SA(0, 1), A, brow + HALF, 0);
    if (wr == 1) BAR;
    WAIT_V(4); BAR;
    STAGE(SB(1, 0), Bt, bcol, 1); STAGE(SA(1, 0), A, brow, 1); STAGE(SB(1, 1), Bt, bcol + HALF, 1);
    WAIT_V(6); BAR;
    for (int t = 0; t < nt - 2; t += 2) {
        LDB(B0, 0, 0); SCHED; LDA(At, 0, 0); STAGE(SA(1, 1), A, brow + HALF, t + 1);
        WAIT_L(8); BAR; WAIT_L(0); MMA(0, 0, At, B0); BAR; SCHED;
        LDB(B1, 0, 1); STAGE(SB(0, 0), Bt, bcol, t + 2);
        BAR; WAIT_L(0); MMA(0, 1, At, B1); BAR;
        LDA(At, 0, 1); STAGE(SA(0, 0), A, brow, t + 2);
        BAR; WAIT_L(0); MMA(1, 0, At, B0); BAR; SCHED;
        STAGE(SB(0, 1), Bt, bcol + HALF, t + 2);
        WAIT_V(6); BAR; MMA(1, 1, At, B1); BAR;
        LDB(B0, 1, 0); SCHED; LDA(At, 1, 0); STAGE(SA(0, 1), A, brow + HALF, t + 2);
        WAIT_L(8); BAR; WAIT_L(0); MMA(0, 0, At, B0); BAR; SCHED;
        LDB(B1, 1, 1); STAGE(SB(1, 0), Bt, bcol, t + 3);
        BAR; WAIT_L(0); MMA(0, 1, At, B1); BAR;
        LDA(At, 1, 1); STAGE(SA(1, 0), A, brow, t + 3);
        BAR; WAIT_L(0); MMA(1, 0, At, B0); BAR; SCHED;
        STAGE(SB(1, 1), Bt, bcol + HALF, t + 3);
        WAIT_V(6); BAR; MMA(1, 1, At, B1); BAR;
    }
    int tz = threadIdx.x; asm volatile("" : "+v"(tz)); wid = tz >> 6; lane = tz & 63; wr = wid >> 2; wc = wid & 3; fr = lane & 15; fq = lane >> 4;
    { LDB(B0, 0, 0); WAIT_V(0); LDA(At, 0, 0); STAGE_X(tz, SA(1, 1), A, brow + HALF, nt - 1);
      BAR; WAIT_L(0); MMA(0, 0, At, B0); BAR;
      LDB(B1, 0, 1); BAR; WAIT_L(0); MMA(0, 1, At, B1); BAR;
      LDA(At, 0, 1); WAIT_V(4); BAR; WAIT_L(0); MMA(1, 0, At, B0); MMA(1, 1, At, B1); BAR; }
    { LDB(B0, 1, 0); LDA(At, 1, 0); WAIT_V(2); BAR; WAIT_L(0); MMA(0, 0, At, B0); BAR;
      LDB(B1, 1, 1); WAIT_V(0); BAR; WAIT_L(0); MMA(0, 1, At, B1); BAR;
      LDA(At, 1, 1); BAR; WAIT_L(0); MMA(1, 0, At, B0); MMA(1, 1, At, B1); BAR; }
    if (wr == 0) BAR;
#pragma unroll
    for (int ai = 0; ai < 2; ++ai)
#pragma unroll
        for (int bj = 0; bj < 2; ++bj)
#pragma unroll
            for (int m = 0; m < 4; ++m)
#pragma unroll
                for (int n = 0; n < 2; ++n)
#pragma unroll
                    for (int j = 0; j < 4; ++j) epi(brow + ai * HALF + wr * 64 + m * 16 + fq * 4 + j, bcol + bj * HALF + wc * 32 + n * 16 + fr, acc[ai][bj][m][n][j]);
    __syncthreads();
#undef SA
#undef SB
}


template <int NCB, class Epi>
__device__ __forceinline__ void gemm_rows8(const bf16_t* __restrict__ A, const bf16_t* __restrict__ Bt, int cu, unsigned char* lds, const Epi& epi) {
    int tid = threadIdx.x; asm volatile("" : "+v"(tid));
    const int wave = tid >> 6, lane = tid & 63, r16 = lane & 15, quad = lane >> 4, k0 = wave * 256;
    constexpr int NC = 16 * NCB;
    f32x4 acc[NCB];
#pragma unroll
    for (int cb = 0; cb < NCB; ++cb) acc[cb] = (f32x4){0.f, 0.f, 0.f, 0.f};
#pragma unroll
    for (int ks = 0; ks < 8; ++ks) {
        bf16x8 a = (bf16x8){0, 0, 0, 0, 0, 0, 0, 0};
        if (r16 < 8) a = *(const bf16x8*)(A + (size_t)r16 * 2048 + k0 + 32 * ks + 8 * quad);
#pragma unroll
        for (int cb = 0; cb < NCB; ++cb) { const bf16x8 b = *(const bf16x8*)(Bt + (size_t)(cu * NC + 16 * cb + r16) * 2048 + k0 + 32 * ks + 8 * quad); acc[cb] = MFMA16(a, b, acc[cb]); }
    }
    float* red = (float*)lds;
    if (quad < 2) {
#pragma unroll
        for (int cb = 0; cb < NCB; ++cb)
#pragma unroll
            for (int rg = 0; rg < 4; ++rg) red[(wave * 8 + 4 * quad + rg) * NC + 16 * cb + r16] = acc[cb][rg]; }
    __syncthreads();
    if (tid < 8 * NC) { const int row = tid / NC, col = tid % NC; float v = 0.f;
#pragma unroll
      for (int w = 0; w < 8; ++w) v += red[(w * 8 + row) * NC + col];
      epi(NP + row, cu * NC + col, v); }
    __syncthreads();
}
__device__ __forceinline__ void ph0_adaln(const Params& p, int u, float* smem) {
    float* sc = smem;
    float* red = smem + 12 * 2048;
    const int tid = threadIdx.x;
    for (int i = tid; i < 12 * 2048; i += NTHR) { const int r = i >> 11, k = i & 2047; const float c = r < 4 ? p.c_prompt[r * 2048 + k] : p.c_sample[(r - 4) * 2048 + k]; sc[i] = silu_f(c); }
    __syncthreads();
    const int col = u * 64 + (tid & 63), ks = tid >> 6;
    float a[12];
#pragma unroll
    for (int r = 0; r < 12; ++r) a[r] = 0.f;
    const float* w = p.w_ada + (size_t)(ks * 256) * 12288 + col;
#pragma unroll 1
    for (int k0 = 0; k0 < 256; k0 += 16) {
        float wv[16];
#pragma unroll
        for (int kk = 0; kk < 16; ++kk) wv[kk] = w[(size_t)(k0 + kk) * 12288];
#pragma unroll
        for (int kk = 0; kk < 16; ++kk)
#pragma unroll
            for (int r = 0; r < 12; ++r) a[r] += sc[r * 2048 + ks * 256 + k0 + kk] * wv[kk];
    }
#pragma unroll
    for (int r = 0; r < 12; ++r) red[(ks * 12 + r) * 64 + (tid & 63)] = a[r];
    __syncthreads();
    for (int i = tid; i < 12 * 64; i += NTHR) { const int r = i >> 6, c = i & 63; const int cc = u * 64 + c; float s = p.b_ada[cc];
#pragma unroll
        for (int k8 = 0; k8 < 8; ++k8) s += red[(k8 * 12 + r) * 64 + c];
        p.mod[r * 12288 + cc] = s; }
    __syncthreads();
}
__device__ __forceinline__ void ph0_transpose(const float* __restrict__ W, bf16_t* __restrict__ Wt, int Nreal, int ntn, int u, float* smem, int Kdim = 2048) {
    const int tk = u / ntn, tn = u % ntn, k0 = tk * 64, n0 = tn * 64, tid = threadIdx.x;
    for (int i = 0; i < 8; ++i) { const int idx = tid + NTHR * i, kk = idx >> 6, nn = idx & 63; smem[kk * 65 + nn] = (n0 + nn < Nreal) ? W[(size_t)(k0 + kk) * Nreal + n0 + nn] : 0.f; }
    __syncthreads();
    for (int i = 0; i < 8; ++i) { const int idx = tid + NTHR * i, nn = idx >> 6, kk = idx & 63; Wt[(size_t)(n0 + nn) * Kdim + k0 + kk] = f2bf(smem[kk * 65 + nn]); }
    __syncthreads();
}


__device__ __forceinline__ void ph0_cvt(const float* __restrict__ s, bf16_t* __restrict__ d, size_t u) {
    const size_t i = u * 4096 + (size_t)threadIdx.x * 8;
    const float4 a = *(const float4*)(s + i), b = *(const float4*)(s + i + 4);
    *(uint4*)(d + i) = make_uint4((unsigned)f2bf(a.x) | ((unsigned)f2bf(a.y) << 16), (unsigned)f2bf(a.z) | ((unsigned)f2bf(a.w) << 16), (unsigned)f2bf(b.x) | ((unsigned)f2bf(b.y) << 16), (unsigned)f2bf(b.z) | ((unsigned)f2bf(b.w) << 16));
}

__device__ __forceinline__ void ph0_fp8(const float* __restrict__ src, unsigned char* __restrict__ dst, float* __restrict__ scl, int u) {
    const int wave = threadIdx.x >> 6, lane = threadIdx.x & 63, r = u * 8 + wave;
    const float* s = src + (size_t)r * 2048 + lane * 16;
    float4 v[8]; float am = 0.f;
#pragma unroll
    for (int c = 0; c < 2; ++c)
#pragma unroll
        for (int k = 0; k < 4; ++k) { v[c * 4 + k] = *(const float4*)(s + c * 1024 + k * 4); const float4 t = v[c * 4 + k];
            am = fmaxf(am, fmaxf(fmaxf(fabsf(t.x), fabsf(t.y)), fmaxf(fabsf(t.z), fabsf(t.w)))); }
    am = wave_max(am);
    const float sc = fmaxf(am, 1e-30f) * (1.f / 440.f), inv = 1.f / sc;
#pragma unroll
    for (int c = 0; c < 2; ++c) { u32x4 w;
#pragma unroll
        for (int k = 0; k < 4; ++k) { const float4 t = v[c * 4 + k]; int pk = 0; pk = __builtin_amdgcn_cvt_pk_fp8_f32(t.x * inv, t.y * inv, pk, false); pk = __builtin_amdgcn_cvt_pk_fp8_f32(t.z * inv, t.w * inv, pk, true); w[k] = (unsigned)pk; }
        *(u32x4*)(dst + (size_t)(c * 8 + (lane >> 3)) * (16384 * 128) + (size_t)r * 128 + (lane & 7) * 16) = w; }
    if (lane == 0) scl[r] = sc;
}
__device__ __forceinline__ void ph0_keys(const Params& p, int u) {
    for (int k = 0; k < 8; ++k) { const int i = u * 4096 + threadIdx.x * 8 + k; const float x = p.peer_keys[i]; const bf16_t h = f2bf(x); p.kh[i] = h; p.kl[i] = f2bf(x - __uint_as_float((unsigned)h << 16)); }
}
template <int WHICH>
__device__ __forceinline__ void norm_row(const Params& p, int row) {
    const int lane = threadIdx.x & 63;
    bf16_t* dst = (WHICH == 0 ? p.h1 : p.h2) + (size_t)row * 2048;
    if (row >= NTOK) { for (int i = 0; i < 8; ++i) { const int c = i * 256 + lane * 4; *(uint2*)(dst + c) = make_uint2(0u, 0u); } return; }
    const int mrow = row < NP ? row / SEQ : 4 + (row - NP);
    const float* xr = row < NP ? p.x_prompt + (size_t)row * 2048 : p.x_sample + (size_t)(row - NP) * 2048;
    const float* mod = p.mod + (size_t)mrow * 12288;
    const float* nw = WHICH == 0 ? p.norm_mix : p.norm_ffn;
    float4 v[8]; float ss = 0.f;
#pragma unroll
    for (int i = 0; i < 8; ++i) { const int c = i * 256 + lane * 4; v[i] = *(const float4*)(xr + c);
        if (WHICH == 1) { const float4 a = *(const float4*)(p.acc2 + (size_t)row * 2048 + c); const float4 g = *(const float4*)(mod + 4096 + c);
            v[i].x += g.x * a.x; v[i].y += g.y * a.y; v[i].z += g.z * a.z; v[i].w += g.w * a.w; *(float4*)(p.x1 + (size_t)row * 2048 + c) = v[i]; }
        ss += v[i].x * v[i].x + v[i].y * v[i].y + v[i].z * v[i].z + v[i].w * v[i].w; }
    ss = wave_sum(ss);
    const float rstd = rsqrtf(ss * (1.f / 2048.f) + 1e-6f);
    const int osh = WHICH == 0 ? 0 : 6144, osc = WHICH == 0 ? 2048 : 8192;
#pragma unroll
    for (int i = 0; i < 8; ++i) { const int c = i * 256 + lane * 4;
        const float4 w = *(const float4*)(nw + c), sc = *(const float4*)(mod + osc + c), sh = *(const float4*)(mod + osh + c);
        float4 h; h.x = v[i].x * rstd * w.x * (1.f + sc.x) + sh.x; h.y = v[i].y * rstd * w.y * (1.f + sc.y) + sh.y; h.z = v[i].z * rstd * w.z * (1.f + sc.z) + sh.z; h.w = v[i].w * rstd * w.w * (1.f + sc.w) + sh.w;
        uint2 pk; pk.x = (unsigned)f2bf(h.x) | ((unsigned)f2bf(h.y) << 16); pk.y = (unsigned)f2bf(h.z) | ((unsigned)f2bf(h.w) << 16);
        *(uint2*)(dst + c) = pk;
        if (WHICH == 1) {
            int q8 = 0; q8 = __builtin_amdgcn_cvt_pk_fp8_f32(h.x, h.y, q8, false); q8 = __builtin_amdgcn_cvt_pk_fp8_f32(h.z, h.w, q8, true); *(int*)(p.h2q + (size_t)row * 2048 + c) = q8; } }
}

__device__ __forceinline__ void ph3_scatter(const Params& p, int u) {
    const int tid = threadIdx.x;
    if (u >= NSB) { const int b = (u - NSB) / 3, i = (u - NSB) % 3; const float* Pr = p.P + (size_t)(b * SEQ + SEQ - 3 + i) * INCP;
        for (int c = tid; c < 3072; c += NTHR) p.out[O_CVP + ((size_t)b * 3 + i) * 3072 + c] = Pr[C_QKV + c];
        return; }
    const int b = u, row = NP + b;
    const float* Pr = p.P + (size_t)row * INCP;
    { const int c = tid * 2; *(unsigned*)(p.Qb + (size_t)row * 1024 + c) = (unsigned)f2bf(Pr[C_Q + c]) | ((unsigned)f2bf(Pr[C_Q + c + 1]) << 16);
      *(unsigned*)(p.KVb + (size_t)row * 1024 + c) = (unsigned)f2bf(Pr[C_KVS + c]) | ((unsigned)f2bf(Pr[C_KVS + c + 1]) << 16); }
    p.out[O_CKS + b * 512 + tid] = Pr[C_KVC + tid];
    p.out[O_SKS + b * 512 + tid] = Pr[C_KVS + tid];
    p.out[O_WKS + ((size_t)b * 512 + 511) * 512 + tid] = Pr[C_KVW + tid];
    for (int i = 0; i < 3; ++i) for (int c = tid; c < 3072; c += NTHR) p.out[O_CVS + ((size_t)b * 3 + i) * 3072 + c] = i < 2 ? p.state_conv[((size_t)b * 3 + i + 1) * 3072 + c] : Pr[C_QKV + c];
}
constexpr int CP_A = 0, CP_B = 34816, CP_H = 69632;
template <bool SMP>
__device__ __forceinline__ void cmp_tile(const Params& p, int tile, int s, unsigned char* lds) {
    int tid = threadIdx.x; asm volatile("" : "+v"(tid));
    const int wave = tid >> 6, lane = tid & 63, r16 = lane & 15, quad = lane >> 4, wr = wave >> 1, wc = wave & 1;
    const int NC = SMP ? 512 : 64, STR = 512;
    const float* abase[8];
#pragma unroll
    for (int i = 0; i < 8; ++i) { const int id = tid + 512 * i, R = tile * 128 + (id >> 5), part = id & 31;
        const int h = R & 1, n = (R >> 1) & (NC - 1), b = R / (2 * NC);
        if (SMP) abase[i] = p.cache_cmp + ((size_t)p.page_table[b * NPAGES + (n >> 2)] * 128 + (n & 3) * 32) * 512 + s * 256 + h * 128 + part * 4;
        else abase[i] = p.out + O_CKP + (size_t)(b * SEQ + n * 32) * 512 + s * 256 + h * 128 + part * 4; }
    const float* pe = p.cmp_pe + (size_t)s * 4096 + ((tid & 31) * 4);
    const bf16_t* bsrc[4];
#pragma unroll
    for (int i = 0; i < 4; ++i) { const int id = tid + 512 * i; bsrc[i] = p.w1t + ((size_t)s * 128 + (id >> 4)) * 4096 + (id & 15) * 8; }
    float4 av[8]; u32x4 bv[4];
#pragma unroll
    for (int i = 0; i < 8; ++i) av[i] = *(const float4*)(abase[i]);
#pragma unroll
    for (int i = 0; i < 4; ++i) bv[i] = *(const u32x4*)(bsrc[i]);
    f32x4 acc[2][4];
#pragma unroll
    for (int a = 0; a < 2; ++a) for (int c = 0; c < 4; ++c) acc[a][c] = (f32x4){0.f, 0.f, 0.f, 0.f};
    unsigned char* Ab = lds + CP_A; unsigned char* Bb = lds + CP_B;
#pragma unroll 1
    for (int l = 0; l < 32; ++l) {
        { const float4 pv = *(const float4*)(pe + l * 128);
#pragma unroll
          for (int i = 0; i < 8; ++i) { const int id = tid + 512 * i; uint2 w; w.x = pk2(av[i].x + pv.x, av[i].y + pv.y); w.y = pk2(av[i].z + pv.z, av[i].w + pv.w);
              *(uint2*)(Ab + (id >> 5) * 272 + (id & 31) * 8) = w; } }
#pragma unroll
        for (int i = 0; i < 4; ++i) { const int id = tid + 512 * i; *(u32x4*)(Bb + (id >> 4) * 272 + (id & 15) * 16) = bv[i]; }
        __syncthreads();
        if (l + 1 < 32) {
#pragma unroll
            for (int i = 0; i < 8; ++i) av[i] = *(const float4*)(abase[i] + (size_t)(l + 1) * STR);
#pragma unroll
            for (int i = 0; i < 4; ++i) bv[i] = *(const u32x4*)(bsrc[i] + (l + 1) * 128); }
#pragma unroll
        for (int ks = 0; ks < 4; ++ks) { bf16x8 a[2], b[4];
#pragma unroll
            for (int rb = 0; rb < 2; ++rb) a[rb] = *(const bf16x8*)(Ab + (32 * wr + 16 * rb + r16) * 272 + (32 * ks + 8 * quad) * 2);
#pragma unroll
            for (int cb = 0; cb < 4; ++cb) b[cb] = *(const bf16x8*)(Bb + (64 * wc + 16 * cb + r16) * 272 + (32 * ks + 8 * quad) * 2);
#pragma unroll
            for (int rb = 0; rb < 2; ++rb)
#pragma unroll
                for (int cb = 0; cb < 4; ++cb) acc[rb][cb] = MFMA16(a[rb], b[cb], acc[rb][cb]); }
        __syncthreads();
    }
    unsigned char* H = lds + CP_H;
#pragma unroll
    for (int rb = 0; rb < 2; ++rb)
#pragma unroll
        for (int cb = 0; cb < 4; ++cb) { const int e = 64 * wc + 16 * cb + r16; const float b1 = p.cmp_b1[s * 128 + e];
#pragma unroll
            for (int rg = 0; rg < 4; ++rg) *(bf16_t*)(H + (32 * wr + 16 * rb + 4 * quad + rg) * 272 + e * 2) = f2bf(gelu_tanh(acc[rb][cb][rg] + b1)); }
    __syncthreads();
    float* dst = SMP ? p.ckv_s : p.ckv_p;
#pragma unroll
    for (int rb = 0; rb < 2; ++rb)
#pragma unroll
        for (int cb = 0; cb < 4; ++cb) { f32x4 o = (f32x4){0.f, 0.f, 0.f, 0.f}; const int d = 64 * wc + 16 * cb + r16;
#pragma unroll
            for (int ks = 0; ks < 4; ++ks) { const bf16x8 a = *(const bf16x8*)(H + (32 * wr + 16 * rb + r16) * 272 + (32 * ks + 8 * quad) * 2);
                const bf16x8 b = *(const bf16x8*)(p.w2t + ((size_t)s * 128 + d) * 128 + 32 * ks + 8 * quad); o = MFMA16(a, b, o); }
#pragma unroll
            for (int rg = 0; rg < 4; ++rg) { const int R = tile * 128 + 32 * wr + 16 * rb + 4 * quad + rg; const int h = R & 1, n = (R >> 1) & (NC - 1), b = R / (2 * NC);
                dst[((((size_t)b * NC + n) * 2 + s) * 2 + h) * 128 + d] = o[rg]; } }
    __syncthreads();
}
__device__ __forceinline__ void ph3_gdnprep(const Params& p, int row, float* smem) {
    float* cv = smem;
    const int tid = threadIdx.x;
    const float* Pr = p.P + (size_t)row * INCP;
    for (int c = tid; c < 3072; c += NTHR) {
        float acc = 0.f;
        if (row < NP) { const int t = row % SEQ;
#pragma unroll
            for (int i = 0; i < 4; ++i) { const int tt = t - 3 + i; if (tt >= 0) acc += p.P[(size_t)(row - 3 + i) * INCP + C_QKV + c] * p.conv_w[i * 3072 + c]; } }
        else { const int b = row - NP;
#pragma unroll
            for (int i = 0; i < 3; ++i) acc += p.state_conv[((size_t)b * 3 + i) * 3072 + c] * p.conv_w[i * 3072 + c];
            acc += Pr[C_QKV + c] * p.conv_w[3 * 3072 + c]; }
        cv[c] = silu_f(acc);
    }
    __syncthreads();
    const int wave = tid >> 6, lane = tid & 63;
    for (int hh = wave; hh < 16; hh += 8) {
        const float a = cv[hh * 128 + lane], b2 = cv[hh * 128 + 64 + lane];
        const float ss = wave_sum(a * a + b2 * b2);
        float r = rsqrtf(ss + 1e-6f); if (hh < 8) r *= 0.08838834764831845f;
        p.qkvn[(size_t)row * 3072 + hh * 128 + lane] = a * r; p.qkvn[(size_t)row * 3072 + hh * 128 + 64 + lane] = b2 * r;
    }
    for (int c = tid; c < 1024; c += NTHR) p.qkvn[(size_t)row * 3072 + 2048 + c] = cv[2048 + c];
    if (tid < 8) { p.gbeta[row * 8 + tid] = sigmoid_f(Pr[C_BL + tid]); p.gg[row * 8 + tid] = -__expf(p.a_log[tid]) * softplus_f(Pr[C_AL + tid] + p.dt_bias[tid]); }
    __syncthreads();
}

template <int BR, bool SMP>
__device__ __forceinline__ void nsa_key(const Params& p, int b, int tpos, int kvh, int j, const int* sel, int& pos, bool& valid, const float*& kp, const float*& vp) {
    if (BR == 0) {
        const int NC = SMP ? 512 : 64; pos = 32 * j + 31; valid = pos <= tpos;
        const float* base = (SMP ? p.ckv_s : p.ckv_p) + (((size_t)b * NC + j) * 4) * 128; kp = base + kvh * 128; vp = base + (2 + kvh) * 128;
    } else if (BR == 1) {
        const int blk = sel[j >> 6]; pos = blk * 64 + (j & 63); valid = pos <= tpos;
        const float* base;
        if (!SMP) base = p.P + (size_t)(b * SEQ + (valid ? pos : 0)) * INCP + C_KVS;
        else if (pos < PAST) base = p.cache_sel + ((size_t)p.page_table[b * NPAGES + (pos >> 7)] * 128 + (pos & 127)) * 512;
        else base = p.P + (size_t)(NP + b) * INCP + C_KVS;
        kp = base + kvh * 128; vp = base + 256 + kvh * 128;
    } else {
        const float* base;
        if (!SMP) { pos = tpos - 511 + j; valid = pos >= 0; base = p.P + (size_t)(b * SEQ + (valid ? pos : 0)) * INCP + C_KVW; }
        else { const int jj = j + 1; pos = PAST - 512 + jj; valid = true; base = jj < 512 ? p.state_win + ((size_t)b * 512 + jj) * 512 : p.P + (size_t)(NP + b) * INCP + C_KVW; }
        kp = base + kvh * 128; vp = base + 256 + kvh * 128;
    }
}
template <int BR, bool SMP>
__device__ __forceinline__ void nsa_branch(const Params& p, int b, int tpos, int kvh, int nkeys, const int* sel, const float* myq, float* mysc, float slope, int lane, float& r0, float& r1) {
    const float scale = 0.08838834764831845f;
    float mloc = -1e30f;
    for (int j0 = 0; j0 < nkeys; j0 += 64) {
        const int j = j0 + lane; float s = -1e30f;
        if (j < nkeys) {
            int pos; bool valid; const float *kp, *vp; nsa_key<BR, SMP>(p, b, tpos, kvh, j, sel, pos, valid, kp, vp);
            if (valid) { float dot = 0.f;
                for (int d = 0; d < 128; d += 4) { const float4 kv = *(const float4*)(kp + d); dot += myq[d] * kv.x + myq[d + 1] * kv.y + myq[d + 2] * kv.z + myq[d + 3] * kv.w; }
                s = dot * scale - slope * (float)(tpos - pos); }
            mysc[j] = s;
        }
        mloc = fmaxf(mloc, s);
    }
    const float m = wave_max(mloc);
    float lsum = 0.f;
    for (int j0 = 0; j0 < nkeys; j0 += 64) { const int j = j0 + lane; if (j < nkeys) { const float s = mysc[j]; const float e = s > -1e29f ? __expf(s - m) : 0.f; mysc[j] = e; lsum += e; } }
    const float l = wave_sum(lsum);
    const float linv = l > 0.f ? 1.f / l : 0.f;
    for (int j0 = 0; j0 < nkeys; j0 += 64) { const int j = j0 + lane; if (j < nkeys) mysc[j] *= linv; }
    float a0 = 0.f, a1 = 0.f;
    for (int j = 0; j < nkeys; ++j) {
        const float pj = mysc[j];
        if (pj != 0.f) { int pos; bool valid; const float *kp, *vp; nsa_key<BR, SMP>(p, b, tpos, kvh, j, sel, pos, valid, kp, vp);
            const float2 vv = *(const float2*)(vp + 2 * lane); a0 += pj * vv.x; a1 += pj * vv.y; }
    }
    r0 = a0; r1 = a1;
}
template <bool SMP>
__device__ __forceinline__ void ph4_nsa(const Params& p, int b, int t, float* smem) {
    float* q_s = smem;
    float* sc = smem + 1024;
    int* sel_s = (int*)(sc + 8 * 1024);
    const int tid = threadIdx.x, wave = tid >> 6, lane = tid & 63, hd = wave, kvh = wave >> 2;
    const int row = SMP ? NP + b : b * SEQ + t, tpos = SMP ? PAST : t;
    const float* Pr = p.P + (size_t)row * INCP;
    for (int i = tid; i < 1024; i += NTHR) q_s[i] = Pr[C_Q + i];
    __syncthreads();
    const float slope = exp2f(-(float)(hd + 1));
    float* mysc = sc + wave * 1024; const float* myq = q_s + hd * 128;
    const int NC = SMP ? 512 : 64;
    float c0, c1, s0, s1, w0, w1;
    nsa_branch<0, SMP>(p, b, tpos, kvh, NC, nullptr, myq, mysc, slope, lane, c0, c1);
    __syncthreads();
    const int cur = tpos >> 6, ncand = cur + 1, nsel = ncand < 16 ? ncand : 16;
    if ((wave & 3) == 0) {
        float val[5];
#pragma unroll
        for (int i = 0; i < 5; ++i) { const int blk = lane + 64 * i; float v = -INFINITY;
            if (blk < ncand) { const bool forced = blk == 0 || blk == cur || blk == cur - 1; float imp = 0.f;
                if (!forced) { for (int g = 0; g < 4; ++g) { const float* ps = sc + (kvh * 4 + g) * 1024; if (2 * blk < NC) imp += ps[2 * blk]; if (2 * blk + 1 < NC) imp += ps[2 * blk + 1]; } }
                v = forced ? 1e4f : imp; }
            val[i] = v; }
        for (int r = 0; r < nsel; ++r) {
            float bv = val[0]; int bi = lane;
#pragma unroll
            for (int i = 1; i < 5; ++i) if (val[i] > bv) { bv = val[i]; bi = lane + 64 * i; }
            for (int o = 32; o > 0; o >>= 1) { const float ov = __shfl_xor(bv, o); const int oi = __shfl_xor(bi, o); if (ov > bv || (ov == bv && oi < bi)) { bv = ov; bi = oi; } }
            if (lane == 0) sel_s[kvh * 16 + r] = bi;
#pragma unroll
            for (int i = 0; i < 5; ++i) if (lane + 64 * i == bi) val[i] = -INFINITY;
        }
    }
    __syncthreads();
    nsa_branch<1, SMP>(p, b, tpos, kvh, nsel * 64, sel_s + kvh * 16, myq, mysc, slope, lane, s0, s1);
    nsa_branch<2, SMP>(p, b, tpos, kvh, 512, nullptr, myq, mysc, slope, lane, w0, w1);
    const float g0 = sigmoid_f(Pr[C_GTS + hd * 3 + 0]), g1 = sigmoid_f(Pr[C_GTS + hd * 3 + 1]), g2 = sigmoid_f(Pr[C_GTS + hd * 3 + 2]);
    const float o0 = g0 * c0 + g1 * s0 + g2 * w0, o1 = g0 * c1 + g1 * s1 + g2 * w1;
    *(unsigned*)(p.amix + (size_t)row * 2048 + hd * 128 + 2 * lane) = (unsigned)f2bf(o0) | ((unsigned)f2bf(o1) << 16);
    __syncthreads();
}

constexpr int NSA_KT0 = 0, NSA_VS0 = 17408, NSA_KT1 = 37888, NSA_VS1 = 55296, NSA_IMP = 75776, NSA_SELM = NSA_IMP + 4 * 64 * 33 * 4, NSA_UNI = NSA_SELM + 256;
typedef short s16x4 __attribute__((ext_vector_type(4)));
__device__ __forceinline__ bf16x8 pack8(float x0, float x1, float x2, float x3, float x4, float x5, float x6, float x7) {
    u32x4 p;
    asm volatile("v_cvt_pk_bf16_f32 %0, %4, %5\n\tv_cvt_pk_bf16_f32 %1, %6, %7\n\tv_cvt_pk_bf16_f32 %2, %8, %9\n\tv_cvt_pk_bf16_f32 %3, %10, %11\n\ts_nop 1"
                 : "=&v"(p[0]), "=&v"(p[1]), "=&v"(p[2]), "=&v"(p[3]) : "v"(x0), "v"(x1), "v"(x2), "v"(x3), "v"(x4), "v"(x5), "v"(x6), "v"(x7));
    return __builtin_bit_cast(bf16x8, p);
}
__device__ __forceinline__ void nsa_fetch(const bf16_t* kbase, const bf16_t* vbase, int rs, int tid, uint4 (&kr)[2], uint4 (&vr)[2]) {
#pragma unroll
    for (int u = 0; u < 2; ++u) { const int c = tid + 512 * u; kr[u] = *(const uint4*)(kbase + (size_t)(c >> 4) * rs + (c & 15) * 8); vr[u] = *(const uint4*)(vbase + (size_t)(c >> 4) * rs + (c & 15) * 8); }
}
__device__ __forceinline__ void nsa_store(unsigned char* Kt, unsigned char* Vs, int tid, const uint4 (&kr)[2], const uint4 (&vr)[2]) {
#pragma unroll
    for (int u = 0; u < 2; ++u) { const int c = tid + 512 * u; *(uint4*)(Kt + (c >> 4) * 272 + (c & 15) * 16) = kr[u]; *(uint4*)(Vs + (c >> 4) * 320 + (c & 15) * 16) = vr[u]; }
}
template <int MODE>
__device__ __forceinline__ void nsa_tile(const unsigned char* Kt, const unsigned char* Vt, const bf16x8 (&qf)[8], int lane, int kb0, int t, float scl, float slp, bool sel, int edge,
                                         float& m, float& l, f32x16 (&O)[4], f32x16 (&S)[2], bf16x8 (&pf)[4]) {
    const int ql = lane & 31, h = lane >> 5;
#pragma unroll
    for (int b2 = 0; b2 < 2; ++b2) {
        f32x16 acc; for (int r = 0; r < 16; ++r) acc[r] = 0.f;
        bf16x8 kf[8];
#pragma unroll
        for (int s = 0; s < 8; ++s) kf[s] = *(const bf16x8*)(Kt + (32 * b2 + ql) * 272 + (16 * s + 8 * h) * 2);
#pragma unroll
        for (int s = 0; s < 8; ++s) acc = MFMA32(kf[s], qf[s], acc);
        S[b2] = acc;
    }
    float tmax = -1e30f;
    const int KS = MODE == 0 ? 32 : 1;
    const int d0 = MODE == 0 ? t - 31 - 128 * h : t - kb0 - 4 * h;
    const float nb0 = -slp * (float)d0, slk = slp * (float)KS;
#pragma unroll
    for (int b2 = 0; b2 < 2; ++b2)
#pragma unroll
        for (int r = 0; r < 16; ++r) {
            const int c = 32 * b2 + 8 * (r >> 2) + (r & 3);
            bool valid;
            if (MODE == 0) valid = d0 >= KS * c;
            else if (MODE == 1) valid = sel && (!(edge & 1) || d0 >= c);
            else valid = (!(edge & 1) || d0 >= c) && (!(edge & 2) || d0 < 512 + c);
            const float sc = __builtin_fmaf(S[b2][r], scl, __builtin_fmaf(slk, (float)c, nb0));
            const float sv = valid ? sc : -1e30f;
            S[b2][r] = sv; tmax = fmaxf(tmax, sv);
        }
    tmax = fmaxf(tmax, __shfl_xor(tmax, 32));
    const float mn = fmaxf(m, tmax);
    const float alpha = __builtin_amdgcn_exp2f(m - mn);
    m = mn;
    if (!__all(alpha == 1.f)) {
        l *= alpha;
#pragma unroll
        for (int d = 0; d < 4; ++d)
#pragma unroll
            for (int r = 0; r < 16; ++r) O[d][r] *= alpha;
    }
    float ls = 0.f;
#pragma unroll
    for (int b2 = 0; b2 < 2; ++b2)
#pragma unroll
        for (int r = 0; r < 16; ++r) { const float sv = S[b2][r]; const float pv = sv > -1e29f ? __builtin_amdgcn_exp2f(sv - mn) : 0.f; S[b2][r] = pv; ls += pv; }
    l += ls;
#pragma unroll
    for (int ks = 0; ks < 4; ++ks) { const int b2 = ks >> 1, s = ks & 1;
        pf[ks] = pack8(S[b2][8 * s], S[b2][8 * s + 1], S[b2][8 * s + 2], S[b2][8 * s + 3], S[b2][8 * s + 4], S[b2][8 * s + 5], S[b2][8 * s + 6], S[b2][8 * s + 7]); }
}
__device__ __forceinline__ void nsa_pv(const unsigned char* Vs, int lane, f32x16 (&O)[4], const bf16x8 (&pf)[4]) {
    const int g = lane >> 4, i16 = lane & 15, h = g >> 1;
    const unsigned char* vb = Vs + (4 * h + (i16 >> 2)) * 320 + (16 * (g & 1) + 4 * (i16 & 3)) * 2;
#pragma unroll
    for (int d = 0; d < 4; ++d) {
        s16x4 lo[4], hi[4];
#pragma unroll
        for (int ks = 0; ks < 4; ++ks) { lo[ks] = __builtin_amdgcn_ds_read_tr16_b64_v4i16((LAS s16x4*)(vb + (16 * ks) * 320 + 64 * d)); hi[ks] = __builtin_amdgcn_ds_read_tr16_b64_v4i16((LAS s16x4*)(vb + (16 * ks + 8) * 320 + 64 * d)); }
#pragma unroll
        for (int ks = 0; ks < 4; ++ks) { const bf16x8 av = __builtin_shufflevector(lo[ks], hi[ks], 0, 1, 2, 3, 4, 5, 6, 7); O[d] = MFMA32(av, pf[ks], O[d]); }
    }
}
template <bool FIRST>
__device__ __forceinline__ void nsa_flush(bf16_t* orow, int h, float f, f32x16 (&O)[4]) {
#pragma unroll
    for (int d = 0; d < 4; ++d)
#pragma unroll
        for (int rg = 0; rg < 4; ++rg) {
            uint2* dst = (uint2*)(orow + 32 * d + 8 * rg + 4 * h);
            float a0 = O[d][4 * rg] * f, a1 = O[d][4 * rg + 1] * f, a2 = O[d][4 * rg + 2] * f, a3 = O[d][4 * rg + 3] * f;
            if (!FIRST) { const uint2 old = *dst; a0 += __uint_as_float(old.x << 16); a1 += __uint_as_float(old.x & 0xffff0000u); a2 += __uint_as_float(old.y << 16); a3 += __uint_as_float(old.y & 0xffff0000u); }
            uint2 w; w.x = pk2(a0, a1); w.y = pk2(a2, a3); *dst = w;
            O[d][4 * rg] = 0.f; O[d][4 * rg + 1] = 0.f; O[d][4 * rg + 2] = 0.f; O[d][4 * rg + 3] = 0.f;
        }
}
__device__ __forceinline__ void ph4_nsa_fast(const Params& p, int u, unsigned char* lds) {
    int tid = threadIdx.x; asm volatile("" : "+v"(tid));
    const int wave = tid >> 6, lane = tid & 63, ql = lane & 31;
    const int i = 31 - (u >> 3), b = (u & 7) >> 1, kvh = u & 1;
    const int g = wave >> 1, qh = wave & 1, hd = kvh * 4 + g;
    const int t = i * 64 + qh * 32 + ql;
    const size_t row = (size_t)b * SEQ + t;
    float* imp = (float*)(lds + NSA_IMP); unsigned* selm = (unsigned*)(lds + NSA_SELM); unsigned* uni = (unsigned*)(lds + NSA_UNI);
    bf16x8 qf[8];
    { const bf16_t* qrow = p.Qb + row * 1024 + hd * 128 + 8 * (lane >> 5);
#pragma unroll
      for (int s = 0; s < 8; ++s) qf[s] = *(const bf16x8*)(qrow + 16 * s); }
    const float LOG2E = 1.4426950408889634f;
    const float scl = 0.08838834764831845f * LOG2E, slp = exp2f(-(float)(hd + 1)) * LOG2E;
    const float* Pr = p.P + row * INCP;
    const float g0 = sigmoid_f(Pr[C_GTS + hd * 3 + 0]), g1 = sigmoid_f(Pr[C_GTS + hd * 3 + 1]), g2 = sigmoid_f(Pr[C_GTS + hd * 3 + 2]);
    f32x16 O[4], S[2];
#pragma unroll
    for (int d = 0; d < 4; ++d) for (int r = 0; r < 16; ++r) O[d][r] = 0.f;
    bf16_t* orow = p.amix + row * 2048 + hd * 128;
    uint4 kr[2], vr[2];
    if (wave >= 4) __builtin_amdgcn_s_setprio(1);
    int cnt = 0;
#define KT(k) (lds + (((k) & 1) ? NSA_KT1 : NSA_KT0))
#define VS(k) (lds + (((k) & 1) ? NSA_VS1 : NSA_VS0))
    {
        const float* cb = p.ckv_p + (size_t)b * 64 * 512;
#pragma unroll
        for (int uu = 0; uu < 2; ++uu) { const int c = tid + 512 * uu, n = c >> 4, part = c & 15;
            const float4 a = *(const float4*)(cb + (size_t)n * 512 + kvh * 128 + part * 8), bq = *(const float4*)(cb + (size_t)n * 512 + kvh * 128 + part * 8 + 4);
            kr[uu] = make_uint4(pk2(a.x, a.y), pk2(a.z, a.w), pk2(bq.x, bq.y), pk2(bq.z, bq.w));
            const float4 c4 = *(const float4*)(cb + (size_t)n * 512 + 256 + kvh * 128 + part * 8), d4 = *(const float4*)(cb + (size_t)n * 512 + 256 + kvh * 128 + part * 8 + 4);
            vr[uu] = make_uint4(pk2(c4.x, c4.y), pk2(c4.z, c4.w), pk2(d4.x, d4.y), pk2(d4.z, d4.w)); }
        nsa_store(KT(cnt), VS(cnt), tid, kr, vr);
        __syncthreads();
        float m = -1e30f, l = 0.f;
        bf16x8 pf[4];
        nsa_tile<0>(KT(cnt), nullptr, qf, lane, 0, t, scl, slp, true, 0, m, l, O, S, pf);
        nsa_pv(VS(cnt), lane, O, pf);
        ++cnt;
        const float lt = l + __shfl_xor(l, 32);
        const float linv = lt > 0.f ? 1.f / lt : 0.f;
        float* ip = imp + (size_t)(g * 64 + qh * 32 + ql) * 33;
#pragma unroll
        for (int b2 = 0; b2 < 2; ++b2)
#pragma unroll
            for (int r = 0; r < 16; r += 2) { const int ko = 32 * b2 + 8 * (r >> 2) + 4 * (lane >> 5) + (r & 3); ip[ko >> 1] = (S[b2][r] + S[b2][r + 1]) * linv; }
        nsa_flush<true>(orow, lane >> 5, g0 * linv, O);
    }
    __syncthreads();
    {
        const int qq = tid >> 3, sub = tid & 7, ncand = i + 1;
        unsigned mask;
        if (ncand <= 16) mask = (1u << ncand) - 1u;
        else {
            float val[4];
#pragma unroll
            for (int c = 0; c < 4; ++c) { const int blk = sub + 8 * c; float v = -INFINITY;
                if (blk < ncand) { const bool forced = blk == 0 || blk == i || blk == i - 1;
                    v = forced ? 1e4f : imp[(0 * 64 + qq) * 33 + blk] + imp[(1 * 64 + qq) * 33 + blk] + imp[(2 * 64 + qq) * 33 + blk] + imp[(3 * 64 + qq) * 33 + blk]; }
                val[c] = v; }
            mask = 0u;
            for (int r = 0; r < 16; ++r) {
                float bv = val[0]; int bi = sub;
#pragma unroll
                for (int c = 1; c < 4; ++c) if (val[c] > bv) { bv = val[c]; bi = sub + 8 * c; }
#pragma unroll
                for (int o = 4; o > 0; o >>= 1) { const float ov = __shfl_xor(bv, o); const int oi = __shfl_xor(bi, o); if (ov > bv || (ov == bv && oi < bi)) { bv = ov; bi = oi; } }
                mask |= 1u << bi;
#pragma unroll
                for (int c = 0; c < 4; ++c) if (sub + 8 * c == bi) val[c] = -INFINITY;
            }
        }
        if (sub == 0) selm[qq] = mask;
    }
    __syncthreads();
    if (wave == 0) { unsigned um = selm[lane]; for (int o = 32; o > 0; o >>= 1) um |= __shfl_xor(um, o); if (lane == 0) uni[0] = um; }
    __syncthreads();
    const unsigned mymask = selm[qh * 32 + ql], umask = uni[0];
    {
        const bf16_t* kvb = p.KVb + (size_t)b * SEQ * 1024 + kvh * 128;
        float m = -1e30f, l = 0.f;
        int j = i;
        nsa_fetch(kvb + (size_t)j * 64 * 1024, kvb + (size_t)j * 64 * 1024 + 256, 1024, tid, kr, vr);
        nsa_store(KT(cnt), VS(cnt), tid, kr, vr);
        __syncthreads();
        while (j >= 0) {
            int jn = j - 1; while (jn >= 0 && !((umask >> jn) & 1u)) --jn;
            const bool sel = (mymask >> j) & 1u; const bool any = __any(sel);
            bf16x8 pf[4];
            if (any) nsa_tile<1>(KT(cnt), nullptr, qf, lane, j * 64, t, scl, slp, sel, j == i ? 1 : 0, m, l, O, S, pf);
            if (jn >= 0) nsa_fetch(kvb + (size_t)jn * 64 * 1024, kvb + (size_t)jn * 64 * 1024 + 256, 1024, tid, kr, vr);
            if (any) nsa_pv(VS(cnt), lane, O, pf);
            ++cnt;
            if (jn >= 0) nsa_store(KT(cnt), VS(cnt), tid, kr, vr);
            __syncthreads();
            j = jn;
        }
        const float lt = l + __shfl_xor(l, 32);
        nsa_flush<false>(orow, lane >> 5, lt > 0.f ? g1 / lt : 0.f, O);
    }
    {
        const bf16_t* kvb = p.KVb + (size_t)b * SEQ * 1024 + 512 + kvh * 128;
        float m = -1e30f, l = 0.f;
        const int jlo = i - 8 < 0 ? 0 : i - 8;
        int j = i;
        nsa_fetch(kvb + (size_t)j * 64 * 1024, kvb + (size_t)j * 64 * 1024 + 256, 1024, tid, kr, vr);
        nsa_store(KT(cnt), VS(cnt), tid, kr, vr);
        __syncthreads();
        while (j >= jlo) {
            bf16x8 pf[4];
            nsa_tile<2>(KT(cnt), nullptr, qf, lane, j * 64, t, scl, slp, true, (j == i ? 1 : 0) | (j == i - 8 ? 2 : 0), m, l, O, S, pf);
            if (j - 1 >= jlo) nsa_fetch(kvb + (size_t)(j - 1) * 64 * 1024, kvb + (size_t)(j - 1) * 64 * 1024 + 256, 1024, tid, kr, vr);
            nsa_pv(VS(cnt), lane, O, pf);
            ++cnt;
            if (j - 1 >= jlo) nsa_store(KT(cnt), VS(cnt), tid, kr, vr);
            __syncthreads();
            --j;
        }
        const float lt = l + __shfl_xor(l, 32);
        nsa_flush<false>(orow, lane >> 5, lt > 0.f ? g2 / lt : 0.f, O);
    }
#undef KT
#undef VS
    __builtin_amdgcn_s_setprio(0);
    __syncthreads();
}

constexpr int NS_Q = 0, NS_SC = 2048, NS_SEL = NS_SC + 4 * 2048 * 4, NS_RED = NS_SEL + 256;
__device__ __forceinline__ void ns_softmax(float* s, int lo, int hi, int lane, float mult) {
    float m = -1e30f;
    for (int j = lo + lane; j < hi; j += 64) m = fmaxf(m, s[j]);
    m = wave_max(m);
    float sum = 0.f;
    for (int j = lo + lane; j < hi; j += 64) { const float v = s[j]; const float e = v > -1e29f ? __expf(v - m) : 0.f; s[j] = e; sum += e; }
    sum = wave_sum(sum);
    const float f = sum > 0.f ? mult / sum : 0.f;
    for (int j = lo + lane; j < hi; j += 64) s[j] *= f;
}
__device__ __forceinline__ void ns_scores(const float* q_s, const float* kp, bool valid, int dist, int kvh, float* sc, int j) {
    float a0 = 0.f, a1 = 0.f, a2 = 0.f, a3 = 0.f;
    if (valid) {
#pragma unroll 16
        for (int d = 0; d < 128; d += 4) { const float4 kv = *(const float4*)(kp + d);
            a0 += q_s[d] * kv.x + q_s[d + 1] * kv.y + q_s[d + 2] * kv.z + q_s[d + 3] * kv.w;
            a1 += q_s[128 + d] * kv.x + q_s[128 + d + 1] * kv.y + q_s[128 + d + 2] * kv.z + q_s[128 + d + 3] * kv.w;
            a2 += q_s[256 + d] * kv.x + q_s[256 + d + 1] * kv.y + q_s[256 + d + 2] * kv.z + q_s[256 + d + 3] * kv.w;
            a3 += q_s[384 + d] * kv.x + q_s[384 + d + 1] * kv.y + q_s[384 + d + 2] * kv.z + q_s[384 + d + 3] * kv.w; }
    }
    const float scale = 0.08838834764831845f, fd = (float)dist;
    sc[0 * 2048 + j] = valid ? a0 * scale - exp2f(-(float)(kvh * 4 + 1)) * fd : -1e30f;
    sc[1 * 2048 + j] = valid ? a1 * scale - exp2f(-(float)(kvh * 4 + 2)) * fd : -1e30f;
    sc[2 * 2048 + j] = valid ? a2 * scale - exp2f(-(float)(kvh * 4 + 3)) * fd : -1e30f;
    sc[3 * 2048 + j] = valid ? a3 * scale - exp2f(-(float)(kvh * 4 + 4)) * fd : -1e30f;
}
__device__ __forceinline__ void ph4_nsa_sample(const Params& p, int u, unsigned char* lds) {
    int tid = threadIdx.x; asm volatile("" : "+v"(tid));
    const int wave = tid >> 6, lane = tid & 63, b = u >> 1, kvh = u & 1, row = NP + b, tpos = PAST;
    float* q_s = (float*)(lds + NS_Q); float* sc = (float*)(lds + NS_SC); int* sel_s = (int*)(lds + NS_SEL); float* red = (float*)(lds + NS_RED);
    const float* Pr = p.P + (size_t)row * INCP;
    q_s[tid] = Pr[C_Q + kvh * 512 + tid];
    __syncthreads();
    { int pos; bool valid; const float *kp, *vp; nsa_key<0, true>(p, b, tpos, kvh, tid, nullptr, pos, valid, kp, vp); ns_scores(q_s, kp, valid, tpos - pos, kvh, sc, tid); }
    __syncthreads();
    if (wave < 4) ns_softmax(sc + wave * 2048, 0, 512, lane, 1.f);
    __syncthreads();
    if (wave == 0) {
        const int cur = tpos >> 6, ncand = cur + 1;
        float val[5];
#pragma unroll
        for (int i = 0; i < 5; ++i) { const int blk = lane + 64 * i; float v = -INFINITY;
            if (blk < ncand) { const bool forced = blk == 0 || blk == cur || blk == cur - 1; float imp = 0.f;
                if (!forced) { for (int g = 0; g < 4; ++g) { if (2 * blk < 512) imp += sc[g * 2048 + 2 * blk]; if (2 * blk + 1 < 512) imp += sc[g * 2048 + 2 * blk + 1]; } }
                v = forced ? 1e4f : imp; }
            val[i] = v; }
        for (int r = 0; r < 16; ++r) {
            float bv = val[0]; int bi = lane;
#pragma unroll
            for (int i = 1; i < 5; ++i) if (val[i] > bv) { bv = val[i]; bi = lane + 64 * i; }
            for (int o = 32; o > 0; o >>= 1) { const float ov = __shfl_xor(bv, o); const int oi = __shfl_xor(bi, o); if (ov > bv || (ov == bv && oi < bi)) { bv = ov; bi = oi; } }
            if (lane == 0) sel_s[r] = bi;
#pragma unroll
            for (int i = 0; i < 5; ++i) if (lane + 64 * i == bi) val[i] = -INFINITY;
        }
    }
    __syncthreads();
#pragma unroll
    for (int i = 0; i < 3; ++i) { const int j = 512 + tid + 512 * i; int pos; bool valid; const float *kp, *vp;
        if (i < 2) nsa_key<1, true>(p, b, tpos, kvh, j - 512, sel_s, pos, valid, kp, vp); else nsa_key<2, true>(p, b, tpos, kvh, j - 1536, nullptr, pos, valid, kp, vp);
        ns_scores(q_s, kp, valid, tpos - pos, kvh, sc, j); }
    __syncthreads();
    { const int h = wave & 3, br = wave >> 2; const float gt = sigmoid_f(Pr[C_GTS + (kvh * 4 + h) * 3 + 1 + br]);
      ns_softmax(sc + h * 2048, br ? 1536 : 512, br ? 2048 : 1536, lane, gt);
      if (wave < 4) { const float g0 = sigmoid_f(Pr[C_GTS + (kvh * 4 + h) * 3]); for (int j = lane; j < 512; j += 64) sc[h * 2048 + j] *= g0; } }
    __syncthreads();
    { const int d4 = tid & 31, slice = tid >> 5;
      float4 a0 = make_float4(0.f, 0.f, 0.f, 0.f), a1 = a0, a2 = a0, a3 = a0;
#pragma unroll 16
      for (int i = 0; i < 128; ++i) { const int j = slice * 128 + i; int pos; bool valid; const float *kp, *vp;
          if (slice < 4) nsa_key<0, true>(p, b, tpos, kvh, j, nullptr, pos, valid, kp, vp);
          else if (slice < 12) nsa_key<1, true>(p, b, tpos, kvh, j - 512, sel_s, pos, valid, kp, vp);
          else nsa_key<2, true>(p, b, tpos, kvh, j - 1536, nullptr, pos, valid, kp, vp);
          const float4 v = *(const float4*)(vp + 4 * d4);
          const float w0 = sc[j], w1 = sc[2048 + j], w2 = sc[4096 + j], w3 = sc[6144 + j];
          a0.x += w0 * v.x; a0.y += w0 * v.y; a0.z += w0 * v.z; a0.w += w0 * v.w; a1.x += w1 * v.x; a1.y += w1 * v.y; a1.z += w1 * v.z; a1.w += w1 * v.w;
          a2.x += w2 * v.x; a2.y += w2 * v.y; a2.z += w2 * v.z; a2.w += w2 * v.w; a3.x += w3 * v.x; a3.y += w3 * v.y; a3.z += w3 * v.z; a3.w += w3 * v.w; }
      *(float4*)(red + (slice * 4 + 0) * 128 + 4 * d4) = a0; *(float4*)(red + (slice * 4 + 1) * 128 + 4 * d4) = a1;
      *(float4*)(red + (slice * 4 + 2) * 128 + 4 * d4) = a2; *(float4*)(red + (slice * 4 + 3) * 128 + 4 * d4) = a3; }
    __syncthreads();
    { const int h = tid >> 7, d = tid & 127; float o = 0.f;
#pragma unroll
      for (int s2 = 0; s2 < 16; ++s2) o += red[(s2 * 4 + h) * 128 + d];
      p.amix[(size_t)row * 2048 + (kvh * 4 + h) * 128 + d] = f2bf(o); }
    __syncthreads();
}
__device__ __forceinline__ void ph4_gdn(const Params& p, int u, float* smem) {
    float* qs = smem;
    float* ks = qs + 16 * 128;
    float* vs = ks + 16 * 128;
    float* ab = vs + 16 * 128;
    float* red = ab + 32;
    float* red2 = red + 512;
    const int tid = threadIdx.x, dv = tid & 127, grp = tid >> 7;
    const bool smp = u >= 32; const int v = smp ? u - 32 : u, b = v >> 3, h = v & 7;
    const int T = smp ? 1 : SEQ, row0 = smp ? NP + b : b * SEQ;
    float S[32];
#pragma unroll
    for (int i = 0; i < 32; ++i) S[i] = smp ? p.state_gdn[(((size_t)b * 8 + h) * 128 + grp * 32 + i) * 128 + dv] : 0.f;
    for (int t0 = 0; t0 < T; t0 += 16) {
        const int nst = (T - t0) < 16 ? (T - t0) : 16;
        __syncthreads();
        for (int i = tid; i < nst * 128; i += NTHR) { const int st = i >> 7, d = i & 127; const float* r = p.qkvn + (size_t)(row0 + t0 + st) * 3072 + h * 128 + d;
            qs[i] = r[0]; ks[i] = r[1024]; vs[i] = r[2048]; }
        if (tid < nst) { ab[tid * 2] = __expf(p.gg[(row0 + t0 + tid) * 8 + h]); ab[tid * 2 + 1] = p.gbeta[(row0 + t0 + tid) * 8 + h]; }
        __syncthreads();
        for (int st = 0; st < nst; ++st) {
            const float a = ab[st * 2], be = ab[st * 2 + 1];
            const float* kk = ks + st * 128 + grp * 32; const float* qq = qs + st * 128 + grp * 32;
            float part = 0.f;
#pragma unroll
            for (int i = 0; i < 32; ++i) part += kk[i] * S[i];
            red[grp * 128 + dv] = part;
            __syncthreads();
            const float kS = red[dv] + red[128 + dv] + red[256 + dv] + red[384 + dv];
            const float vn = be * (vs[st * 128 + dv] - a * kS);
            float op = 0.f;
#pragma unroll
            for (int i = 0; i < 32; ++i) { S[i] = a * S[i] + kk[i] * vn; op += qq[i] * S[i]; }
            red2[grp * 128 + dv] = op;
            __syncthreads();
            if (grp == 0) p.ograw[(size_t)(row0 + t0 + st) * 1024 + h * 128 + dv] = red2[dv] + red2[128 + dv] + red2[256 + dv] + red2[384 + dv];
        }
    }
    float* So = p.out + (smp ? O_GS : O_GP) + (((size_t)b * 8 + h) * 128) * 128;
#pragma unroll
    for (int i = 0; i < 32; ++i) So[(size_t)(grp * 32 + i) * 128 + dv] = S[i];
    __syncthreads();
}


constexpr int GA_Q = 0, GA_K = 17408, GA_T = GA_K, GA_VBT = 34816, GA_KBGT = 53248, GA_KDT = 71680, GA_QK = 90112, GA_AF = 99328, GA_WT = 99328, GA_UT = 117760, GA_SC = 136192;
__device__ __forceinline__ uint2 pack4(const f32x4& v) { uint2 w; w.x = pk2(v[0], v[1]); w.y = pk2(v[2], v[3]); return w; }
__device__ __forceinline__ void ph3_gdnA(const Params& p, int u, unsigned char* lds) {
    int tid = threadIdx.x; asm volatile("" : "+v"(tid));
    const int wave = tid >> 6, lane = tid & 63, r16 = lane & 15, quad = lane >> 4;
    const int n = u & 31, h = (u >> 5) & 7, b = u >> 8;
    const int row0 = b * SEQ + n * 64;
    float* sc_beta = (float*)(lds + GA_SC); float* sc_G = sc_beta + 64; float* sc_eG = sc_G + 64; float* sc_eGl = sc_eG + 64;
    if (tid < 64) {
        const float* Pr = p.P + (size_t)(row0 + tid) * INCP;
        const float be = sigmoid_f(Pr[C_BL + h]);
        float g = -__expf(p.a_log[h]) * softplus_f(Pr[C_AL + h] + p.dt_bias[h]);
        for (int o = 1; o < 64; o <<= 1) { const float tt = __shfl_up(g, o); if (lane >= o) g += tt; }
        const float Gl = __shfl(g, 63);
        sc_beta[tid] = be; sc_G[tid] = g; sc_eG[tid] = __expf(g); sc_eGl[tid] = __expf(Gl - g);
    }
    __syncthreads();
    {
        float cw[6][4];
#pragma unroll
        for (int e = 0; e < 6; ++e) { const int col = (e >> 1) * 1024 + h * 128 + lane + 64 * (e & 1);
#pragma unroll
            for (int i = 0; i < 4; ++i) cw[e][i] = p.conv_w[i * 3072 + col]; }
        float raw[11][6];
#pragma unroll
        for (int r = 0; r < 11; ++r) { const int tt = n * 64 + wave * 8 - 3 + r;
#pragma unroll
            for (int e = 0; e < 6; ++e) { const int col = C_QKV + (e >> 1) * 1024 + h * 128 + lane + 64 * (e & 1);
                raw[r][e] = tt >= 0 ? p.P[(size_t)(row0 + wave * 8 - 3 + r) * INCP + col] : 0.f; } }
#pragma unroll
        for (int ii = 0; ii < 8; ++ii) {
            const int c = wave * 8 + ii;
            float val[6];
#pragma unroll
            for (int e = 0; e < 6; ++e) { float acc = 0.f;
#pragma unroll
                for (int i = 0; i < 4; ++i) acc += raw[ii + i][e] * cw[e][i];
                val[e] = silu_f(acc); }
            const float rq = rsqrtf(wave_sum_sw(val[0] * val[0] + val[1] * val[1]) + 1e-6f) * 0.08838834764831845f;
            const float rk = rsqrtf(wave_sum_sw(val[2] * val[2] + val[3] * val[3]) + 1e-6f);
            const float be = sc_beta[c], eG = sc_eG[c], eGl = sc_eGl[c];
#pragma unroll
            for (int e2 = 0; e2 < 2; ++e2) { const int ch = lane + 64 * e2; const float kv = val[2 + e2] * rk;
                *(bf16_t*)(lds + GA_Q + c * 272 + ch * 2) = f2bf(val[e2] * rq);
                *(bf16_t*)(lds + GA_K + c * 272 + ch * 2) = f2bf(kv);
                *(bf16_t*)(lds + GA_KBGT + ch * 144 + c * 2) = f2bf(kv * be * eG);
                *(bf16_t*)(lds + GA_KDT + ch * 144 + c * 2) = f2bf(kv * eGl);
                *(bf16_t*)(lds + GA_VBT + ch * 144 + c * 2) = f2bf(val[4 + e2] * be); }
        }
    }
    __syncthreads();
    {
        const int sel = wave >> 2, rb = wave & 3;
        const unsigned char* Ab = lds + (sel ? GA_Q : GA_K) + (16 * rb + r16) * 272 + quad * 16;
        f32x4 acc[4];
#pragma unroll
        for (int cb = 0; cb < 4; ++cb) acc[cb] = (f32x4){0.f, 0.f, 0.f, 0.f};
#pragma unroll
        for (int ks = 0; ks < 4; ++ks) { const bf16x8 a = *(const bf16x8*)(Ab + ks * 64);
#pragma unroll
            for (int cb = 0; cb < 4; ++cb) { const bf16x8 bb = *(const bf16x8*)(lds + GA_K + (16 * cb + r16) * 272 + quad * 16 + ks * 64); acc[cb] = MFMA16(a, bb, acc[cb]); } }
        float* AF = (float*)(lds + GA_AF);
#pragma unroll
        for (int cb = 0; cb < 4; ++cb)
#pragma unroll
            for (int rg = 0; rg < 4; ++rg) { const int c = 16 * rb + 4 * quad + rg, m = 16 * cb + r16;
                const float dec = m <= c ? __expf(sc_G[c] - sc_G[m]) : 0.f;
                if (sel == 0) AF[c * 64 + m] = m < c ? sc_beta[c] * acc[cb][rg] * dec : 0.f;
                else *(bf16_t*)(lds + GA_QK + c * 144 + m * 2) = f2bf(acc[cb][rg] * dec); }
    }
    __syncthreads();
    if (wave == 0) {
        int zoff = 0; asm volatile("" : "+v"(zoff));
        const float* AF = (const float*)(lds + GA_AF) + zoff;
        float tc[64];
#pragma unroll
        for (int c = 0; c < 64; ++c) {
            f32x4 ar[16];
#pragma unroll
            for (int q = 0; q < (c + 3) / 4; ++q) ar[q] = *(const f32x4*)(AF + c * 64 + 4 * q);
            float acc = (c == lane) ? 1.f : 0.f;
#pragma unroll
            for (int m = 0; m < c; ++m) acc -= ar[m >> 2][m & 3] * tc[m];
            tc[c] = acc; }
#pragma unroll
        for (int c = 0; c < 64; ++c) *(bf16_t*)(lds + GA_T + c * 144 + lane * 2) = f2bf(tc[c]);
    }
    __syncthreads();
    {
        const int isW = wave >> 2;
        const unsigned char* Bs = lds + (isW ? GA_KBGT : GA_VBT); unsigned char* Ds = lds + (isW ? GA_WT : GA_UT);
#pragma unroll
        for (int cbi = 0; cbi < 2; ++cbi) { const int cb = (wave & 3) * 2 + cbi;
            bf16x8 bfr[2];
#pragma unroll
            for (int ks = 0; ks < 2; ++ks) bfr[ks] = *(const bf16x8*)(Bs + (16 * cb + r16) * 144 + ks * 64 + quad * 16);
#pragma unroll
            for (int rb = 0; rb < 4; ++rb) { f32x4 acc = (f32x4){0.f, 0.f, 0.f, 0.f};
#pragma unroll
                for (int ks = 0; ks < 2; ++ks) { const bf16x8 a = *(const bf16x8*)(lds + GA_T + (16 * rb + r16) * 144 + ks * 64 + quad * 16); acc = MFMA16(a, bfr[ks], acc); }
                *(uint2*)(Ds + (16 * cb + r16) * 144 + (16 * rb + 4 * quad) * 2) = pack4(acc); } }
    }
    __syncthreads();
    {
        bf16_t* gN = p.gN + (size_t)u * 16384; bf16_t* gBT = p.gBT + (size_t)u * 16384; bf16_t* gQp = p.gQp + (size_t)u * 8192; bf16_t* gOpT = p.gOpT + (size_t)u * 8192;
        {
            const bool isB = wave >= 4;
            const unsigned char* As = lds + (isB ? GA_KDT : GA_WT); const unsigned char* Bs = lds + (isB ? GA_UT : GA_KDT);
            bf16_t* dst = isB ? gBT : gN;
#pragma unroll
            for (int cbi = 0; cbi < 2; ++cbi) { const int cb = (wave & 3) * 2 + cbi;
                bf16x8 bfr[2];
#pragma unroll
                for (int ks = 0; ks < 2; ++ks) bfr[ks] = *(const bf16x8*)(Bs + (16 * cb + r16) * 144 + ks * 64 + quad * 16);
#pragma unroll
                for (int rb = 0; rb < 8; ++rb) { f32x4 acc = (f32x4){0.f, 0.f, 0.f, 0.f};
#pragma unroll
                    for (int ks = 0; ks < 2; ++ks) { const bf16x8 a = *(const bf16x8*)(As + (16 * rb + r16) * 144 + ks * 64 + quad * 16); acc = MFMA16(a, bfr[ks], acc); }
                    *(uint2*)(dst + (size_t)(16 * cb + r16) * 128 + 16 * rb + 4 * quad) = pack4(acc); } }
        }
        {
            bf16x8 afr[2];
#pragma unroll
            for (int ks = 0; ks < 2; ++ks) afr[ks] = *(const bf16x8*)(lds + GA_WT + (16 * wave + r16) * 144 + ks * 64 + quad * 16);
#pragma unroll
            for (int cb = 0; cb < 4; ++cb) { f32x4 acc = (f32x4){0.f, 0.f, 0.f, 0.f};
#pragma unroll
                for (int ks = 0; ks < 2; ++ks) { const bf16x8 bb = *(const bf16x8*)(lds + GA_QK + (16 * cb + r16) * 144 + ks * 64 + quad * 16); acc = MFMA16(afr[ks], bb, acc); }
                const int c = 16 * cb + r16, dk0 = 16 * wave + 4 * quad; const float eG = sc_eG[c];
                const uint2 qv = *(const uint2*)(lds + GA_Q + c * 272 + dk0 * 2);
                f32x4 o; o[0] = __uint_as_float(qv.x << 16) * eG - acc[0]; o[1] = __uint_as_float(qv.x & 0xffff0000u) * eG - acc[1]; o[2] = __uint_as_float(qv.y << 16) * eG - acc[2]; o[3] = __uint_as_float(qv.y & 0xffff0000u) * eG - acc[3];
                *(uint2*)(gQp + (size_t)c * 128 + dk0) = pack4(o); }
        }
        {
            bf16x8 bfr[2];
#pragma unroll
            for (int ks = 0; ks < 2; ++ks) bfr[ks] = *(const bf16x8*)(lds + GA_UT + (16 * wave + r16) * 144 + ks * 64 + quad * 16);
#pragma unroll
            for (int rb = 0; rb < 4; ++rb) { f32x4 acc = (f32x4){0.f, 0.f, 0.f, 0.f};
#pragma unroll
                for (int ks = 0; ks < 2; ++ks) { const bf16x8 a = *(const bf16x8*)(lds + GA_QK + (16 * rb + r16) * 144 + ks * 64 + quad * 16); acc = MFMA16(a, bfr[ks], acc); }
                *(uint2*)(gOpT + (size_t)(16 * wave + r16) * 64 + 16 * rb + 4 * quad) = pack4(acc); }
        }
        if (tid == 0) p.ggl[u] = sc_eG[63];
    }
    __syncthreads();
}
constexpr int GB_N0 = 0, GB_N1 = 34816;
struct GBSet { u32x4 nreg[4]; u32x2 breg[8]; };
__device__ __forceinline__ void gb_load(const Params& p, size_t ci, int tid, int dv, int quad, GBSet& s) {
    const bf16_t* gN = p.gN + ci * 16384; const bf16_t* gB = p.gBT + ci * 16384;
#pragma unroll
    for (int i = 0; i < 4; ++i) s.nreg[i] = *(const u32x4*)(gN + (size_t)(tid + 512 * i) * 8);
    if (tid < 256) {
#pragma unroll
        for (int rb = 0; rb < 8; ++rb) s.breg[rb] = *(const u32x2*)(gB + (size_t)dv * 128 + 16 * rb + 4 * quad); }
}
__device__ __forceinline__ void gb_step(const Params& p, int u, int n, float gl, unsigned char* lds, int tid, int r16, int quad, int dv, GBSet& s, f32x4 (&S)[8]) {
    const size_t ci = (size_t)u * 32 + n;
    const bool owner = tid < 256;
    bf16_t* gS = p.gST + ci * 16384 + (size_t)dv * 128 + 4 * quad;
    if (owner) {
#pragma unroll
        for (int rb = 0; rb < 8; ++rb) *(uint2*)(gS + 16 * rb) = pack4(S[rb]); }
    bf16x8 bfr[4];
#pragma unroll
    for (int ks = 0; ks < 4; ++ks) bfr[ks] = pack8(S[2 * ks][0], S[2 * ks][1], S[2 * ks][2], S[2 * ks][3], S[2 * ks + 1][0], S[2 * ks + 1][1], S[2 * ks + 1][2], S[2 * ks + 1][3]);
    unsigned char* buf = lds + ((n & 1) ? GB_N1 : GB_N0);
#pragma unroll
    for (int i = 0; i < 4; ++i) { const int idx = tid + 512 * i; *(u32x4*)(buf + (idx >> 4) * 272 + (idx & 15) * 16) = s.nreg[i]; }
    f32x4 Bv[8];
#pragma unroll
    for (int rb = 0; rb < 8; ++rb) { Bv[rb][0] = __uint_as_float(s.breg[rb].x << 16); Bv[rb][1] = __uint_as_float(s.breg[rb].x & 0xffff0000u); Bv[rb][2] = __uint_as_float(s.breg[rb].y << 16); Bv[rb][3] = __uint_as_float(s.breg[rb].y & 0xffff0000u); }
    __syncthreads();
    gb_load(p, (size_t)u * 32 + (n + 2 < 32 ? n + 2 : 31), tid, dv, quad, s);
    if (owner)
#pragma unroll
    for (int rb = 0; rb < 8; ++rb) { f32x4 acc = (f32x4){0.f, 0.f, 0.f, 0.f};
        u32x4 av[4];
#pragma unroll
        for (int ks = 0; ks < 4; ++ks) { const unsigned char* ap = buf + (16 * rb + r16) * 272 + (32 * ks + 4 * quad) * 2;
            const uint2 lo = *(const uint2*)ap, hi = *(const uint2*)(ap + 32); av[ks][0] = lo.x; av[ks][1] = lo.y; av[ks][2] = hi.x; av[ks][3] = hi.y; }
#pragma unroll
        for (int ks = 0; ks < 4; ++ks) acc = MFMA16(__builtin_bit_cast(bf16x8, av[ks]), bfr[ks], acc);
#pragma unroll
        for (int rg = 0; rg < 4; ++rg) S[rb][rg] = gl * S[rb][rg] + Bv[rb][rg] - acc[rg]; }
}
__device__ __forceinline__ void ph4_gdnB(const Params& p, int uu, unsigned char* lds) {
    const int u = uu >> 1, half = uu & 1;
    const int tid = threadIdx.x, wave = tid >> 6, lane = tid & 63, r16 = lane & 15, quad = lane >> 4, dv = 64 * half + 16 * (wave & 3) + r16;
    f32x4 S[8];
#pragma unroll
    for (int rb = 0; rb < 8; ++rb) S[rb] = (f32x4){0.f, 0.f, 0.f, 0.f};
    GBSet A, B;
    gb_load(p, (size_t)u * 32, tid, dv, quad, A);
    gb_load(p, (size_t)u * 32 + 1, tid, dv, quad, B);
    const float glv = p.ggl[(size_t)u * 32 + (lane & 31)];
#pragma unroll 1
    for (int n = 0; n < 32; n += 2) {
        gb_step(p, u, n, __shfl(glv, n), lds, tid, r16, quad, dv, A, S);
        gb_step(p, u, n + 1, __shfl(glv, n + 1), lds, tid, r16, quad, dv, B, S);
    }
    float* So = p.out + O_GP + (size_t)u * 16384;
    if (tid < 256) {
#pragma unroll
        for (int rb = 0; rb < 8; ++rb)
#pragma unroll
            for (int rg = 0; rg < 4; ++rg) So[(size_t)(16 * rb + 4 * quad + rg) * 128 + dv] = S[rb][rg]; }
    __syncthreads();
}
__device__ __forceinline__ void ph5_gdnC(const Params& p, int u, unsigned char* lds) {
    const int tid = threadIdx.x, wave = tid >> 6, lane = tid & 63, r16 = lane & 15, quad = lane >> 4, dv = 16 * wave + r16;
    const int n = u & 31, h = (u >> 5) & 7, b = u >> 8, row0 = b * SEQ + n * 64;
    const bf16_t* Qp = p.gQp + (size_t)u * 8192; const bf16_t* ST = p.gST + (size_t)u * 16384; const bf16_t* OpT = p.gOpT + (size_t)u * 8192;
    bf16x8 bfr[4];
#pragma unroll
    for (int ks = 0; ks < 4; ++ks) bfr[ks] = *(const bf16x8*)(ST + (size_t)dv * 128 + 32 * ks + 8 * quad);
    float zv[4][4];
#pragma unroll
    for (int rb = 0; rb < 4; ++rb)
#pragma unroll
        for (int rg = 0; rg < 4; ++rg) zv[rb][rg] = p.P[(size_t)(row0 + 16 * rb + 4 * quad + rg) * INCP + C_Z + h * 128 + dv];
    f32x4 o[4];
#pragma unroll
    for (int rb = 0; rb < 4; ++rb) { f32x4 acc = (f32x4){0.f, 0.f, 0.f, 0.f};
#pragma unroll
        for (int ks = 0; ks < 4; ++ks) { const bf16x8 a = *(const bf16x8*)(Qp + (size_t)(16 * rb + r16) * 128 + 32 * ks + 8 * quad); acc = MFMA16(a, bfr[ks], acc); }
        const uint2 op = *(const uint2*)(OpT + (size_t)dv * 64 + 16 * rb + 4 * quad);
        acc[0] += __uint_as_float(op.x << 16); acc[1] += __uint_as_float(op.x & 0xffff0000u); acc[2] += __uint_as_float(op.y << 16); acc[3] += __uint_as_float(op.y & 0xffff0000u);
        o[rb] = acc; }
    float* part = (float*)lds;
#pragma unroll
    for (int rb = 0; rb < 4; ++rb)
#pragma unroll
        for (int rg = 0; rg < 4; ++rg) { float v = o[rb][rg] * o[rb][rg]; v += __shfl_xor(v, 1); v += __shfl_xor(v, 2); v += __shfl_xor(v, 4); v += __shfl_xor(v, 8);
            if (r16 == 0) part[wave * 64 + 16 * rb + 4 * quad + rg] = v; }
    __syncthreads();
    const float gw = p.gdn_norm[dv];
#pragma unroll
    for (int rb = 0; rb < 4; ++rb)
#pragma unroll
        for (int rg = 0; rg < 4; ++rg) { const int c = 16 * rb + 4 * quad + rg;
            const float tot = part[c] + part[64 + c] + part[128 + c] + part[192 + c] + part[256 + c] + part[320 + c] + part[384 + c] + part[448 + c];
            const float rstd = rsqrtf(tot * (1.f / 128.f) + 1e-6f);
            p.amix[(size_t)(row0 + c) * 2048 + 1024 + h * 128 + dv] = f2bf(o[rb][rg] * rstd * gw * silu_f(zv[rb][rg])); }
    __syncthreads();
}

__device__ __forceinline__ void ph5_gdnout(const Params& p, int row) {
    const int wave = threadIdx.x >> 6, lane = threadIdx.x & 63, h = wave;
    const float* o = p.ograw + (size_t)row * 1024 + h * 128; const float* z = p.P + (size_t)row * INCP + C_Z + h * 128;
    const float a = o[2 * lane], b = o[2 * lane + 1];
    const float ss = wave_sum(a * a + b * b);
    const float r = rsqrtf(ss * (1.f / 128.f) + 1e-6f);
    const float y0 = a * r * p.gdn_norm[2 * lane] * silu_f(z[2 * lane]), y1 = b * r * p.gdn_norm[2 * lane + 1] * silu_f(z[2 * lane + 1]);
    *(unsigned*)(p.amix + (size_t)row * 2048 + 1024 + h * 128 + 2 * lane) = (unsigned)f2bf(y0) | ((unsigned)f2bf(y1) << 16);
}

__device__ __forceinline__ void ph9_peer(const Params& p, int row, float* smem) {
    float* qs = smem;
    float* hs = qs + 2048;
    float* ssc = hs + 2048;
    float* s_half = ssc + 2048;
    int* i_half = (int*)(s_half + 256);
    float* wgt = (float*)(i_half + 256);
    int* eid = (int*)(wgt + 128);
    float* red = (float*)(eid + 128);
    int tid = threadIdx.x; asm volatile("" : "+v"(tid));
    const int wave = tid >> 6, lane = tid & 63;
    for (int i = tid; i < 2048; i += NTHR) { qs[i] = p.qp[(size_t)row * 2048 + i]; hs[i] = p.h2f[(size_t)row * 2048 + i]; }
    __syncthreads();
    for (int i = 0; i < 4; ++i) { const int idx = tid + NTHR * i, hp = idx >> 7, k = idx & 127, half = hp & 1;
        const float* kr = p.peer_keys + ((size_t)half * 128 + k) * 128; const float* qq = qs + (hp >> 1) * 256 + half * 128;
        float acc = 0.f; for (int d = 0; d < 128; d += 4) { const float4 kv = *(const float4*)(kr + d); acc += qq[d] * kv.x + qq[d + 1] * kv.y + qq[d + 2] * kv.z + qq[d + 3] * kv.w; }
        ssc[idx] = acc; }
    __syncthreads();
    for (int li = 0; li < 2; ++li) { const int hp = wave * 2 + li;
        float v0 = ssc[hp * 128 + lane], v1 = ssc[hp * 128 + 64 + lane];
        for (int r = 0; r < 16; ++r) {
            float bv = v0; int bi = lane; if (v1 > bv) { bv = v1; bi = lane + 64; }
            for (int o = 32; o > 0; o >>= 1) { const float ov = __shfl_xor(bv, o); const int oi = __shfl_xor(bi, o); if (ov > bv || (ov == bv && oi < bi)) { bv = ov; bi = oi; } }
            if (lane == 0) { s_half[hp * 16 + r] = bv; i_half[hp * 16 + r] = bi; }
            if (bi == lane) v0 = -INFINITY; if (bi == lane + 64) v1 = -INFINITY;
        } }
    __syncthreads();
    { const int h = wave; float cv[4];
#pragma unroll
      for (int c = 0; c < 4; ++c) { const int f = lane + 64 * c; cv[c] = s_half[(h * 2) * 16 + (f >> 4)] + s_half[(h * 2 + 1) * 16 + (f & 15)]; }
      float bs_mine = 0.f; int e_mine = 0;
      for (int r = 0; r < 16; ++r) {
          float bv = cv[0]; int bi = lane;
#pragma unroll
          for (int c = 1; c < 4; ++c) if (cv[c] > bv) { bv = cv[c]; bi = lane + 64 * c; }
          for (int o = 32; o > 0; o >>= 1) { const float ov = __shfl_xor(bv, o); const int oi = __shfl_xor(bi, o); if (ov > bv || (ov == bv && oi < bi)) { bv = ov; bi = oi; } }
          if (lane == r) { bs_mine = bv; e_mine = i_half[(h * 2) * 16 + (bi >> 4)] * 128 + i_half[(h * 2 + 1) * 16 + (bi & 15)]; }
#pragma unroll
          for (int c = 0; c < 4; ++c) if (lane + 64 * c == bi) cv[c] = -INFINITY;
      }
      float mx = lane < 16 ? bs_mine : -INFINITY; mx = wave_max(mx);
      const float ex = lane < 16 ? __expf(bs_mine - mx) : 0.f; const float den = wave_sum(ex);
      const float gate = ex / den;
      for (int r = 0; r < 16; ++r) { const int e = __shfl(e_mine, r); const float* ur = p.peer_u + (size_t)e * 2048;
          float acc = 0.f;
#pragma unroll
          for (int i = 0; i < 8; ++i) { const int c = i * 256 + lane * 4; const float4 uv = *(const float4*)(ur + c); acc += hs[c] * uv.x + hs[c + 1] * uv.y + hs[c + 2] * uv.z + hs[c + 3] * uv.w; }
          acc = wave_sum(acc);
          const float g = __shfl(gate, r);
          if (lane == 0) { wgt[h * 16 + r] = g * gelu_tanh(acc); eid[h * 16 + r] = e; } }
    }
    __syncthreads();
    float4 o = make_float4(0.f, 0.f, 0.f, 0.f);
    for (int j = 0; j < 128; ++j) { const float w = wgt[j]; const float4 vv = *(const float4*)(p.peer_v + (size_t)eid[j] * 2048 + tid * 4); o.x += w * vv.x; o.y += w * vv.y; o.z += w * vv.z; o.w += w * vv.w; }
    const int mrow = row < NP ? row / SEQ : 4 + (row - NP);
    const float4 g2 = *(const float4*)(p.mod + (size_t)mrow * 12288 + 10240 + tid * 4);
    const float4 xv = *(const float4*)(p.x1 + (size_t)row * 2048 + tid * 4);
    float4 x2; x2.x = xv.x + g2.x * o.x; x2.y = xv.y + g2.y * o.y; x2.z = xv.z + g2.z * o.z; x2.w = xv.w + g2.w * o.w;
    float ss = wave_sum(x2.x * x2.x + x2.y * x2.y + x2.z * x2.z + x2.w * x2.w);
    if (lane == 0) red[wave] = ss;
    __syncthreads();
    ss = red[0] + red[1] + red[2] + red[3] + red[4] + red[5] + red[6] + red[7];
    const float rstd = rsqrtf(ss * (1.f / 2048.f) + 1e-6f);
    const float4 fw = *(const float4*)(p.final_norm + tid * 4);
    float4 y; y.x = x2.x * rstd * fw.x; y.y = x2.y * rstd * fw.y; y.z = x2.z * rstd * fw.z; y.w = x2.w * rstd * fw.w;
    float* dst = row < NP ? p.out + O_YP + (size_t)row * 2048 : p.out + O_YS + (size_t)(row - NP) * 2048;
    *(float4*)(dst + tid * 4) = y;
    __syncthreads();
}


constexpr int PK_SH = 0, PK_IH = 16384, PK_EID = 32768, PK_GATE = 40960, PK_KH = 49152, PK_KL = 83968;
__device__ __forceinline__ void split8(const float4& a, const float4& b, bf16x8& hi, bf16x8& lo) {
    hi = pack8(a.x, a.y, a.z, a.w, b.x, b.y, b.z, b.w);
    const u32x4 hb = __builtin_bit_cast(u32x4, hi);
    lo = pack8(a.x - __uint_as_float(hb[0] << 16), a.y - __uint_as_float(hb[0] & 0xffff0000u), a.z - __uint_as_float(hb[1] << 16), a.w - __uint_as_float(hb[1] & 0xffff0000u),
               b.x - __uint_as_float(hb[2] << 16), b.y - __uint_as_float(hb[2] & 0xffff0000u), b.z - __uint_as_float(hb[3] << 16), b.w - __uint_as_float(hb[3] & 0xffff0000u));
}
__device__ __forceinline__ float dot8(const u32x4& a, const u32x4& b, float acc) {
#pragma unroll
    for (int k = 0; k < 4; ++k) { const unsigned ak = a[k], bk = b[k];
        acc = __builtin_amdgcn_fdot2_f32_bf16(__builtin_bit_cast(bf2_t, ak), __builtin_bit_cast(bf2_t, bk), acc, false); }
    return acc;
}

#ifndef PEER_DBG
#define PEER_DBG 0
#endif
__device__ __forceinline__ void peer_topk_naive(const Params& p, int row, int tk, unsigned char* lds) {
    float* qs = (float*)(lds + 65536);
    float* ssc = qs + 2048;
    float* s_half = ssc + 2048;
    int* i_half = (int*)(s_half + 256);
    int* eidL = (int*)(lds + PK_EID); float* gateL = (float*)(lds + PK_GATE);
    const int tid = threadIdx.x, wave = tid >> 6, lane = tid & 63;
    for (int i = tid; i < 2048; i += NTHR) qs[i] = p.qp[(size_t)row * 2048 + i];
    __syncthreads();
    for (int i = 0; i < 4; ++i) { const int idx = tid + NTHR * i, hp = idx >> 7, k = idx & 127, half = hp & 1;
        const float* kr = p.peer_keys + ((size_t)half * 128 + k) * 128; const float* qq = qs + (hp >> 1) * 256 + half * 128;
        float acc = 0.f; for (int d = 0; d < 128; d += 4) { const float4 kv = *(const float4*)(kr + d); acc += qq[d] * kv.x + qq[d + 1] * kv.y + qq[d + 2] * kv.z + qq[d + 3] * kv.w; }
        ssc[idx] = acc; }
    __syncthreads();
    for (int li = 0; li < 2; ++li) { const int hp = wave * 2 + li;
        float v0 = ssc[hp * 128 + lane], v1 = ssc[hp * 128 + 64 + lane];
        for (int r = 0; r < 16; ++r) {
            float bv = v0; int bi = lane; if (v1 > bv) { bv = v1; bi = lane + 64; }
            for (int o = 32; o > 0; o >>= 1) { const float ov = __shfl_xor(bv, o); const int oi = __shfl_xor(bi, o); if (ov > bv || (ov == bv && oi < bi)) { bv = ov; bi = oi; } }
            if (lane == 0) { s_half[hp * 16 + r] = bv; i_half[hp * 16 + r] = bi; }
            if (bi == lane) v0 = -INFINITY; if (bi == lane + 64) v1 = -INFINITY;
        } }
    __syncthreads();
    { const int h = wave; float cv[4];
#pragma unroll
      for (int c = 0; c < 4; ++c) { const int f = lane + 64 * c; cv[c] = s_half[(h * 2) * 16 + (f >> 4)] + s_half[(h * 2 + 1) * 16 + (f & 15)]; }
      float bs_mine = 0.f; int e_mine = 0;
      for (int r = 0; r < 16; ++r) {
          float bv = cv[0]; int bi = lane;
#pragma unroll
          for (int c = 1; c < 4; ++c) if (cv[c] > bv) { bv = cv[c]; bi = lane + 64 * c; }
          for (int o = 32; o > 0; o >>= 1) { const float ov = __shfl_xor(bv, o); const int oi = __shfl_xor(bi, o); if (ov > bv || (ov == bv && oi < bi)) { bv = ov; bi = oi; } }
          if (lane == r) { bs_mine = bv; e_mine = i_half[(h * 2) * 16 + (bi >> 4)] * 128 + i_half[(h * 2 + 1) * 16 + (bi & 15)]; }
#pragma unroll
          for (int c = 0; c < 4; ++c) if (lane + 64 * c == bi) cv[c] = -INFINITY;
      }
      float mx = lane < 16 ? bs_mine : -INFINITY; mx = wave_max(mx);
      const float ex = lane < 16 ? __expf(bs_mine - mx) : 0.f; const float den = wave_sum(ex);
      if (lane < 16) { eidL[tk * 128 + h * 16 + lane] = e_mine; gateL[tk * 128 + h * 16 + lane] = ex / den; }
    }
    __syncthreads();
}
template <bool LATE>
__device__ __forceinline__ void ph9_peer_fast(const Params& p, int u, unsigned char* lds) {
    int tid = threadIdx.x; asm volatile("" : "+v"(tid));
    const int wave = tid >> 6, lane = tid & 63, r16 = lane & 15, quad = lane >> 4;
    float* sh = (float*)(lds + PK_SH); int* ih = (int*)(lds + PK_IH); int* eidL = (int*)(lds + PK_EID); float* gateL = (float*)(lds + PK_GATE);
    const int tok0 = u * 16;
#if PEER_DBG == 1
    for (int tk = 0; tk < 16; ++tk) peer_topk_naive(p, tok0 + tk < NTOK ? tok0 + tk : NTOK - 1, tk, lds);
#else
    {
        const int row = tok0 + r16 < NTOK ? tok0 + r16 : NTOK - 1, head = wave;
        const int lbase = (wave * 16 + r16) * 32;
#pragma unroll 1
        for (int half = 0; half < 2; ++half) {
            bf16x8 qh[4], ql[4];
            const float* qrow = p.qp + (size_t)row * 2048 + head * 256 + half * 128 + 8 * quad;
#pragma unroll
            for (int ks = 0; ks < 4; ++ks) split8(*(const float4*)(qrow + 32 * ks), *(const float4*)(qrow + 32 * ks + 4), qh[ks], ql[ks]);
            __syncthreads();
#pragma unroll
            for (int i = 0; i < 4; ++i) { const int id = tid + 512 * i, kr = id >> 4, part = id & 15; const size_t go = (size_t)(half * 128 + kr) * 128 + part * 8;
                *(u32x4*)(lds + PK_KH + kr * 272 + part * 16) = *(const u32x4*)(p.kh + go); *(u32x4*)(lds + PK_KL + kr * 272 + part * 16) = *(const u32x4*)(p.kl + go); }
            __syncthreads();
            f32x4 acc[8];
#pragma unroll
            for (int kb = 0; kb < 8; ++kb) { acc[kb] = (f32x4){0.f, 0.f, 0.f, 0.f};
                const int ko = (16 * kb + r16) * 272 + quad * 16;
                bf16x8 ahv[4], alv[4];
#pragma unroll
                for (int ks = 0; ks < 4; ++ks) { ahv[ks] = *(const bf16x8*)(lds + PK_KH + ko + 64 * ks); alv[ks] = *(const bf16x8*)(lds + PK_KL + ko + 64 * ks); }
#pragma unroll
                for (int ks = 0; ks < 4; ++ks) { acc[kb] = MFMA16(ahv[ks], qh[ks], acc[kb]); acc[kb] = MFMA16(ahv[ks], ql[ks], acc[kb]); acc[kb] = MFMA16(alv[ks], qh[ks], acc[kb]); } }
#pragma unroll 1
            for (int r = 0; r < 16; ++r) {
                float bv = acc[0][0]; int bi = 4 * quad;
#pragma unroll
                for (int kb = 0; kb < 8; ++kb)
#pragma unroll
                    for (int rg = 0; rg < 4; ++rg) if (acc[kb][rg] > bv) { bv = acc[kb][rg]; bi = 16 * kb + 4 * quad + rg; }
#pragma unroll
                for (int o = 16; o <= 32; o <<= 1) { const float ov = __shfl_xor(bv, o); const int oi = __shfl_xor(bi, o); if (ov > bv || (ov == bv && oi < bi)) { bv = ov; bi = oi; } }
                if (quad == 0) { sh[lbase + half * 16 + r] = bv; ih[lbase + half * 16 + r] = bi; }
#pragma unroll
                for (int kb = 0; kb < 8; ++kb)
#pragma unroll
                    for (int rg = 0; rg < 4; ++rg) if (bi == 16 * kb + 4 * quad + rg) acc[kb][rg] = -INFINITY;
            }
        }
        __syncthreads();
        float s0v[4], cur[4]; int ptr[4];
#pragma unroll
        for (int ii = 0; ii < 4; ++ii) { s0v[ii] = sh[lbase + 4 * quad + ii]; ptr[ii] = 0; cur[ii] = s0v[ii] + sh[lbase + 16]; }
        float bs[16]; int be[16];
#pragma unroll
        for (int r = 0; r < 16; ++r) {
            float bv = cur[0]; int bi = 4 * quad, bj = ptr[0];
#pragma unroll
            for (int ii = 1; ii < 4; ++ii) if (cur[ii] > bv) { bv = cur[ii]; bi = 4 * quad + ii; bj = ptr[ii]; }
#pragma unroll
            for (int o = 16; o <= 32; o <<= 1) { const float ov = __shfl_xor(bv, o); const int oi = __shfl_xor(bi, o), oj = __shfl_xor(bj, o); if (ov > bv || (ov == bv && oi < bi)) { bv = ov; bi = oi; bj = oj; } }
            bs[r] = bv; be[r] = ih[lbase + bi] * 128 + ih[lbase + 16 + bj];
#pragma unroll
            for (int ii = 0; ii < 4; ++ii) if (bi == 4 * quad + ii) { ptr[ii] += 1; cur[ii] = ptr[ii] < 16 ? s0v[ii] + sh[lbase + 16 + (ptr[ii] & 15)] : -INFINITY; }
        }
        float den = 0.f; const float bmax = bs[0];
#pragma unroll
        for (int r = 0; r < 16; ++r) { bs[r] = __expf(bs[r] - bmax); den += bs[r]; }
        const float dinv = 1.f / den;
        if (quad == 0) {
#pragma unroll
            for (int r = 0; r < 16; ++r) { eidL[r16 * 128 + head * 16 + r] = be[r]; gateL[r16 * 128 + head * 16 + r] = bs[r] * dinv; } }
        if (quad == 0 && tok0 + r16 < NTOK) {
#pragma unroll
            for (int r = 0; r < 16; ++r) { int* pe = p.pk_eid + (size_t)(tok0 + r16) * 128 + head * 16 + r; float* pg = p.pk_gate + (size_t)(tok0 + r16) * 128 + head * 16 + r;
                if (LATE) { __hip_atomic_store(pe, be[r], __ATOMIC_RELAXED, __HIP_MEMORY_SCOPE_AGENT); __hip_atomic_store(pg, bs[r] * dinv, __ATOMIC_RELAXED, __HIP_MEMORY_SCOPE_AGENT); }
                else { *pe = be[r]; *pg = bs[r] * dinv; } } }
    }
#endif
    __syncthreads();
}

__device__ __forceinline__ float dot16_fp8(const u32x4& q, const float* h, float acc) {
    f32x2 a2 = (f32x2){acc, 0.f};
#pragma unroll
    for (int k = 0; k < 4; ++k) { const int w = (int)q[k]; const f32x2 lo = __builtin_amdgcn_cvt_pk_f32_fp8(w, false), hi = __builtin_amdgcn_cvt_pk_f32_fp8(w, true);
        a2 = __builtin_elementwise_fma(lo, (f32x2){h[4 * k], h[4 * k + 1]}, a2); a2 = __builtin_elementwise_fma(hi, (f32x2){h[4 * k + 2], h[4 * k + 3]}, a2); }
    return a2[0] + a2[1];
}
__device__ __forceinline__ void axpy16_fp8(const u32x4& q, float w, float* o) {
    const f32x2 w2 = (f32x2){w, w};
#pragma unroll
    for (int k = 0; k < 4; ++k) { const int x = (int)q[k]; const f32x2 lo = __builtin_amdgcn_cvt_pk_f32_fp8(x, false), hi = __builtin_amdgcn_cvt_pk_f32_fp8(x, true);
        const f32x2 a = __builtin_elementwise_fma(w2, lo, (f32x2){o[4 * k], o[4 * k + 1]}), b = __builtin_elementwise_fma(w2, hi, (f32x2){o[4 * k + 2], o[4 * k + 3]});
        o[4 * k] = a[0]; o[4 * k + 1] = a[1]; o[4 * k + 2] = b[0]; o[4 * k + 3] = b[1]; }
}
__device__ __forceinline__ void ph10_token(const Params& p, int row, int lane) {
    asm volatile("" : "+v"(lane));
    float hv[32];
    { const float* hr = p.h2f + (size_t)row * 2048 + lane * 16;
#pragma unroll
      for (int c = 0; c < 2; ++c)
#pragma unroll
          for (int k = 0; k < 4; ++k) { const float4 t = *(const float4*)(hr + c * 1024 + 4 * k); hv[c * 16 + 4 * k] = t.x; hv[c * 16 + 4 * k + 1] = t.y; hv[c * 16 + 4 * k + 2] = t.z; hv[c * 16 + 4 * k + 3] = t.w; } }
    const int e_lo = p.pk_eid[(size_t)row * 128 + lane], e_hi = p.pk_eid[(size_t)row * 128 + 64 + lane];
    const float g_lo = p.pk_gate[(size_t)row * 128 + lane], g_hi = p.pk_gate[(size_t)row * 128 + 64 + lane];
    float w_lo = 0.f, w_hi = 0.f;
#pragma unroll 1
    for (int j0 = 0; j0 < 128; j0 += 8) {
        u32x4 uv[8][2]; float su[8];
#pragma unroll
        for (int jj = 0; jj < 8; ++jj) { const int j = j0 + jj; const int e = __shfl(j < 64 ? e_lo : e_hi, j & 63); const unsigned char* ur = p.u8 + (size_t)e * 2048 + lane * 16;
            uv[jj][0] = *(const u32x4*)ur; uv[jj][1] = *(const u32x4*)(ur + 1024); su[jj] = p.us[e]; }
#pragma unroll
        for (int jj = 0; jj < 8; ++jj) { const int j = j0 + jj; float d = dot16_fp8(uv[jj][0], hv, 0.f); d = dot16_fp8(uv[jj][1], hv + 16, d);
            d = wave_sum_sw(d) * su[jj];
            const float w = __shfl(j < 64 ? g_lo : g_hi, j & 63) * gelu_tanh(d);
            if (lane == (j & 63)) { if (j < 64) w_lo = w; else w_hi = w; }
            __builtin_amdgcn_sched_barrier(0); }
    }
    float out[32];
#pragma unroll
    for (int k = 0; k < 32; ++k) out[k] = 0.f;
#pragma unroll 1
    for (int j0 = 0; j0 < 128; j0 += 4) {
        u32x4 vv[4][2]; float sv[4];
#pragma unroll
        for (int jj = 0; jj < 4; ++jj) { const int j = j0 + jj; const int e = __shfl(j < 64 ? e_lo : e_hi, j & 63); const unsigned char* vr = p.v8 + (size_t)e * 2048 + lane * 16;
            vv[jj][0] = *(const u32x4*)vr; vv[jj][1] = *(const u32x4*)(vr + 1024); sv[jj] = p.vs[e]; }
#pragma unroll
        for (int jj = 0; jj < 4; ++jj) { const int j = j0 + jj; const float w = __shfl(j < 64 ? w_lo : w_hi, j & 63) * sv[jj];
            axpy16_fp8(vv[jj][0], w, out); axpy16_fp8(vv[jj][1], w, out + 16); __builtin_amdgcn_sched_barrier(0); }
    }
    asm volatile("" : "+s"(row));
    const int mrow = row < NP ? row / SEQ : 4 + (row - NP);
    const float* g2 = p.mod + (size_t)mrow * 12288 + 10240 + lane * 16; const float* x1 = p.x1 + (size_t)row * 2048 + lane * 16;
    float ss = 0.f;
#pragma unroll
    for (int c = 0; c < 2; ++c)
#pragma unroll
        for (int k = 0; k < 16; k += 4) { const float4 xv = *(const float4*)(x1 + c * 1024 + k), gv = *(const float4*)(g2 + c * 1024 + k); float* o = out + c * 16 + k;
            o[0] = xv.x + gv.x * o[0]; o[1] = xv.y + gv.y * o[1]; o[2] = xv.z + gv.z * o[2]; o[3] = xv.w + gv.w * o[3];
            ss += o[0] * o[0] + o[1] * o[1] + o[2] * o[2] + o[3] * o[3]; }
    ss = wave_sum_sw(ss);
    const float rstd = rsqrtf(ss * (1.f / 2048.f) + 1e-6f);
    float* dst = (row < NP ? p.out + O_YP + (size_t)row * 2048 : p.out + O_YS + (size_t)(row - NP) * 2048) + lane * 16;
#pragma unroll
    for (int c = 0; c < 2; ++c)
#pragma unroll
        for (int k = 0; k < 16; k += 4) { const float4 fw = *(const float4*)(p.final_norm + lane * 16 + c * 1024 + k); const float* o = out + c * 16 + k;
            float4 y; y.x = o[0] * rstd * fw.x; y.y = o[1] * rstd * fw.y; y.z = o[2] * rstd * fw.z; y.w = o[3] * rstd * fw.w;
            *(float4*)(dst + c * 1024 + k) = y; }
}
__device__ __forceinline__ void ph10_gather(const Params& p, unsigned qword) {
    const int lane = threadIdx.x & 63;
    for (;;) {
        unsigned coff = qword; asm volatile("" : "+v"(coff));
        unsigned t = 0; if (lane == 0) t = atomicAdd(p.bar + coff, 1u);
        t = (unsigned)__builtin_amdgcn_readfirstlane((int)t);
        if (t >= (unsigned)NTOK) break;
        ph10_token(p, (int)t, lane);
    }
}


template <int CTRL> __device__ __forceinline__ float dpp_add(float v) { return v + __int_as_float(__builtin_amdgcn_update_dpp(0, __float_as_int(v), CTRL, 0xf, 0xf, true)); }
template <int PAT> __device__ __forceinline__ float swz_add(float v) { return v + __int_as_float(__builtin_amdgcn_ds_swizzle(__float_as_int(v), PAT)); }
struct SlabIds { int e_lo, e_hi; };
constexpr int QW_FLAG = 3900;
template <int TBL>
__device__ __forceinline__ SlabIds slab_ids(const Params& p, int t, int lane) {
    SlabIds s;
    if (TBL == 0 && t >= NP && gridDim.x >= 16) {
        for (unsigned sp = 0; sp < (1u << 22); ++sp) { if (__builtin_amdgcn_readfirstlane((int)__hip_atomic_load(p.bar + QW_FLAG, __ATOMIC_RELAXED, __HIP_MEMORY_SCOPE_AGENT)) != 0) break; __builtin_amdgcn_s_sleep(8); }
        s.e_lo = __hip_atomic_load(p.pk_eid + (size_t)t * 128 + lane, __ATOMIC_RELAXED, __HIP_MEMORY_SCOPE_AGENT); s.e_hi = __hip_atomic_load(p.pk_eid + (size_t)t * 128 + 64 + lane, __ATOMIC_RELAXED, __HIP_MEMORY_SCOPE_AGENT);
    } else { s.e_lo = p.pk_eid[(size_t)t * 128 + lane]; s.e_hi = p.pk_eid[(size_t)t * 128 + 64 + lane]; }
    return s;
}
template <int TBL> struct SlabRows { u32x4 rv[16]; u32x4 hq[2]; float w0, w1; };
template <int TBL>
__device__ __forceinline__ void slab_issue(const Params& p, int t, int slab, int lane, const SlabIds& id, SlabRows<TBL>& r) {
    if (TBL == 0) {
        const int gq = lane >> 3, c8 = lane & 7, kq = lane >> 4;
        const unsigned char* tab = p.u8 + (size_t)slab * (16384 * 128) + c8 * 16;
#pragma unroll
        for (int k = 0; k < 16; ++k) { const int e = __shfl(k < 8 ? id.e_lo : id.e_hi, (8 * k + gq) & 63); r.rv[k] = *(const u32x4*)(tab + (size_t)e * 128); }
        const unsigned char* hp = p.h2q + (size_t)t * 2048 + slab * 128 + kq * 32;
        r.hq[0] = *(const u32x4*)hp; r.hq[1] = *(const u32x4*)(hp + 16);
    } else {
        const int gq = lane >> 3, c8 = lane & 7;
        const unsigned char* tab = p.v8 + (size_t)slab * (16384 * 128) + c8 * 16;
#pragma unroll
        for (int k = 0; k < 16; ++k) { const int e = __shfl(k < 8 ? id.e_lo : id.e_hi, (8 * k + gq) & 63); r.rv[k] = *(const u32x4*)(tab + (size_t)e * 128); }
        { const unsigned char* wp = p.wq + (size_t)t * 128 + (lane >> 4) * 8;
          const i32x2 a0 = *(const i32x2*)wp, a1 = *(const i32x2*)(wp + 32), a2 = *(const i32x2*)(wp + 64), a3 = *(const i32x2*)(wp + 96);
          r.hq[0] = (u32x4){(unsigned)a0[0], (unsigned)a0[1], (unsigned)a1[0], (unsigned)a1[1]}; r.hq[1] = (u32x4){(unsigned)a2[0], (unsigned)a2[1], (unsigned)a3[0], (unsigned)a3[1]}; r.w0 = p.wsc[t]; r.w1 = 0.f; }
    }
}
__device__ __forceinline__ long pk64(unsigned lo, unsigned hi) { return (long)(((unsigned long long)hi << 32) | (unsigned long long)lo); }
template <int TBL>
__device__ __forceinline__ void slab_compute(const Params& p, int t, int slab, int lane, const SlabRows<TBL>& r, unsigned char* lds_w) {
    if (TBL == 0) {
        const int r16 = lane & 15, kq = lane >> 4, gq = lane >> 3, c8 = lane & 7;
        unsigned char* stg = lds_w;
        const long b0 = pk64(r.hq[0][0], r.hq[0][1]), b1 = pk64(r.hq[0][2], r.hq[0][3]), b2 = pk64(r.hq[1][0], r.hq[1][1]), b3 = pk64(r.hq[1][2], r.hq[1][3]);
        f32x4 sel = (f32x4){0.f, 0.f, 0.f, 0.f};
#pragma unroll
        for (int hf = 0; hf < 2; ++hf) {
#pragma unroll
            for (int k = 0; k < 8; ++k) *(u32x4*)(stg + (8 * k + gq) * 144 + c8 * 16) = r.rv[8 * hf + k];
            asm volatile("s_waitcnt lgkmcnt(0)" ::: "memory");
#pragma unroll
            for (int g2 = 0; g2 < 4; ++g2) { const int g = 4 * hf + g2;
                const u32x4 a0 = *(const u32x4*)(stg + (16 * g2 + r16) * 144 + kq * 32), a1 = *(const u32x4*)(stg + (16 * g2 + r16) * 144 + kq * 32 + 16);
                f32x4 acc = (f32x4){0.f, 0.f, 0.f, 0.f};
                acc = __builtin_amdgcn_mfma_f32_16x16x32_fp8_fp8(pk64(a0[0], a0[1]), b0, acc, 0, 0, 0);
                acc = __builtin_amdgcn_mfma_f32_16x16x32_fp8_fp8(pk64(a0[2], a0[3]), b1, acc, 0, 0, 0);
                acc = __builtin_amdgcn_mfma_f32_16x16x32_fp8_fp8(pk64(a1[0], a1[1]), b2, acc, 0, 0, 0);
                acc = __builtin_amdgcn_mfma_f32_16x16x32_fp8_fp8(pk64(a1[2], a1[3]), b3, acc, 0, 0, 0);
                if (r16 == g) sel = acc; }
            asm volatile("s_waitcnt lgkmcnt(0)" ::: "memory");
        }
        if (r16 < 8) *(f32x4*)(p.pd + ((size_t)slab * NTOK + t) * 128 + 16 * r16 + 4 * kq) = sel;
    } else {
        const int i16 = lane & 15, kq = lane >> 4, gq = lane >> 3, c8 = lane & 7;
        unsigned char* stg = lds_w;
        f32x4 acc[8];
#pragma unroll
        for (int cb = 0; cb < 8; ++cb) acc[cb] = (f32x4){0.f, 0.f, 0.f, 0.f};
#pragma unroll
        for (int hf = 0; hf < 2; ++hf) {
#pragma unroll
            for (int k = 0; k < 8; ++k) *(u32x4*)(stg + (8 * k + gq) * 144 + c8 * 16) = r.rv[8 * hf + k];
            asm volatile("s_waitcnt lgkmcnt(0)" ::: "memory");
#pragma unroll
            for (int s2 = 0; s2 < 2; ++s2) { const int s = 2 * hf + s2;
                const long a = pk64(r.hq[s >> 1][2 * (s & 1)], r.hq[s >> 1][2 * (s & 1) + 1]);
                const unsigned char* tb = stg + (32 * s2 + 8 * kq + (i16 >> 1)) * 144 + 8 * (i16 & 1);
#pragma unroll
                for (int cb = 0; cb < 8; ++cb) { const i32x2 bq = __builtin_amdgcn_ds_read_tr8_b64_v2i32((LAS i32x2*)(tb + 16 * cb));
                    acc[cb] = __builtin_amdgcn_mfma_f32_16x16x32_fp8_fp8(a, pk64((unsigned)bq[0], (unsigned)bq[1]), acc[cb], 0, 0, 0); } }
            asm volatile("s_waitcnt lgkmcnt(0)" ::: "memory");
        }
        if (lane < 16) { float* dst = p.po + (size_t)t * 2048 + slab * 128 + lane;
#pragma unroll
            for (int cb = 0; cb < 8; ++cb) dst[16 * cb] = acc[cb][0] * r.w0; }
    }
}
template <int TBL>
__device__ __forceinline__ void peer_slab_phase(const Params& p, int bx, int G, unsigned char* lds, bool skip_last) {
    int lane = threadIdx.x & 63; asm volatile("" : "+v"(lane));
    const int wave = threadIdx.x >> 6;
    const int x = bx & 7, nblk = ((G - x + 7) >> 3) - ((skip_last && x == ((G - 1) & 7)) ? 1 : 0), w = (bx >> 3) * 8 + wave, nw = nblk * 8;
    const int cw = w < NTOK ? (NTOK - w + nw - 1) / nw : 0, n = 2 * cw;
#define ITEM_T(i) (w + ((i) % cw) * nw)
#define ITEM_S(i) (x + 8 * ((i) / cw))
    if (n == 0) return;
    SlabRows<TBL> A, B; SlabIds ia, ib;
    ia = slab_ids<TBL>(p, ITEM_T(0), lane);
    ib = slab_ids<TBL>(p, ITEM_T(n > 1 ? 1 : 0), lane);
    slab_issue<TBL>(p, ITEM_T(0), ITEM_S(0), lane, ia, A);
#pragma unroll 1
    for (int i = 0; i < n; i += 2) {
        const int i1 = i + 1 < n ? i + 1 : n - 1, i2 = i + 2 < n ? i + 2 : n - 1, i3 = i + 3 < n ? i + 3 : n - 1;
        ia = slab_ids<TBL>(p, ITEM_T(i2), lane);
        slab_issue<TBL>(p, ITEM_T(i1), ITEM_S(i1), lane, ib, B);
        slab_compute<TBL>(p, ITEM_T(i), ITEM_S(i), lane, A, lds + wave * 9216);
        ib = slab_ids<TBL>(p, ITEM_T(i3), lane);
        slab_issue<TBL>(p, ITEM_T(i2), ITEM_S(i2), lane, ia, A);
        if (i + 1 < n) slab_compute<TBL>(p, ITEM_T(i1), ITEM_S(i1), lane, B, lds + wave * 9216);
    }
#undef ITEM_T
#undef ITEM_S
}
__device__ __forceinline__ void peer_w_phase(const Params& p, int bx, int G) {
    const int lane = threadIdx.x & 63, gw = bx * 8 + (threadIdx.x >> 6);
#pragma unroll 1
    for (int t = gw; t < NTOK; t += G * 8) {
        float wv[2];
#pragma unroll
        for (int hh = 0; hh < 2; ++hh) { const int pi = lane + 64 * hh; float d = 0.f;
#pragma unroll
            for (int s = 0; s < 16; ++s) d += p.pd[((size_t)s * NTOK + t) * 128 + pi];
            const int e = p.pk_eid[(size_t)t * 128 + pi];
            wv[hh] = p.pk_gate[(size_t)t * 128 + pi] * gelu_tanh(d * p.us[e]) * p.vs[e]; }
        const float am = wave_max(fmaxf(fabsf(wv[0]), fabsf(wv[1])));
        const float sc = am > 0.f ? am * (1.f / 440.f) : 1.f, inv = 1.f / sc;
        const int pk = __builtin_amdgcn_cvt_pk_fp8_f32(wv[0] * inv, wv[1] * inv, 0, false);
        p.wq[(size_t)t * 128 + lane] = (unsigned char)(pk & 0xff); p.wq[(size_t)t * 128 + 64 + lane] = (unsigned char)((pk >> 8) & 0xff);
        if (lane == 0) p.wsc[t] = sc;
    }
}
__device__ __forceinline__ void peer_final_phase(const Params& p, int bx, int G) {
    const int lane = threadIdx.x & 63, gw = bx * 8 + (threadIdx.x >> 6);
#pragma unroll 1
    for (int row = gw; row < NTOK; row += G * 8) {
        const int mrow = row < NP ? row / SEQ : 4 + (row - NP);
        const float* g2 = p.mod + (size_t)mrow * 12288 + 10240 + lane * 16; const float* x1 = p.x1 + (size_t)row * 2048 + lane * 16; const float* po = p.po + (size_t)row * 2048 + lane * 16;
        float out[32]; float ss = 0.f;
#pragma unroll
        for (int c = 0; c < 2; ++c)
#pragma unroll
            for (int k = 0; k < 16; k += 4) { const float4 xv = *(const float4*)(x1 + c * 1024 + k), gv = *(const float4*)(g2 + c * 1024 + k), ov = *(const float4*)(po + c * 1024 + k); float* o = out + c * 16 + k;
                o[0] = xv.x + gv.x * ov.x; o[1] = xv.y + gv.y * ov.y; o[2] = xv.z + gv.z * ov.z; o[3] = xv.w + gv.w * ov.w;
                ss += o[0] * o[0] + o[1] * o[1] + o[2] * o[2] + o[3] * o[3]; }
        ss = wave_sum_sw(ss);
        const float rstd = rsqrtf(ss * (1.f / 2048.f) + 1e-6f);
        float* dst = (row < NP ? p.out + O_YP + (size_t)row * 2048 : p.out + O_YS + (size_t)(row - NP) * 2048) + lane * 16;
#pragma unroll
        for (int c = 0; c < 2; ++c)
#pragma unroll
            for (int k = 0; k < 16; k += 4) { const float4 fw = *(const float4*)(p.final_norm + lane * 16 + c * 1024 + k); const float* o = out + c * 16 + k;
                float4 y; y.x = o[0] * rstd * fw.x; y.y = o[1] * rstd * fw.y; y.z = o[2] * rstd * fw.z; y.w = o[3] * rstd * fw.w;
                *(float4*)(dst + c * 1024 + k) = y; }
    }
}


constexpr int NF_T = 1024, NF_W = 64, NFILL = NF_W + 2 * NF_T + 2 * 2048, QW_HEAD = 3700, QW_DONE = 3800;
__device__ __forceinline__ void filler_unit(const Params& p, int f, unsigned char* lds) {
    if (f < NF_W) {
        const int b = f >> 3, j0 = (f & 7) * 64;
#pragma unroll
        for (int i = 0; i < 16; ++i) { const int idx = threadIdx.x + NTHR * i, j = j0 + (idx >> 7), c = (idx & 127) * 4;
            if (j < 511) *(float4*)(p.out + O_WKS + ((size_t)b * 512 + j) * 512 + c) = *(const float4*)(p.state_win + ((size_t)b * 512 + j + 1) * 512 + c); }
        return; }
    f -= NF_W;
    if (f < NF_T) ph0_transpose(p.w_out, p.wt_out, 2048, 32, f, (float*)lds);
    else if (f < 2 * NF_T) ph0_transpose(p.peer_wq, p.wt_q, 2048, 32, f - NF_T, (float*)lds);
    else if (f < 2 * NF_T + 2048) ph0_fp8(p.peer_u, p.u8, p.us, f - 2 * NF_T);
    else ph0_fp8(p.peer_v, p.v8, p.vs, f - 2 * NF_T - 2048);
}
template <bool DRAIN>
__device__ __forceinline__ void filler_bg(const Params& p, unsigned char* lds, int phase, int G) {
    volatile int* w = (volatile int*)(lds + LDS_BYTES - 64);
    __syncthreads();
    if (!DRAIN && threadIdx.x == 0) __hip_atomic_fetch_add(p.bar + QW_DONE + phase, 1u, __ATOMIC_RELAXED, __HIP_MEMORY_SCOPE_AGENT);
    for (;;) {
        if (threadIdx.x == 0) {
            int f = NFILL;
            const bool others_busy = DRAIN || __hip_atomic_load(p.bar + QW_DONE + phase, __ATOMIC_RELAXED, __HIP_MEMORY_SCOPE_AGENT) < (unsigned)G;
            if (others_busy) f = (int)__hip_atomic_fetch_add(p.bar + QW_HEAD, 1u, __ATOMIC_RELAXED, __HIP_MEMORY_SCOPE_AGENT);
            w[0] = f;
        }
        __syncthreads();
        const int f = w[0];
        __syncthreads();
        if (f >= NFILL) break;
        filler_unit(p, f, lds);
    }
}
#ifndef PROBE_DBL
#define PROBE_DBL 0
#endif
#ifndef PROBE_SUB
#define PROBE_SUB 0
#endif
#define PHASE_FN(k) __device__ __forceinline__ void phase##k(const Params& p, unsigned char* lds, const int bx, const int G, const int rep)
PHASE_FN(0) {
    float* smem = (float*)lds;
    constexpr int NA = 192, NT_IN = 32 * (INCP / 64), NC = 2 * 128 + 2 * 4, NK = 8, NTOT = NA + NT_IN + NC + NK;
    volatile int* qw = (volatile int*)(lds + LDS_BYTES - 64);
    const unsigned qhead = QW_HEAD + 32 + (unsigned)rep;
    for (;;) {
        __syncthreads();
        if (threadIdx.x == 0) qw[0] = (int)__hip_atomic_fetch_add(p.bar + qhead, 1u, __ATOMIC_RELAXED, __HIP_MEMORY_SCOPE_AGENT);
        __syncthreads();
        int u = qw[0];
        if (u >= NTOT) break;
        if (u < NA) { ph0_adaln(p, u, smem); continue; }
        u -= NA;
        if (u < NT_IN) { ph0_transpose(p.w_in, p.wt_in, INC, INCP / 64, u, smem); continue; }
        u -= NT_IN;
        if (u < NC) {
            if (u < 256) { const int s = u >> 7; ph0_transpose(p.cmp_w1 + (size_t)s * 4096 * 128, p.w1t + (size_t)s * 128 * 4096, 128, 2, u & 127, smem, 4096); }
            else { const int s = (u - 256) >> 2; ph0_transpose(p.cmp_w2 + (size_t)s * 128 * 128, p.w2t + (size_t)s * 128 * 128, 128, 2, (u - 256) & 3, smem, 128); }
            continue; }
        ph0_keys(p, u - NC);
    }
}
PHASE_FN(1) { for (int u = bx; u < MPAD / 8; u += G) norm_row<0>(p, u * 8 + (threadIdx.x >> 6)); }
PHASE_FN(2) {
    constexpr int MT = NP / 256, NG1 = MT * (INCP / 256);
    float* C = p.P; float* out = p.out; bf16_t* Qb = p.Qb; bf16_t* KVb = p.KVb;
    auto epiP = [C](int r, int c, float v) { __builtin_nontemporal_store(v, C + (size_t)r * INCP + c); };
    auto epiA = [Qb](int r, int c, float v) { Qb[(size_t)r * 1024 + c] = f2bf(v); };
    auto epiB = [out](int r, int c, float v) { out[O_CKP + (size_t)r * 512 + (c - C_KVC)] = v; };
    auto epiC = [out, KVb](int r, int c, float v) { out[O_SKP + (size_t)r * 512 + (c - C_KVS)] = v; KVb[(size_t)r * 1024 + (c - C_KVS)] = f2bf(v); };
    auto epiD = [out, KVb](int r, int c, float v) { KVb[(size_t)r * 1024 + (c - C_KVS)] = f2bf(v); const int t = r & (SEQ - 1);
        if (t >= SEQ - 512) out[O_WKP + ((size_t)(r >> 11) * 512 + (t - (SEQ - 512))) * 512 + (c - C_KVW)] = v; };
    volatile int* qw = (volatile int*)(lds + LDS_BYTES - 64);
    const unsigned qhead = QW_HEAD + 64 + (unsigned)rep * 64;
    for (;;) {
        __syncthreads();
        if (threadIdx.x == 0) qw[0] = (int)__hip_atomic_fetch_add(p.bar + qhead, 1u, __ATOMIC_RELAXED, __HIP_MEMORY_SCOPE_AGENT);
        __syncthreads();
        const int q = qw[0];
        if (q >= 128 + NG1 + INCP / 64) break;
        if (q < 128) cmp_tile<true>(p, q >> 1, q & 1, lds);
        else if (q < 128 + NG1) { const int g = q - 128, pn = (g / MT + 4) % (INCP / 256), pm = g % MT;
            if (pn < 4) gemm_tile(p.h1, p.wt_in, 2048, pm * 256, pn * 256, (bf16_t*)lds, epiA);
            else if (pn < 6) gemm_tile(p.h1, p.wt_in, 2048, pm * 256, pn * 256, (bf16_t*)lds, epiB);
            else if (pn < 8) gemm_tile(p.h1, p.wt_in, 2048, pm * 256, pn * 256, (bf16_t*)lds, epiC);
            else if (pn < 10) gemm_tile(p.h1, p.wt_in, 2048, pm * 256, pn * 256, (bf16_t*)lds, epiD);
            else gemm_tile(p.h1, p.wt_in, 2048, pm * 256, pn * 256, (bf16_t*)lds, epiP); }
        else gemm_rows8<4>(p.h1 + (size_t)NP * 2048, p.wt_in, q - 128 - NG1, lds, epiP);
    }
    if (rep == 0) filler_bg<false>(p, lds, 2, G);
}
PHASE_FN(3) {
    float* smem = (float*)lds;
    constexpr int NQ3 = 8 + 1024 + NSB + NSB + NB * 3;
    volatile int* qw = (volatile int*)(lds + LDS_BYTES - 64);
    const unsigned qhead = QW_HEAD + 40 + (unsigned)rep;
    for (;;) {
        __syncthreads();
        if (threadIdx.x == 0) qw[0] = (int)__hip_atomic_fetch_add(p.bar + qhead, 1u, __ATOMIC_RELAXED, __HIP_MEMORY_SCOPE_AGENT);
        __syncthreads();
        int u = qw[0];
        if (u >= NQ3) break;
        if (u < 8) { cmp_tile<false>(p, u >> 1, u & 1, lds); continue; }
        u -= 8;
        if (u < 1024) { ph3_gdnA(p, u, lds); if (PROBE_SUB & 1) ph3_gdnA(p, u, lds); continue; }
        u -= 1024;
        if (u < NSB) { ph3_gdnprep(p, NP + u, smem); continue; }
        ph3_scatter(p, u - NSB);
    }
    if (rep == 0) filler_bg<false>(p, lds, 3, G);
}
PHASE_FN(4) {
    float* smem = (float*)lds;
    if (G >= 128) {
        if (bx < 64) { ph4_gdnB(p, bx, lds); if (PROBE_SUB & 8) ph4_gdnB(p, bx, lds); ph4_gdn(p, 32 + bx, smem); }
        else if (bx < 80) { ph4_nsa_sample(p, bx - 64, lds); if (PROBE_SUB & 32) ph4_nsa_sample(p, bx - 64, lds); }
        else { const int NB = G - 80, k = bx - 80;
            for (int pass = 0; pass * NB < 256; ++pass) { const int u = pass * NB + ((pass & 1) ? NB - 1 - k : k); if (u < 256) { ph4_nsa_fast(p, u, lds); if (PROBE_SUB & 16) ph4_nsa_fast(p, u, lds); } }
        }
    } else {
        for (int u = bx; u < 64; u += G) ph4_gdnB(p, u, lds);
        for (int u = 32 + bx; u < 96; u += G) ph4_gdn(p, u, smem);
        for (int u = bx; u < 256; u += G) ph4_nsa_fast(p, u, lds);
        for (int u = bx; u < 2 * NSB; u += G) ph4_nsa_sample(p, u, lds);
    }
    if (rep == 0) filler_bg<false>(p, lds, 4, G);
}
PHASE_FN(5) { for (int u = bx; u < 1024; u += G) ph5_gdnC(p, u, lds); for (int u = bx; u < NSB; u += G) ph5_gdnout(p, NP + u); if (rep == 0) filler_bg<true>(p, lds, 5, G); }
PHASE_FN(6) {
    float* C = p.acc2;
    auto epi = [C](int r, int c, float v) { C[(size_t)r * 2048 + c] = v; };
    constexpr int MT = NP / 256;
    for (int u = bx; u < MT * 8; u += G) { const int pn = u / MT, pm = u % MT; gemm_tile(p.amix, p.wt_out, 2048, pm * 256, pn * 256, (bf16_t*)lds, epi); }
    for (int c = bx; c < 128; c += G) gemm_rows8<1>(p.amix + (size_t)NP * 2048, p.wt_out, c, lds, epi);
}
PHASE_FN(7) { for (int u = bx; u < MPAD / 8; u += G) norm_row<1>(p, u * 8 + (threadIdx.x >> 6)); }
PHASE_FN(8) {
    float* C = p.qp;
    auto epi = [C](int r, int c, float v) { C[(size_t)r * 2048 + c] = v; };
    constexpr int MT = NP / 256;
    for (int u = bx; u < MT * 8; u += G) { const int pn = u / MT, pm = u % MT; gemm_tile(p.h2, p.wt_q, 2048, pm * 256, pn * 256, (bf16_t*)lds, epi); }
    for (int c = bx; c < 128; c += G) gemm_rows8<1>(p.h2 + (size_t)NP * 2048, p.wt_q, c, lds, epi);
}
PHASE_FN(9) { for (int u = bx; u < NP / 16 + ((G < 16) ? 1 : 0); u += G) ph9_peer_fast<false>(p, u, lds); }
PHASE_FN(10) {
    if (G >= 16 && bx == G - 1) {
        ph9_peer_fast<true>(p, NP / 16, lds);
        asm volatile("s_waitcnt vmcnt(0)" ::: "memory");
        __syncthreads();
        if (threadIdx.x == 0) __hip_atomic_store(p.bar + QW_FLAG, 1u, __ATOMIC_RELAXED, __HIP_MEMORY_SCOPE_AGENT);
    } else peer_slab_phase<0>(p, bx, G, lds, G >= 16);
}
PHASE_FN(11) { peer_w_phase(p, bx, G); }
PHASE_FN(12) { peer_slab_phase<1>(p, bx, G, lds, false); }
PHASE_FN(13) { peer_final_phase(p, bx, G); }

__global__ void __launch_bounds__(NTHR, 2) fwd(Params p) {
    extern __shared__ __attribute__((aligned(16))) unsigned char lds[];
    LAS unsigned* xbw = (LAS unsigned*)(lds + LDS_BYTES - 16);
    const int tid = threadIdx.x, G = gridDim.x, bx = blockIdx.x;
    if (tid < 4) xbw[tid] = 0u;
    __syncthreads();
    XcdBarrier bar; bar.bar = p.bar; bar.x = 0; bar.st = nullptr;
    const int lo = p.ph_lo, hi = p.ph_hi;
    if (hi - lo > 1) bar = xcd_barrier_post(p.bar, (volatile LAS unsigned*)xbw);
#define IN(k) (lo <= (k) && (k) < hi)
#ifndef PROBE_BAR
#define PROBE_BAR 0
#endif
#define SEAM(k) do { if (IN(k) && IN((k) + 1)) { xcd_barrier(bar); if (PROBE_BAR) xcd_barrier(bar); } } while (0)
#define RUN(k) do { if (IN(k)) { phase##k(p, lds, bx, G, 0); if ((PROBE_DBL >> (k)) & 1) { __syncthreads(); phase##k(p, lds, bx, G, 1); } } } while (0)
    RUN(0); SEAM(0);
    RUN(1); SEAM(1);
    RUN(2); SEAM(2);
    RUN(3); SEAM(3);
    RUN(4); SEAM(4);
    RUN(5); SEAM(5);
    RUN(6); SEAM(6);
    RUN(7); SEAM(7);
    RUN(8); SEAM(8);
    RUN(9); SEAM(9);
    RUN(10); SEAM(10);
    RUN(11); SEAM(11);
    RUN(12); SEAM(12);
    RUN(13);
}

extern "C" void kernel_launch(void* const* d_in, const int* in_sizes, int n_in, void* d_out, int out_size, void* d_ws, size_t ws_size, hipStream_t stream) {
    static int grid = 0;
    if (grid == 0) {
        int dev = 0, cus = 0;
        if (hipGetDevice(&dev) != hipSuccess || hipDeviceGetAttribute(&cus, hipDeviceAttributeMultiprocessorCount, dev) != hipSuccess) { fprintf(stderr, "kernel_launch: device query failed\n"); grid = -1; return; }
        if (hipFuncSetAttribute((const void*)fwd, hipFuncAttributeMaxDynamicSharedMemorySize, LDS_BYTES) != hipSuccess) { fprintf(stderr, "kernel_launch: hipFuncSetAttribute failed\n"); grid = -1; return; }
        int per_cu = 0;
        if (hipOccupancyMaxActiveBlocksPerMultiprocessor(&per_cu, (const void*)fwd, NTHR, LDS_BYTES) != hipSuccess || per_cu < 1) fprintf(stderr, "kernel_launch: occupancy query says %d\n", per_cu);
        (void)hipGetLastError();
        grid = cus;
    }
    if (grid < 0) return;
    Params p{};
    p.x_prompt = (const float*)d_in[0]; p.x_sample = (const float*)d_in[1]; p.cache_cmp = (const float*)d_in[2]; p.cache_sel = (const float*)d_in[3];
    p.state_win = (const float*)d_in[4]; p.state_conv = (const float*)d_in[5]; p.state_gdn = (const float*)d_in[6]; p.page_table = (const int*)d_in[7];
    p.c_prompt = (const float*)d_in[8]; p.c_sample = (const float*)d_in[9]; p.w_ada = (const float*)d_in[10]; p.b_ada = (const float*)d_in[11];
    p.norm_mix = (const float*)d_in[12]; p.norm_ffn = (const float*)d_in[13]; p.w_in = (const float*)d_in[14]; p.cmp_pe = (const float*)d_in[15];
    p.cmp_w1 = (const float*)d_in[16]; p.cmp_b1 = (const float*)d_in[17]; p.cmp_w2 = (const float*)d_in[18]; p.conv_w = (const float*)d_in[19];
    p.a_log = (const float*)d_in[20]; p.dt_bias = (const float*)d_in[21]; p.gdn_norm = (const float*)d_in[22]; p.w_out = (const float*)d_in[23];
    p.peer_wq = (const float*)d_in[24]; p.peer_keys = (const float*)d_in[25]; p.peer_u = (const float*)d_in[26]; p.peer_v = (const float*)d_in[27];
    p.final_norm = (const float*)d_in[28];
    p.out = (float*)d_out;
    unsigned char* ws = (unsigned char*)d_ws; size_t off = 0;
    auto take = [&](size_t bytes) { unsigned char* r = ws + off; off += (bytes + 255) & ~(size_t)255; return r; };
    p.bar = (unsigned*)take(16384);
    p.mod = (float*)take((size_t)12 * 12288 * 4);
    p.h1 = (bf16_t*)take((size_t)MPAD * 2048 * 2);
    p.wt_in = (bf16_t*)take((size_t)INCP * 2048 * 2);
    p.wt_out = (bf16_t*)take((size_t)2048 * 2048 * 2);
    p.wt_q = (bf16_t*)take((size_t)2048 * 2048 * 2);
    p.P = (float*)take((size_t)MPAD * INCP * 4);
    p.ckv_p = (float*)take((size_t)4 * 64 * 4 * 128 * 4);
    p.ckv_s = (float*)take((size_t)8 * 512 * 4 * 128 * 4);
    p.qkvn = (float*)take((size_t)NTOK * 3072 * 4);
    p.gbeta = (float*)take((size_t)NTOK * 8 * 4);
    p.gg = (float*)take((size_t)NTOK * 8 * 4);
    p.ograw = (float*)take((size_t)NTOK * 1024 * 4);
    p.amix = (bf16_t*)take((size_t)MPAD * 2048 * 2);
    p.acc2 = (float*)take((size_t)MPAD * 2048 * 4);
    p.x1 = (float*)take((size_t)NTOK * 2048 * 4);
    p.h2f = (float*)take((size_t)NTOK * 2048 * 4);
    p.h2 = (bf16_t*)take((size_t)MPAD * 2048 * 2);
    p.qp = (float*)take((size_t)MPAD * 2048 * 4);
    p.Qb = (bf16_t*)take((size_t)MPAD * 1024 * 2);
    p.gN = (bf16_t*)take((size_t)1024 * 16384 * 2); p.gBT = (bf16_t*)take((size_t)1024 * 16384 * 2); p.gQp = (bf16_t*)take((size_t)1024 * 8192 * 2);
    p.u8 = (unsigned char*)take((size_t)16384 * 2048); p.v8 = (unsigned char*)take((size_t)16384 * 2048); p.us = (float*)take(65536); p.vs = (float*)take(65536);
    p.pk_eid = (int*)take((size_t)NTOK * 128 * 4); p.pk_gate = (float*)take((size_t)NTOK * 128 * 4);
    p.pd = (float*)take((size_t)16 * NTOK * 128 * 4); p.wv = (float*)take((size_t)NTOK * 128 * 4); p.h2q = (unsigned char*)take((size_t)NTOK * 2048); p.po = (float*)take((size_t)NTOK * 2048 * 4); p.wq = (unsigned char*)take((size_t)NTOK * 128); p.wsc = (float*)take((size_t)NTOK * 4); p.kh = (bf16_t*)take(65536); p.kl = (bf16_t*)take(65536); p.w1t = (bf16_t*)take((size_t)2 * 128 * 4096 * 2); p.w2t = (bf16_t*)take((size_t)2 * 128 * 128 * 2);
    p.gOpT = (bf16_t*)take((size_t)1024 * 8192 * 2); p.gST = (bf16_t*)take((size_t)1024 * 16384 * 2); p.ggl = (float*)take(4096);
    p.KVb = (bf16_t*)take((size_t)MPAD * 1024 * 2);
    if (off > ws_size) { fprintf(stderr, "kernel_launch: workspace too small (%zu > %zu)\n", off, ws_size); return; }
    (void)hipMemsetAsync(p.bar, 0, 16384, stream);
    if (N_LAUNCHES == 1) { p.ph_lo = 0; p.ph_hi = NPH; hipLaunchKernelGGL(fwd, dim3(grid), dim3(NTHR), LDS_BYTES, stream, p); }
    else for (int li = 0; li < NPH; ++li) { p.ph_lo = li; p.ph_hi = li + 1; hipLaunchKernelGGL(fwd, dim3(grid), dim3(NTHR), LDS_BYTES, stream, p); }
    const hipError_t le = hipPeekAtLastError();
    if (le != hipSuccess) fprintf(stderr, "kernel_launch: launch failed: %s\n", hipGetErrorName(le));
}
```

```cpp
#include <hip/hip_runtime.h>
#include <stdint.h>
#include <stdio.h>

#ifndef N_LAUNCHES
#define N_LAUNCHES 1
#endif

typedef unsigned short bf16_t;
typedef short bf16x8 __attribute__((ext_vector_type(8)));
typedef float f32x4 __attribute__((ext_vector_type(4)));
typedef float f32x16 __attribute__((ext_vector_type(16)));
typedef unsigned u32x4 __attribute__((ext_vector_type(4)));
typedef unsigned u32x2 __attribute__((ext_vector_type(2)));
typedef __bf16 bf2_t __attribute__((ext_vector_type(2)));
typedef float f32x2 __attribute__((ext_vector_type(2)));
typedef int i32x2 __attribute__((ext_vector_type(2)));
#define MFMA32(a, b, c) __builtin_amdgcn_mfma_f32_32x32x16_bf16((a), (b), (c), 0, 0, 0)
#define MFMA16(a, b, c) __builtin_amdgcn_mfma_f32_16x16x32_bf16((a), (b), (c), 0, 0, 0)

constexpr int DM = 2048, SEQ = 2048, NB = 4, NSB = 8;
constexpr int NP = NB * SEQ;
constexpr int NTOK = NP + NSB;
constexpr int MPAD = 8448;
constexpr int INC = 6696, INCP = 6912;
constexpr int C_Q = 0, C_KVC = 1024, C_KVS = 1536, C_KVW = 2048, C_GTS = 2560, C_QKV = 2584, C_Z = 5656, C_BL = 6680, C_AL = 6688;
constexpr int PAST = 16384, NPAGES = 128;
constexpr int NPH = 14;
constexpr int LDS_BYTES = 147456;
constexpr int NTHR = 512;

struct Params {
    const float *x_prompt, *x_sample, *cache_cmp, *cache_sel, *state_win, *state_conv, *state_gdn;
    const int* page_table;
    const float *c_prompt, *c_sample, *w_ada, *b_ada, *norm_mix, *norm_ffn, *w_in, *cmp_pe, *cmp_w1, *cmp_b1, *cmp_w2,
        *conv_w, *a_log, *dt_bias, *gdn_norm, *w_out, *peer_wq, *peer_keys, *peer_u, *peer_v, *final_norm;
    float* out;
    unsigned* bar;
    float* mod;
    bf16_t* h1;
    bf16_t* wt_in;
    bf16_t* wt_out;
    bf16_t* wt_q;
    float* P;
    float* ckv_p;
    float* ckv_s;
    float* qkvn;
    float* gbeta;
    float* gg;
    float* ograw;
    bf16_t* amix;
    float* acc2;
    float* x1;
    float* h2f;
    bf16_t* h2;
    float* qp;
    bf16_t* Qb;
    bf16_t* gN;
    bf16_t* gBT;
    bf16_t* gQp;
    bf16_t* gOpT;
    bf16_t* gST;
    float* ggl;
    unsigned char* u8;
    unsigned char* v8;
    float* us;
    float* vs;
    int* pk_eid;
    float* pk_gate;
    float* pd;
    unsigned char* h2q;
    float* wv;
    float* po;
    unsigned char* wq;
    float* wsc;
    bf16_t* kh;
    bf16_t* kl;
    bf16_t* w1t;
    bf16_t* w2t;
    bf16_t* KVb;
    int ph_lo, ph_hi;
};

constexpr size_t O_YP = 0, O_YS = O_YP + (size_t)NP * DM, O_CKP = O_YS + (size_t)NSB * DM, O_CKS = O_CKP + (size_t)NP * 512,
                 O_SKP = O_CKS + NSB * 512, O_SKS = O_SKP + (size_t)NP * 512, O_WKP = O_SKS + NSB * 512, O_WKS = O_WKP + (size_t)NB * 512 * 512,
                 O_CVP = O_WKS + (size_t)NSB * 512 * 512, O_CVS = O_CVP + NB * 3 * 3072, O_GP = O_CVS + NSB * 3 * 3072,
                 O_GS = O_GP + (size_t)NB * 8 * 128 * 128, O_END = O_GS + (size_t)NSB * 8 * 128 * 128;

__device__ __forceinline__ bf16_t f2bf(float f) { unsigned u = __float_as_uint(f); u += 0x7fffu + ((u >> 16) & 1u); return (bf16_t)(u >> 16); }
__device__ __forceinline__ unsigned pk2(float a, float b) { return (unsigned)f2bf(a) | ((unsigned)f2bf(b) << 16); }
__device__ __forceinline__ float wave_sum(float v) { for (int o = 32; o > 0; o >>= 1) v += __shfl_xor(v, o); return v; }
__device__ __forceinline__ float wave_sum_sw(float v) {
    v += __int_as_float(__builtin_amdgcn_ds_swizzle(__float_as_int(v), (1 << 10) | 0x1f));
    v += __int_as_float(__builtin_amdgcn_ds_swizzle(__float_as_int(v), (2 << 10) | 0x1f));
    v += __int_as_float(__builtin_amdgcn_ds_swizzle(__float_as_int(v), (4 << 10) | 0x1f));
    v += __int_as_float(__builtin_amdgcn_ds_swizzle(__float_as_int(v), (8 << 10) | 0x1f));
    v += __int_as_float(__builtin_amdgcn_ds_swizzle(__float_as_int(v), (16 << 10) | 0x1f));
    const auto rr = __builtin_amdgcn_permlane32_swap(__float_as_uint(v), __float_as_uint(v), false, false);
    return __uint_as_float(rr[0]) + __uint_as_float(rr[1]);
}
__device__ __forceinline__ float wave_max(float v) { for (int o = 32; o > 0; o >>= 1) v = fmaxf(v, __shfl_xor(v, o)); return v; }
__device__ __forceinline__ float silu_f(float x) { return x / (1.f + __expf(-x)); }
__device__ __forceinline__ float sigmoid_f(float x) { return 1.f / (1.f + __expf(-x)); }
__device__ __forceinline__ float gelu_tanh(float x) { return 0.5f * x * (1.f + tanhf(0.7978845608028654f * (x + 0.044715f * x * x * x))); }
__device__ __forceinline__ float softplus_f(float x) { return x > 20.f ? x : log1pf(__expf(x)); }

#define XB_TMO      128
#define XB_XCNT(j)  (256  + 64 * (j))
#define XB_XSUB(j)  (1280 + 64 * (j))
#define XB_XGEN(j)  (2304 + 64 * (j))
#define XB_TOP      3328
#define XB_TOPGEN   3392
#define XCD_BAR_WORDS 3456
#define XB_SPIN_CAP (1u << 18)
#define LAS __attribute__((address_space(3)))
__device__ __forceinline__ unsigned xb_ld(unsigned* p)              { return __hip_atomic_load(p, __ATOMIC_RELAXED, __HIP_MEMORY_SCOPE_AGENT); }
__device__ __forceinline__ unsigned xb_add(unsigned* p, unsigned v) { return __hip_atomic_fetch_add(p, v, __ATOMIC_RELAXED, __HIP_MEMORY_SCOPE_AGENT); }
__device__ __forceinline__ unsigned xb_xcc_id() { return (unsigned)__builtin_amdgcn_s_getreg((3 << 11) | 20) & 0xFu; }
#define XB_SPIN(cond, bar) do { unsigned _sp = 0; while (cond) { __builtin_amdgcn_s_sleep(1); \
    if ((++_sp & 255u) == 0u) { if (xb_ld(&(bar)[XB_TMO])) break; if (_sp > XB_SPIN_CAP) { atomicAdd(&(bar)[XB_TMO], 1u); break; } } } } while (0)
struct XcdBarrier { unsigned* bar; unsigned x; volatile LAS unsigned* st; };
__device__ __forceinline__ XcdBarrier xcd_barrier_post(unsigned* bar, volatile LAS unsigned* st) {
    XcdBarrier b; b.bar = bar; b.x = xb_xcc_id(); b.st = st;
    if (threadIdx.x == 0) (void)xb_add(&bar[XB_XCNT(b.x)], 1u);
    return b;
}
__device__ __forceinline__ void xcd_barrier_complete(unsigned* bar, unsigned x, unsigned& nloc, unsigned& nx) {
    const unsigned G = gridDim.x * gridDim.y * gridDim.z;
    unsigned sum, cnt, mine, sp = 0u;
    for (;;) {
        sum = 0u; cnt = 0u; mine = 0u;
#pragma unroll
        for (unsigned j = 0; j < 16; ++j) { const unsigned c = xb_ld(&bar[XB_XCNT(j)]); sum += c; cnt += (c > 0u) ? 1u : 0u; mine = (j == x) ? c : mine; }
        if (sum == G) break;
        __builtin_amdgcn_s_sleep(1);
        if ((++sp & 255u) == 0u) { if (xb_ld(&bar[XB_TMO])) break; if (sp > XB_SPIN_CAP) { atomicAdd(&bar[XB_TMO], 1u); break; } }
    }
    nloc = mine > 0u ? mine : 1u; nx = cnt > 0u ? cnt : 1u;
}
__device__ __forceinline__ void xcd_barrier(const XcdBarrier& b) {
    asm volatile("s_waitcnt vmcnt(0)" ::: "memory");
    __syncthreads();
    if (threadIdx.x == 0) {
        unsigned* bar = b.bar;
        __builtin_amdgcn_s_waitcnt(0);
        unsigned nloc = b.st[0], nx = b.st[1];
        if (nloc == 0u) { xcd_barrier_complete(bar, b.x, nloc, nx); b.st[0] = nloc; b.st[1] = nx; }
        const unsigned old = xb_add(&bar[XB_XSUB(b.x)], 1u);
        const unsigned gen = old / nloc;
        if (old + 1u == (gen + 1u) * nloc) {
            __builtin_amdgcn_fence(__ATOMIC_RELEASE, "agent");
            asm volatile("s_waitcnt vmcnt(0)" ::: "memory");
            const unsigned og = xb_add(&bar[XB_TOP], 1u);
            const unsigned tg = og / nx;
            if (og + 1u == (tg + 1u) * nx) xb_add(&bar[XB_TOPGEN], 1u);
            else XB_SPIN(xb_ld(&bar[XB_TOPGEN]) == tg, bar);
            __builtin_amdgcn_fence(__ATOMIC_ACQUIRE, "agent");
            xb_add(&bar[XB_XGEN(b.x)], 1u);
            asm volatile("s_waitcnt vmcnt(0)" ::: "memory");
        } else {
            XB_SPIN(xb_ld(&bar[XB_XGEN(b.x)]) == gen, bar);
            __builtin_amdgcn_fence(__ATOMIC_ACQUIRE, "agent");
            asm volatile("s_waitcnt vmcnt(0)" ::: "memory");
        }
    }
    __syncthreads();
}

constexpr int BM = 256, BK = 64, HALF = 128, HT = HALF * BK;
__device__ __forceinline__ int lds_byte(int r, int c) { int st = (r >> 4) * 2 + (c >> 5), rr = r & 15, cc = c & 31, ob = rr * 64 + cc * 2; return st * 1024 + (ob ^ (((ob >> 9) & 1) << 5)); }
__device__ __forceinline__ void stage_rc(int b, int& R, int& C) { int st = b / 1024, sb = b % 1024, swz = sb ^ (((sb >> 9) & 1) << 5); R = (st >> 1) * 16 + swz / 64; C = (st & 1) * 32 + (swz % 64) / 2; }

template <class Epi>
__device__ __forceinline__ void gemm_tile(const bf16_t* __restrict__ A, const bf16_t* __restrict__ Bt, const int K, const int brow, const int bcol, bf16_t* shm, const Epi& epi) {
#define SA(b, h) (shm + ((b) * 2 + (h)) * HT)
#define SB(b, h) (shm + (4 + (b) * 2 + (h)) * HT)
#define STAGE_X(T, Pp, BASE, br, kt) do { long _g = (long)(br) * K + (long)(kt) * BK; \
    for (int _i = 0; _i < 2; ++_i) { int _b = (T) * 16 + _i * 8192; int _r, _c; stage_rc(_b, _r, _c); \
      __builtin_amdgcn_global_load_lds((const unsigned*)(BASE + _g + (long)_r * K + _c), (LAS unsigned*)((LAS char*)(Pp) + _b), 16, 0, 0); } } while (0)
#define STAGE(Pp, BASE, br, kt) STAGE_X(tx, Pp, BASE, br, kt)
#define LDA(dst, b, h) for (int m = 0; m < 4; ++m) for (int k = 0; k < 2; ++k) \
    dst[m][k] = *reinterpret_cast<const bf16x8*>((char*)SA(b, h) + lds_byte(wr * 64 + m * 16 + fr, k * 32 + fq * 8))
#define LDB(dst, b, h) for (int n = 0; n < 2; ++n) for (int k = 0; k < 2; ++k) \
    dst[n][k] = *reinterpret_cast<const bf16x8*>((char*)SB(b, h) + lds_byte(wc * 32 + n * 16 + fr, k * 32 + fq * 8))
#define MMA(ai, bj, At, Bt_) do { __builtin_amdgcn_s_setprio(1); \
    for (int m = 0; m < 4; ++m) for (int n = 0; n < 2; ++n) for (int k = 0; k < 2; ++k) \
      acc[ai][bj][m][n] = __builtin_amdgcn_mfma_f32_16x16x32_bf16(At[m][k], Bt_[n][k], acc[ai][bj][m][n], 0, 0, 0); \
    __builtin_amdgcn_s_setprio(0); } while (0)
#define WAIT_V(n) asm volatile("s_waitcnt vmcnt(" #n ")" ::: "memory")
#define WAIT_L(n) asm volatile("s_waitcnt lgkmcnt(" #n ")" ::: "memory")
#define BAR __builtin_amdgcn_s_barrier()
#define SCHED __builtin_amdgcn_sched_barrier(0)
    int tx = threadIdx.x; asm volatile("" : "+v"(tx));
    int wid = tx >> 6, lane = tx & 63, wr = wid >> 2, wc = wid & 3, fr = lane & 15, fq = lane >> 4;
    f32x4 acc[2][2][4][2] = {};
    bf16x8 At[4][2], B0[2][2], B1[2][2];
    const int nt = K / BK;
    STAGE(SB(0, 0), Bt, bcol, 0); STAGE(SA(0, 0), A, brow, 0);
    STAGE(SB(0, 1), Bt, bcol + HALF, 0); STAGE(SA(0, 1), A, brow + HALF, 0);
    if (wr == 1) BAR;
    WAIT_V(4); BAR;
    STAGE(SB(1, 0), Bt, bcol, 1); STAGE(SA(1, 0), A, brow, 1); STAGE(SB(1, 1), Bt, bcol + HALF, 1);
    WAIT_V(6); BAR;
    for (int t = 0; t < nt - 2; t += 2) {
        LDB(B0, 0, 0); SCHED; LDA(At, 0, 0); STAGE(SA(1, 1), A, brow + HALF, t + 1);
        WAIT_L(8); BAR; WAIT_L(0); MMA(0, 0, At, B0); BAR; SCHED;
        LDB(B1, 0, 1); STAGE(SB(0, 0), Bt, bcol, t + 2);
        BAR; WAIT_L(0); MMA(0, 1, At, B1); BAR;
        LDA(At, 0, 1); STAGE(SA(0, 0), A, brow, t + 2);
        BAR; WAIT_L(0); MMA(1, 0, At, B0); BAR; SCHED;
        STAGE(SB(0, 1), Bt, bcol + HALF, t + 2);
        WAIT_V(6); BAR; MMA(1, 1, At, B1); BAR;
        LDB(B0, 1, 0); SCHED; LDA(At, 1, 0); STAGE(SA(0, 1), A, brow + HALF, t + 2);
        WAIT_L(8); BAR; WAIT_L(0); MMA(0, 0, At, B0); BAR; SCHED;
        LDB(B1, 1, 1); STAGE(SB(1, 0), Bt, bcol, t + 3);
        BAR; WAIT_L(0); MMA(0, 1, At, B1); BAR;
        LDA(At, 1, 1); STAGE(SA(1, 0), A, brow, t + 3);
        BAR; WAIT_L(0); MMA(1, 0, At, B0); BAR; SCHED;
        STAGE(SB(1, 1), Bt, bcol + HALF, t + 3);
        WAIT_V(6); BAR; MMA(1, 1, At, B1); BAR;
    }
    int tz = threadIdx.x; asm volatile("" : "+v"(tz)); wid = tz >> 6; lane = tz & 63; wr = wid >> 2; wc = wid & 3; fr = lane & 15; fq = lane >> 4;
    { LDB(B0, 0, 0); WAIT_V(0); LDA(At, 0, 0); STAGE_X(tz, SA(1, 1), A, brow + HALF, nt - 1);
      BAR; WAIT_L(0); MMA(0, 0, At, B0); BAR;
      LDB(B1, 0, 1); BAR; WAIT_L(0); MMA(0, 1, At, B1); BAR;
      LDA(At, 0, 1); WAIT_V(4); BAR; WAIT_L(0); MMA(1, 0, At, B0); MMA(1, 1, At, B1); BAR; }
    { LDB(B0, 1, 0); LDA(At, 1, 0); WAIT_V(2); BAR; WAIT_L(0); MMA(0, 0, At, B0); BAR;
      LDB(B1, 1, 1); WAIT_V(0); BAR; WAIT_L(0); MMA(0, 1, At, B1); BAR;
      LDA(At, 1, 1); BAR; WAIT_L(0); MMA(1, 0, At, B0); MMA(1, 1, At, B1); BAR; }
    if (wr == 0) BAR;
#pragma unroll
    for (int ai = 0; ai < 2; ++ai)
#pragma unroll
        for (int bj = 0; bj < 2; ++bj)
#pragma unroll
            for (int m = 0; m < 4; ++m)
#pragma unroll
                for (int n = 0; n < 2; ++n)
#pragma unroll
                    for (int j = 0; j < 4; ++j) epi(brow + ai * HALF + wr * 64 + m * 16 + fq * 4 + j, bcol + bj * HALF + wc * 32 + n * 16 + fr, acc[ai][bj][m][n][j]);
    __syncthreads();
#undef SA
#undef SB
}


template <int NCB, class Epi>
__device__ __forceinline__ void gemm_rows8(const bf16_t* __restrict__ A, const bf16_t* __restrict__ Bt, int cu, unsigned char* lds, const Epi& epi) {
    int tid = threadIdx.x; asm volatile("" : "+v"(tid));
    const int wave = tid >> 6, lane = tid & 63, r16 = lane & 15, quad = lane >> 4, k0 = wave * 256;
    constexpr int NC = 16 * NCB;
    f32x4 acc[NCB];
#pragma unroll
    for (int cb = 0; cb < NCB; ++cb) acc[cb] = (f32x4){0.f, 0.f, 0.f, 0.f};
#pragma unroll
    for (int ks = 0; ks < 8; ++ks) {
        bf16x8 a = (bf16x8){0, 0, 0, 0, 0, 0, 0, 0};
        if (r16 < 8) a = *(const bf16x8*)(A + (size_t)r16 * 2048 + k0 + 32 * ks + 8 * quad);
#pragma unroll
        for (int cb = 0; cb < NCB; ++cb) { const bf16x8 b = *(const bf16x8*)(Bt + (size_t)(cu * NC + 16 * cb + r16) * 2048 + k0 + 32 * ks + 8 * quad); acc[cb] = MFMA16(a, b, acc[cb]); }
    }
    float* red = (float*)lds;
    if (quad < 2) {
#pragma unroll
        for (int cb = 0; cb < NCB; ++cb)
#pragma unroll
            for (int rg = 0; rg < 4; ++rg) red[(wave * 8 + 4 * quad + rg) * NC + 16 * cb + r16] = acc[cb][rg]; }
    __syncthreads();
    if (tid < 8 * NC) { const int row = tid / NC, col = tid % NC; float v = 0.f;
#pragma unroll
      for (int w = 0; w < 8; ++w) v += red[(w * 8 + row) * NC + col];
      epi(NP + row, cu * NC + col, v); }
    __syncthreads();
}
__device__ __forceinline__ void ph0_adaln(const Params& p, int u, float* smem) {
    float* sc = smem;
    float* red = smem + 12 * 2048;
    const int tid = threadIdx.x;
    for (int i = tid; i < 12 * 2048; i += NTHR) { const int r = i >> 11, k = i & 2047; const float c = r < 4 ? p.c_prompt[r * 2048 + k] : p.c_sample[(r - 4) * 2048 + k]; sc[i] = silu_f(c); }
    __syncthreads();
    const int col = u * 64 + (tid & 63), ks = tid >> 6;
    float a[12];
#pragma unroll
    for (int r = 0; r < 12; ++r) a[r] = 0.f;
    const float* w = p.w_ada + (size_t)(ks * 256) * 12288 + col;
#pragma unroll 1
    for (int k0 = 0; k0 < 256; k0 += 16) {
        float wv[16];
#pragma unroll
        for (int kk = 0; kk < 16; ++kk) wv[kk] = w[(size_t)(k0 + kk) * 12288];
#pragma unroll
        for (int kk = 0; kk < 16; ++kk)
#pragma unroll
            for (int r = 0; r < 12; ++r) a[r] += sc[r * 2048 + ks * 256 + k0 + kk] * wv[kk];
    }
#pragma unroll
    for (int r = 0; r < 12; ++r) red[(ks * 12 + r) * 64 + (tid & 63)] = a[r];
    __syncthreads();
    for (int i = tid; i < 12 * 64; i += NTHR) { const int r = i >> 6, c = i & 63; const int cc = u * 64 + c; float s = p.b_ada[cc];
#pragma unroll
        for (int k8 = 0; k8 < 8; ++k8) s += red[(k8 * 12 + r) * 64 + c];
        p.mod[r * 12288 + cc] = s; }
    __syncthreads();
}
__device__ __forceinline__ void ph0_transpose(const float* __restrict__ W, bf16_t* __restrict__ Wt, int Nreal, int ntn, int u, float* smem, int Kdim = 2048) {
    const int tk = u / ntn, tn = u % ntn, k0 = tk * 64, n0 = tn * 64, tid = threadIdx.x;
    for (int i = 0; i < 8; ++i) { const int idx = tid + NTHR * i, kk = idx >> 6, nn = idx & 63; smem[kk * 65 + nn] = (n0 + nn < Nreal) ? W[(size_t)(k0 + kk) * Nreal + n0 + nn] : 0.f; }
    __syncthreads();
    for (int i = 0; i < 8; ++i) { const int idx = tid + NTHR * i, nn = idx >> 6, kk = idx & 63; Wt[(size_t)(n0 + nn) * Kdim + k0 + kk] = f2bf(smem[kk * 65 + nn]); }
    __syncthreads();
}


__device__ __forceinline__ void ph0_cvt(const float* __restrict__ s, bf16_t* __restrict__ d, size_t u) {
    const size_t i = u * 4096 + (size_t)threadIdx.x * 8;
    const float4 a = *(const float4*)(s + i), b = *(const float4*)(s + i + 4);
    *(uint4*)(d + i) = make_uint4((unsigned)f2bf(a.x) | ((unsigned)f2bf(a.y) << 16), (unsigned)f2bf(a.z) | ((unsigned)f2bf(a.w) << 16), (unsigned)f2bf(b.x) | ((unsigned)f2bf(b.y) << 16), (unsigned)f2bf(b.z) | ((unsigned)f2bf(b.w) << 16));
}

__device__ __forceinline__ void ph0_fp8(const float* __restrict__ src, unsigned char* __restrict__ dst, float* __restrict__ scl, int u) {
    const int wave = threadIdx.x >> 6, lane = threadIdx.x & 63, r = u * 8 + wave;
    const float* s = src + (size_t)r * 2048 + lane * 16;
    float4 v[8]; float am = 0.f;
#pragma unroll
    for (int c = 0; c < 2; ++c)
#pragma unroll
        for (int k = 0; k < 4; ++k) { v[c * 4 + k] = *(const float4*)(s + c * 1024 + k * 4); const float4 t = v[c * 4 + k];
            am = fmaxf(am, fmaxf(fmaxf(fabsf(t.x), fabsf(t.y)), fmaxf(fabsf(t.z), fabsf(t.w)))); }
    am = wave_max(am);
    const float sc = fmaxf(am, 1e-30f) * (1.f / 440.f), inv = 1.f / sc;
#pragma unroll
    for (int c = 0; c < 2; ++c) { u32x4 w;
#pragma unroll
        for (int k = 0; k < 4; ++k) { const float4 t = v[c * 4 + k]; int pk = 0; pk = __builtin_amdgcn_cvt_pk_fp8_f32(t.x * inv, t.y * inv, pk, false); pk = __builtin_amdgcn_cvt_pk_fp8_f32(t.z * inv, t.w * inv, pk, true); w[k] = (unsigned)pk; }
        *(u32x4*)(dst + (size_t)(c * 8 + (lane >> 3)) * (16384 * 128) + (size_t)r * 128 + (lane & 7) * 16) = w; }
    if (lane == 0) scl[r] = sc;
}
__device__ __forceinline__ void ph0_keys(const Params& p, int u) {
    for (int k = 0; k < 8; ++k) { const int i = u * 4096 + threadIdx.x * 8 + k; const float x = p.peer_keys[i]; const bf16_t h = f2bf(x); p.kh[i] = h; p.kl[i] = f2bf(x - __uint_as_float((unsigned)h << 16)); }
}
template <int WHICH>
__device__ __forceinline__ void norm_row(const Params& p, int row) {
    const int lane = threadIdx.x & 63;
    bf16_t* dst = (WHICH == 0 ? p.h1 : p.h2) + (size_t)row * 2048;
    if (row >= NTOK) { for (int i = 0; i < 8; ++i) { const int c = i * 256 + lane * 4; *(uint2*)(dst + c) = make_uint2(0u, 0u); } return; }
    const int mrow = row < NP ? row / SEQ : 4 + (row - NP);
    const float* xr = row < NP ? p.x_prompt + (size_t)row * 2048 : p.x_sample + (size_t)(row - NP) * 2048;
    const float* mod = p.mod + (size_t)mrow * 12288;
    const float* nw = WHICH == 0 ? p.norm_mix : p.norm_ffn;
    float4 v[8]; float ss = 0.f;
#pragma unroll
    for (int i = 0; i < 8; ++i) { const int c = i * 256 + lane * 4; v[i] = *(const float4*)(xr + c);
        if (WHICH == 1) { const float4 a = *(const float4*)(p.acc2 + (size_t)row * 2048 + c); const float4 g = *(const float4*)(mod + 4096 + c);
            v[i].x += g.x * a.x; v[i].y += g.y * a.y; v[i].z += g.z * a.z; v[i].w += g.w * a.w; *(float4*)(p.x1 + (size_t)row * 2048 + c) = v[i]; }
        ss += v[i].x * v[i].x + v[i].y * v[i].y + v[i].z * v[i].z + v[i].w * v[i].w; }
    ss = wave_sum(ss);
    const float rstd = rsqrtf(ss * (1.f / 2048.f) + 1e-6f);
    const int osh = WHICH == 0 ? 0 : 6144, osc = WHICH == 0 ? 2048 : 8192;
#pragma unroll
    for (int i = 0; i < 8; ++i) { const int c = i * 256 + lane * 4;
        const float4 w = *(const float4*)(nw + c), sc = *(const float4*)(mod + osc + c), sh = *(const float4*)(mod + osh + c);
        float4 h; h.x = v[i].x * rstd * w.x * (1.f + sc.x) + sh.x; h.y = v[i].y * rstd * w.y * (1.f + sc.y) + sh.y; h.z = v[i].z * rstd * w.z * (1.f + sc.z) + sh.z; h.w = v[i].w * rstd * w.w * (1.f + sc.w) + sh.w;
        uint2 pk; pk.x = (unsigned)f2bf(h.x) | ((unsigned)f2bf(h.y) << 16); pk.y = (unsigned)f2bf(h.z) | ((unsigned)f2bf(h.w) << 16);
        *(uint2*)(dst + c) = pk;
        if (WHICH == 1) {
            int q8 = 0; q8 = __builtin_amdgcn_cvt_pk_fp8_f32(h.x, h.y, q8, false); q8 = __builtin_amdgcn_cvt_pk_fp8_f32(h.z, h.w, q8, true); *(int*)(p.h2q + (size_t)row * 2048 + c) = q8; } }
}

__device__ __forceinline__ void ph3_scatter(const Params& p, int u) {
    const int tid = threadIdx.x;
    if (u >= NSB) { const int b = (u - NSB) / 3, i = (u - NSB) % 3; const float* Pr = p.P + (size_t)(b * SEQ + SEQ - 3 + i) * INCP;
        for (int c = tid; c < 3072; c += NTHR) p.out[O_CVP + ((size_t)b * 3 + i) * 3072 + c] = Pr[C_QKV + c];
        return; }
    const int b = u, row = NP + b;
    const float* Pr = p.P + (size_t)row * INCP;
    { const int c = tid * 2; *(unsigned*)(p.Qb + (size_t)row * 1024 + c) = (unsigned)f2bf(Pr[C_Q + c]) | ((unsigned)f2bf(Pr[C_Q + c + 1]) << 16);
      *(unsigned*)(p.KVb + (size_t)row * 1024 + c) = (unsigned)f2bf(Pr[C_KVS + c]) | ((unsigned)f2bf(Pr[C_KVS + c + 1]) << 16); }
    p.out[O_CKS + b * 512 + tid] = Pr[C_KVC + tid];
    p.out[O_SKS + b * 512 + tid] = Pr[C_KVS + tid];
    p.out[O_WKS + ((size_t)b * 512 + 511) * 512 + tid] = Pr[C_KVW + tid];
    for (int i = 0; i < 3; ++i) for (int c = tid; c < 3072; c += NTHR) p.out[O_CVS + ((size_t)b * 3 + i) * 3072 + c] = i < 2 ? p.state_conv[((size_t)b * 3 + i + 1) * 3072 + c] : Pr[C_QKV + c];
}
constexpr int CP_A = 0, CP_B = 34816, CP_H = 69632;
template <bool SMP>
__device__ __forceinline__ void cmp_tile(const Params& p, int tile, int s, unsigned char* lds) {
    int tid = threadIdx.x; asm volatile("" : "+v"(tid));
    const int wave = tid >> 6, lane = tid & 63, r16 = lane & 15, quad = lane >> 4, wr = wave >> 1, wc = wave & 1;
    const int NC = SMP ? 512 : 64, STR = 512;
    const float* abase[8];
#pragma unroll
    for (int i = 0; i < 8; ++i) { const int id = tid + 512 * i, R = tile * 128 + (id >> 5), part = id & 31;
        const int h = R & 1, n = (R >> 1) & (NC - 1), b = R / (2 * NC);
        if (SMP) abase[i] = p.cache_cmp + ((size_t)p.page_table[b * NPAGES + (n >> 2)] * 128 + (n & 3) * 32) * 512 + s * 256 + h * 128 + part * 4;
        else abase[i] = p.out + O_CKP + (size_t)(b * SEQ + n * 32) * 512 + s * 256 + h * 128 + part * 4; }
    const float* pe = p.cmp_pe + (size_t)s * 4096 + ((tid & 31) * 4);
    const bf16_t* bsrc[4];
#pragma unroll
    for (int i = 0; i < 4; ++i) { const int id = tid + 512 * i; bsrc[i] = p.w1t + ((size_t)s * 128 + (id >> 4)) * 4096 + (id & 15) * 8; }
    float4 av[8]; u32x4 bv[4];
#pragma unroll
    for (int i = 0; i < 8; ++i) av[i] = *(const float4*)(abase[i]);
#pragma unroll
    for (int i = 0; i < 4; ++i) bv[i] = *(const u32x4*)(bsrc[i]);
    f32x4 acc[2][4];
#pragma unroll
    for (int a = 0; a < 2; ++a) for (int c = 0; c < 4; ++c) acc[a][c] = (f32x4){0.f, 0.f, 0.f, 0.f};
    unsigned char* Ab = lds + CP_A; unsigned char* Bb = lds + CP_B;
#pragma unroll 1
    for (int l = 0; l < 32; ++l) {
        { const float4 pv = *(const float4*)(pe + l * 128);
#pragma unroll
          for (int i = 0; i < 8; ++i) { const int id = tid + 512 * i; uint2 w; w.x = pk2(av[i].x + pv.x, av[i].y + pv.y); w.y = pk2(av[i].z + pv.z, av[i].w + pv.w);
              *(uint2*)(Ab + (id >> 5) * 272 + (id & 31) * 8) = w; } }
#pragma unroll
        for (int i = 0; i < 4; ++i) { const int id = tid + 512 * i; *(u32x4*)(Bb + (id >> 4) * 272 + (id & 15) * 16) = bv[i]; }
        __syncthreads();
        if (l + 1 < 32) {
#pragma unroll
            for (int i = 0; i < 8; ++i) av[i] = *(const float4*)(abase[i] + (size_t)(l + 1) * STR);
#pragma unroll
            for (int i = 0; i < 4; ++i) bv[i] = *(const u32x4*)(bsrc[i] + (l + 1) * 128); }
#pragma unroll
        for (int ks = 0; ks < 4; ++ks) { bf16x8 a[2], b[4];
#pragma unroll
            for (int rb = 0; rb < 2; ++rb) a[rb] = *(const bf16x8*)(Ab + (32 * wr + 16 * rb + r16) * 272 + (32 * ks + 8 * quad) * 2);
#pragma unroll
            for (int cb = 0; cb < 4; ++cb) b[cb] = *(const bf16x8*)(Bb + (64 * wc + 16 * cb + r16) * 272 + (32 * ks + 8 * quad) * 2);
#pragma unroll
            for (int rb = 0; rb < 2; ++rb)
#pragma unroll
                for (int cb = 0; cb < 4; ++cb) acc[rb][cb] = MFMA16(a[rb], b[cb], acc[rb][cb]); }
        __syncthreads();
    }
    unsigned char* H = lds + CP_H;
#pragma unroll
    for (int rb = 0; rb < 2; ++rb)
#pragma unroll
        for (int cb = 0; cb < 4; ++cb) { const int e = 64 * wc + 16 * cb + r16; const float b1 = p.cmp_b1[s * 128 + e];
#pragma unroll
            for (int rg = 0; rg < 4; ++rg) *(bf16_t*)(H + (32 * wr + 16 * rb + 4 * quad + rg) * 272 + e * 2) = f2bf(gelu_tanh(acc[rb][cb][rg] + b1)); }
    __syncthreads();
    float* dst = SMP ? p.ckv_s : p.ckv_p;
#pragma unroll
    for (int rb = 0; rb < 2; ++rb)
#pragma unroll
        for (int cb = 0; cb < 4; ++cb) { f32x4 o = (f32x4){0.f, 0.f, 0.f, 0.f}; const int d = 64 * wc + 16 * cb + r16;
#pragma unroll
            for (int ks = 0; ks < 4; ++ks) { const bf16x8 a = *(const bf16x8*)(H + (32 * wr + 16 * rb + r16) * 272 + (32 * ks + 8 * quad) * 2);
                const bf16x8 b = *(const bf16x8*)(p.w2t + ((size_t)s * 128 + d) * 128 + 32 * ks + 8 * quad); o = MFMA16(a, b, o); }
#pragma unroll
            for (int rg = 0; rg < 4; ++rg) { const int R = tile * 128 + 32 * wr + 16 * rb + 4 * quad + rg; const int h = R & 1, n = (R >> 1) & (NC - 1), b = R / (2 * NC);
                dst[((((size_t)b * NC + n) * 2 + s) * 2 + h) * 128 + d] = o[rg]; } }
    __syncthreads();
}
__device__ __forceinline__ void ph3_gdnprep(const Params& p, int row, float* smem) {
    float* cv = smem;
    const int tid = threadIdx.x;
    const float* Pr = p.P + (size_t)row * INCP;
    for (int c = tid; c < 3072; c += NTHR) {
        float acc = 0.f;
        if (row < NP) { const int t = row % SEQ;
#pragma unroll
            for (int i = 0; i < 4; ++i) { const int tt = t - 3 + i; if (tt >= 0) acc += p.P[(size_t)(row - 3 + i) * INCP + C_QKV + c] * p.conv_w[i * 3072 + c]; } }
        else { const int b = row - NP;
#pragma unroll
            for (int i = 0; i < 3; ++i) acc += p.state_conv[((size_t)b * 3 + i) * 3072 + c] * p.conv_w[i * 3072 + c];
            acc += Pr[C_QKV + c] * p.conv_w[3 * 3072 + c]; }
        cv[c] = silu_f(acc);
    }
    __syncthreads();
    const int wave = tid >> 6, lane = tid & 63;
    for (int hh = wave; hh < 16; hh += 8) {
        const float a = cv[hh * 128 + lane], b2 = cv[hh * 128 + 64 + lane];
        const float ss = wave_sum(a * a + b2 * b2);
        float r = rsqrtf(ss + 1e-6f); if (hh < 8) r *= 0.08838834764831845f;
        p.qkvn[(size_t)row * 3072 + hh * 128 + lane] = a * r; p.qkvn[(size_t)row * 3072 + hh * 128 + 64 + lane] = b2 * r;
    }
    for (int c = tid; c < 1024; c += NTHR) p.qkvn[(size_t)row * 3072 + 2048 + c] = cv[2048 + c];
    if (tid < 8) { p.gbeta[row * 8 + tid] = sigmoid_f(Pr[C_BL + tid]); p.gg[row * 8 + tid] = -__expf(p.a_log[tid]) * softplus_f(Pr[C_AL + tid] + p.dt_bias[tid]); }
    __syncthreads();
}

template <int BR, bool SMP>
__device__ __forceinline__ void nsa_key(const Params& p, int b, int tpos, int kvh, int j, const int* sel, int& pos, bool& valid, const float*& kp, const float*& vp) {
    if (BR == 0) {
        const int NC = SMP ? 512 : 64; pos = 32 * j + 31; valid = pos <= tpos;
        const float* base = (SMP ? p.ckv_s : p.ckv_p) + (((size_t)b * NC + j) * 4) * 128; kp = base + kvh * 128; vp = base + (2 + kvh) * 128;
    } else if (BR == 1) {
        const int blk = sel[j >> 6]; pos = blk * 64 + (j & 63); valid = pos <= tpos;
        const float* base;
        if (!SMP) base = p.P + (size_t)(b * SEQ + (valid ? pos : 0)) * INCP + C_KVS;
        else if (pos < PAST) base = p.cache_sel + ((size_t)p.page_table[b * NPAGES + (pos >> 7)] * 128 + (pos & 127)) * 512;
        else base = p.P + (size_t)(NP + b) * INCP + C_KVS;
        kp = base + kvh * 128; vp = base + 256 + kvh * 128;
    } else {
        const float* base;
        if (!SMP) { pos = tpos - 511 + j; valid = pos >= 0; base = p.P + (size_t)(b * SEQ + (valid ? pos : 0)) * INCP + C_KVW; }
        else { const int jj = j + 1; pos = PAST - 512 + jj; valid = true; base = jj < 512 ? p.state_win + ((size_t)b * 512 + jj) * 512 : p.P + (size_t)(NP + b) * INCP + C_KVW; }
        kp = base + kvh * 128; vp = base + 256 + kvh * 128;
    }
}
template <int BR, bool SMP>
__device__ __forceinline__ void nsa_branch(const Params& p, int b, int tpos, int kvh, int nkeys, const int* sel, const float* myq, float* mysc, float slope, int lane, float& r0, float& r1) {
    const float scale = 0.08838834764831845f;
    float mloc = -1e30f;
    for (int j0 = 0; j0 < nkeys; j0 += 64) {
        const int j = j0 + lane; float s = -1e30f;
        if (j < nkeys) {
            int pos; bool valid; const float *kp, *vp; nsa_key<BR, SMP>(p, b, tpos, kvh, j, sel, pos, valid, kp, vp);
            if (valid) { float dot = 0.f;
                for (int d = 0; d < 128; d += 4) { const float4 kv = *(const float4*)(kp + d); dot += myq[d] * kv.x + myq[d + 1] * kv.y + myq[d + 2] * kv.z + myq[d + 3] * kv.w; }
                s = dot * scale - slope * (float)(tpos - pos); }
            mysc[j] = s;
        }
        mloc = fmaxf(mloc, s);
    }
    const float m = wave_max(mloc);
    float lsum = 0.f;
    for (int j0 = 0; j0 < nkeys; j0 += 64) { const int j = j0 + lane; if (j < nkeys) { const float s = mysc[j]; const float e = s > -1e29f ? __expf(s - m) : 0.f; mysc[j] = e; lsum += e; } }
    const float l = wave_sum(lsum);
    const float linv = l > 0.f ? 1.f / l : 0.f;
    for (int j0 = 0; j0 < nkeys; j0 += 64) { const int j = j0 + lane; if (j < nkeys) mysc[j] *= linv; }
    float a0 = 0.f, a1 = 0.f;
    for (int j = 0; j < nkeys; ++j) {
        const float pj = mysc[j];
        if (pj != 0.f) { int pos; bool valid; const float *kp, *vp; nsa_key<BR, SMP>(p, b, tpos, kvh, j, sel, pos, valid, kp, vp);
            const float2 vv = *(const float2*)(vp + 2 * lane); a0 += pj * vv.x; a1 += pj * vv.y; }
    }
    r0 = a0; r1 = a1;
}
template <bool SMP>
__device__ __forceinline__ void ph4_nsa(const Params& p, int b, int t, float* smem) {
    float* q_s = smem;
    float* sc = smem + 1024;
    int* sel_s = (int*)(sc + 8 * 1024);
    const int tid = threadIdx.x, wave = tid >> 6, lane = tid & 63, hd = wave, kvh = wave >> 2;
    const int row = SMP ? NP + b : b * SEQ + t, tpos = SMP ? PAST : t;
    const float* Pr = p.P + (size_t)row * INCP;
    for (int i = tid; i < 1024; i += NTHR) q_s[i] = Pr[C_Q + i];
    __syncthreads();
    const float slope = exp2f(-(float)(hd + 1));
    float* mysc = sc + wave * 1024; const float* myq = q_s + hd * 128;
    const int NC = SMP ? 512 : 64;
    float c0, c1, s0, s1, w0, w1;
    nsa_branch<0, SMP>(p, b, tpos, kvh, NC, nullptr, myq, mysc, slope, lane, c0, c1);
    __syncthreads();
    const int cur = tpos >> 6, ncand = cur + 1, nsel = ncand < 16 ? ncand : 16;
    if ((wave & 3) == 0) {
        float val[5];
#pragma unroll
        for (int i = 0; i < 5; ++i) { const int blk = lane + 64 * i; float v = -INFINITY;
            if (blk < ncand) { const bool forced = blk == 0 || blk == cur || blk == cur - 1; float imp = 0.f;
                if (!forced) { for (int g = 0; g < 4; ++g) { const float* ps = sc + (kvh * 4 + g) * 1024; if (2 * blk < NC) imp += ps[2 * blk]; if (2 * blk + 1 < NC) imp += ps[2 * blk + 1]; } }
                v = forced ? 1e4f : imp; }
            val[i] = v; }
        for (int r = 0; r < nsel; ++r) {
            float bv = val[0]; int bi = lane;
#pragma unroll
            for (int i = 1; i < 5; ++i) if (val[i] > bv) { bv = val[i]; bi = lane + 64 * i; }
            for (int o = 32; o > 0; o >>= 1) { const float ov = __shfl_xor(bv, o); const int oi = __shfl_xor(bi, o); if (ov > bv || (ov == bv && oi < bi)) { bv = ov; bi = oi; } }
            if (lane == 0) sel_s[kvh * 16 + r] = bi;
#pragma unroll
            for (int i = 0; i < 5; ++i) if (lane + 64 * i == bi) val[i] = -INFINITY;
        }
    }
    __syncthreads();
    nsa_branch<1, SMP>(p, b, tpos, kvh, nsel * 64, sel_s + kvh * 16, myq, mysc, slope, lane, s0, s1);
    nsa_branch<2, SMP>(p, b, tpos, kvh, 512, nullptr, myq, mysc, slope, lane, w0, w1);
    const float g0 = sigmoid_f(Pr[C_GTS + hd * 3 + 0]), g1 = sigmoid_f(Pr[C_GTS + hd * 3 + 1]), g2 = sigmoid_f(Pr[C_GTS + hd * 3 + 2]);
    const float o0 = g0 * c0 + g1 * s0 + g2 * w0, o1 = g0 * c1 + g1 * s1 + g2 * w1;
    *(unsigned*)(p.amix + (size_t)row * 2048 + hd * 128 + 2 * lane) = (unsigned)f2bf(o0) | ((unsigned)f2bf(o1) << 16);
    __syncthreads();
}

constexpr int NSA_KT0 = 0, NSA_VS0 = 17408, NSA_KT1 = 37888, NSA_VS1 = 55296, NSA_IMP = 75776, NSA_SELM = NSA_IMP + 4 * 64 * 33 * 4, NSA_UNI = NSA_SELM + 256;
typedef short s16x4 __attribute__((ext_vector_type(4)));
__device__ __forceinline__ bf16x8 pack8(float x0, float x1, float x2, float x3, float x4, float x5, float x6, float x7) {
    u32x4 p;
    asm volatile("v_cvt_pk_bf16_f32 %0, %4, %5\n\tv_cvt_pk_bf16_f32 %1, %6, %7\n\tv_cvt_pk_bf16_f32 %2, %8, %9\n\tv_cvt_pk_bf16_f32 %3, %10, %11\n\ts_nop 1"
                 : "=&v"(p[0]), "=&v"(p[1]), "=&v"(p[2]), "=&v"(p[3]) : "v"(x0), "v"(x1), "v"(x2), "v"(x3), "v"(x4), "v"(x5), "v"(x6), "v"(x7));
    return __builtin_bit_cast(bf16x8, p);
}
__device__ __forceinline__ void nsa_fetch(const bf16_t* kbase, const bf16_t* vbase, int rs, int tid, uint4 (&kr)[2], uint4 (&vr)[2]) {
#pragma unroll
    for (int u = 0; u < 2; ++u) { const int c = tid + 512 * u; kr[u] = *(const uint4*)(kbase + (size_t)(c >> 4) * rs + (c & 15) * 8); vr[u] = *(const uint4*)(vbase + (size_t)(c >> 4) * rs + (c & 15) * 8); }
}
__device__ __forceinline__ void nsa_store(unsigned char* Kt, unsigned char* Vs, int tid, const uint4 (&kr)[2], const uint4 (&vr)[2]) {
#pragma unroll
    for (int u = 0; u < 2; ++u) { const int c = tid + 512 * u; *(uint4*)(Kt + (c >> 4) * 272 + (c & 15) * 16) = kr[u]; *(uint4*)(Vs + (c >> 4) * 320 + (c & 15) * 16) = vr[u]; }
}
template <int MODE>
__device__ __forceinline__ void nsa_tile(const unsigned char* Kt, const unsigned char* Vt, const bf16x8 (&qf)[8], int lane, int kb0, int t, float scl, float slp, bool sel, int edge,
                                         float& m, float& l, f32x16 (&O)[4], f32x16 (&S)[2], bf16x8 (&pf)[4]) {
    const int ql = lane & 31, h = lane >> 5;
#pragma unroll
    for (int b2 = 0; b2 < 2; ++b2) {
        f32x16 acc; for (int r = 0; r < 16; ++r) acc[r] = 0.f;
        bf16x8 kf[8];
#pragma unroll
        for (int s = 0; s < 8; ++s) kf[s] = *(const bf16x8*)(Kt + (32 * b2 + ql) * 272 + (16 * s + 8 * h) * 2);
#pragma unroll
        for (int s = 0; s < 8; ++s) acc = MFMA32(kf[s], qf[s], acc);
        S[b2] = acc;
    }
    float tmax = -1e30f;
    const int KS = MODE == 0 ? 32 : 1;
    const int d0 = MODE == 0 ? t - 31 - 128 * h : t - kb0 - 4 * h;
    const float nb0 = -slp * (float)d0, slk = slp * (float)KS;
#pragma unroll
    for (int b2 = 0; b2 < 2; ++b2)
#pragma unroll
        for (int r = 0; r < 16; ++r) {
            const int c = 32 * b2 + 8 * (r >> 2) + (r & 3);
            bool valid;
            if (MODE == 0) valid = d0 >= KS * c;
            else if (MODE == 1) valid = sel && (!(edge & 1) || d0 >= c);
            else valid = (!(edge & 1) || d0 >= c) && (!(edge & 2) || d0 < 512 + c);
            const float sc = __builtin_fmaf(S[b2][r], scl, __builtin_fmaf(slk, (float)c, nb0));
            const float sv = valid ? sc : -1e30f;
            S[b2][r] = sv; tmax = fmaxf(tmax, sv);
        }
    tmax = fmaxf(tmax, __shfl_xor(tmax, 32));
    const float mn = fmaxf(m, tmax);
    const float alpha = __builtin_amdgcn_exp2f(m - mn);
    m = mn;
    if (!__all(alpha == 1.f)) {
        l *= alpha;
#pragma unroll
        for (int d = 0; d < 4; ++d)
#pragma unroll
            for (int r = 0; r < 16; ++r) O[d][r] *= alpha;
    }
    float ls = 0.f;
#pragma unroll
    for (int b2 = 0; b2 < 2; ++b2)
#pragma unroll
        for (int r = 0; r < 16; ++r) { const float sv = S[b2][r]; const float pv = sv > -1e29f ? __builtin_amdgcn_exp2f(sv - mn) : 0.f; S[b2][r] = pv; ls += pv; }
    l += ls;
#pragma unroll
    for (int ks = 0; ks < 4; ++ks) { const int b2 = ks >> 1, s = ks & 1;
        pf[ks] = pack8(S[b2][8 * s], S[b2][8 * s + 1], S[b2][8 * s + 2], S[b2][8 * s + 3], S[b2][8 * s + 4], S[b2][8 * s + 5], S[b2][8 * s + 6], S[b2][8 * s + 7]); }
}
__device__ __forceinline__ void nsa_pv(const unsigned char* Vs, int lane, f32x16 (&O)[4], const bf16x8 (&pf)[4]) {
    const int g = lane >> 4, i16 = lane & 15, h = g >> 1;
    const unsigned char* vb = Vs + (4 * h + (i16 >> 2)) * 320 + (16 * (g & 1) + 4 * (i16 & 3)) * 2;
#pragma unroll
    for (int d = 0; d < 4; ++d) {
        s16x4 lo[4], hi[4];
#pragma unroll
        for (int ks = 0; ks < 4; ++ks) { lo[ks] = __builtin_amdgcn_ds_read_tr16_b64_v4i16((LAS s16x4*)(vb + (16 * ks) * 320 + 64 * d)); hi[ks] = __builtin_amdgcn_ds_read_tr16_b64_v4i16((LAS s16x4*)(vb + (16 * ks + 8) * 320 + 64 * d)); }
#pragma unroll
        for (int ks = 0; ks < 4; ++ks) { const bf16x8 av = __builtin_shufflevector(lo[ks], hi[ks], 0, 1, 2, 3, 4, 5, 6, 7); O[d] = MFMA32(av, pf[ks], O[d]); }
    }
}
template <bool FIRST>
__device__ __forceinline__ void nsa_flush(bf16_t* orow, int h, float f, f32x16 (&O)[4]) {
#pragma unroll
    for (int d = 0; d < 4; ++d)
#pragma unroll
        for (int rg = 0; rg < 4; ++rg) {
            uint2* dst = (uint2*)(orow + 32 * d + 8 * rg + 4 * h);
            float a0 = O[d][4 * rg] * f, a1 = O[d][4 * rg + 1] * f, a2 = O[d][4 * rg + 2] * f, a3 = O[d][4 * rg + 3] * f;
            if (!FIRST) { const uint2 old = *dst; a0 += __uint_as_float(old.x << 16); a1 += __uint_as_float(old.x & 0xffff0000u); a2 += __uint_as_float(old.y << 16); a3 += __uint_as_float(old.y & 0xffff0000u); }
            uint2 w; w.x = pk2(a0, a1); w.y = pk2(a2, a3); *dst = w;
            O[d][4 * rg] = 0.f; O[d][4 * rg + 1] = 0.f; O[d][4 * rg + 2] = 0.f; O[d][4 * rg + 3] = 0.f;
        }
}
__device__ __forceinline__ void ph4_nsa_fast(const Params& p, int u, unsigned char* lds) {
    int tid = threadIdx.x; asm volatile("" : "+v"(tid));
    const int wave = tid >> 6, lane = tid & 63, ql = lane & 31;
    const int i = 31 - (u >> 3), b = (u & 7) >> 1, kvh = u & 1;
    const int g = wave >> 1, qh = wave & 1, hd = kvh * 4 + g;
    const int t = i * 64 + qh * 32 + ql;
    const size_t row = (size_t)b * SEQ + t;
    float* imp = (float*)(lds + NSA_IMP); unsigned* selm = (unsigned*)(lds + NSA_SELM); unsigned* uni = (unsigned*)(lds + NSA_UNI);
    bf16x8 qf[8];
    { const bf16_t* qrow = p.Qb + row * 1024 + hd * 128 + 8 * (lane >> 5);
#pragma unroll
      for (int s = 0; s < 8; ++s) qf[s] = *(const bf16x8*)(qrow + 16 * s); }
    const float LOG2E = 1.4426950408889634f;
    const float scl = 0.08838834764831845f * LOG2E, slp = exp2f(-(float)(hd + 1)) * LOG2E;
    const float* Pr = p.P + row * INCP;
    const float g0 = sigmoid_f(Pr[C_GTS + hd * 3 + 0]), g1 = sigmoid_f(Pr[C_GTS + hd * 3 + 1]), g2 = sigmoid_f(Pr[C_GTS + hd * 3 + 2]);
    f32x16 O[4], S[2];
#pragma unroll
    for (int d = 0; d < 4; ++d) for (int r = 0; r < 16; ++r) O[d][r] = 0.f;
    bf16_t* orow = p.amix + row * 2048 + hd * 128;
    uint4 kr[2], vr[2];
    if (wave >= 4) __builtin_amdgcn_s_setprio(1);
    int cnt = 0;
#define KT(k) (lds + (((k) & 1) ? NSA_KT1 : NSA_KT0))
#define VS(k) (lds + (((k) & 1) ? NSA_VS1 : NSA_VS0))
    {
        const float* cb = p.ckv_p + (size_t)b * 64 * 512;
#pragma unroll
        for (int uu = 0; uu < 2; ++uu) { const int c = tid + 512 * uu, n = c >> 4, part = c & 15;
            const float4 a = *(const float4*)(cb + (size_t)n * 512 + kvh * 128 + part * 8), bq = *(const float4*)(cb + (size_t)n * 512 + kvh * 128 + part * 8 + 4);
            kr[uu] = make_uint4(pk2(a.x, a.y), pk2(a.z, a.w), pk2(bq.x, bq.y), pk2(bq.z, bq.w));
            const float4 c4 = *(const float4*)(cb + (size_t)n * 512 + 256 + kvh * 128 + part * 8), d4 = *(const float4*)(cb + (size_t)n * 512 + 256 + kvh * 128 + part * 8 + 4);
            vr[uu] = make_uint4(pk2(c4.x, c4.y), pk2(c4.z, c4.w), pk2(d4.x, d4.y), pk2(d4.z, d4.w)); }
        nsa_store(KT(cnt), VS(cnt), tid, kr, vr);
        __syncthreads();
        float m = -1e30f, l = 0.f;
        bf16x8 pf[4];
        nsa_tile<0>(KT(cnt), nullptr, qf, lane, 0, t, scl, slp, true, 0, m, l, O, S, pf);
        nsa_pv(VS(cnt), lane, O, pf);
        ++cnt;
        const float lt = l + __shfl_xor(l, 32);
        const float linv = lt > 0.f ? 1.f / lt : 0.f;
        float* ip = imp + (size_t)(g * 64 + qh * 32 + ql) * 33;
#pragma unroll
        for (int b2 = 0; b2 < 2; ++b2)
#pragma unroll
            for (int r = 0; r < 16; r += 2) { const int ko = 32 * b2 + 8 * (r >> 2) + 4 * (lane >> 5) + (r & 3); ip[ko >> 1] = (S[b2][r] + S[b2][r + 1]) * linv; }
        nsa_flush<true>(orow, lane >> 5, g0 * linv, O);
    }
    __syncthreads();
    {
        const int qq = tid >> 3, sub = tid & 7, ncand = i + 1;
        unsigned mask;
        if (ncand <= 16) mask = (1u << ncand) - 1u;
        else {
            float val[4];
#pragma unroll
            for (int c = 0; c < 4; ++c) { const int blk = sub + 8 * c; float v = -INFINITY;
                if (blk < ncand) { const bool forced = blk == 0 || blk == i || blk == i - 1;
                    v = forced ? 1e4f : imp[(0 * 64 + qq) * 33 + blk] + imp[(1 * 64 + qq) * 33 + blk] + imp[(2 * 64 + qq) * 33 + blk] + imp[(3 * 64 + qq) * 33 + blk]; }
                val[c] = v; }
            mask = 0u;
            for (int r = 0; r < 16; ++r) {
                float bv = val[0]; int bi = sub;
#pragma unroll
                for (int c = 1; c < 4; ++c) if (val[c] > bv) { bv = val[c]; bi = sub + 8 * c; }
#pragma unroll
                for (int o = 4; o > 0; o >>= 1) { const float ov = __shfl_xor(bv, o); const int oi = __shfl_xor(bi, o); if (ov > bv || (ov == bv && oi < bi)) { bv = ov; bi = oi; } }
                mask |= 1u << bi;
#pragma unroll
                for (int c = 0; c < 4; ++c) if (sub + 8 * c == bi) val[c] = -INFINITY;
            }
        }
        if (sub == 0) selm[qq] = mask;
    }
    __syncthreads();
    if (wave == 0) { unsigned um = selm[lane]; for (int o = 32; o > 0; o >>= 1) um |= __shfl_xor(um, o); if (lane == 0) uni[0] = um; }
    __syncthreads();
    const unsigned mymask = selm[qh * 32 + ql], umask = uni[0];
    {
        const bf16_t* kvb = p.KVb + (size_t)b * SEQ * 1024 + kvh * 128;
        float m = -1e30f, l = 0.f;
        int j = i;
        nsa_fetch(kvb + (size_t)j * 64 * 1024, kvb + (size_t)j * 64 * 1024 + 256, 1024, tid, kr, vr);
        nsa_store(KT(cnt), VS(cnt), tid, kr, vr);
        __syncthreads();
        while (j >= 0) {
            int jn = j - 1; while (jn >= 0 && !((umask >> jn) & 1u)) --jn;
            const bool sel = (mymask >> j) & 1u; const bool any = __any(sel);
            bf16x8 pf[4];
            if (any) nsa_tile<1>(KT(cnt), nullptr, qf, lane, j * 64, t, scl, slp, sel, j == i ? 1 : 0, m, l, O, S, pf);
            if (jn >= 0) nsa_fetch(kvb + (size_t)jn * 64 * 1024, kvb + (size_t)jn * 64 * 1024 + 256, 1024, tid, kr, vr);
            if (any) nsa_pv(VS(cnt), lane, O, pf);
            ++cnt;
            if (jn >= 0) nsa_store(KT(cnt), VS(cnt), tid, kr, vr);
            __syncthreads();
            j = jn;
        }
        const float lt = l + __shfl_xor(l, 32);
        nsa_flush<false>(orow, lane >> 5, lt > 0.f ? g1 / lt : 0.f, O);
    }
    {
        const bf16_t* kvb = p.KVb + (size_t)b * SEQ * 1024 + 512 + kvh * 128;
        float m = -1e30f, l = 0.f;
        const int jlo = i - 8 < 0 ? 0 : i - 8;
        int j = i;
        nsa_fetch(kvb + (size_t)j * 64 * 1024, kvb + (size_t)j * 64 * 1024 + 256, 1024, tid, kr, vr);
        nsa_store(KT(cnt), VS(cnt), tid, kr, vr);
        __syncthreads();
        while (j >= jlo) {
            bf16x8 pf[4];
            nsa_tile<2>(KT(cnt), nullptr, qf, lane, j * 64, t, scl, slp, true, (j == i ? 1 : 0) | (j == i - 8 ? 2 : 0), m, l, O, S, pf);
            if (j - 1 >= jlo) nsa_fetch(kvb + (size_t)(j - 1) * 64 * 1024, kvb + (size_t)(j - 1) * 64 * 1024 + 256, 1024, tid, kr, vr);
            nsa_pv(VS(cnt), lane, O, pf);
            ++cnt;
            if (j - 1 >= jlo) nsa_store(KT(cnt), VS(cnt), tid, kr, vr);
            __syncthreads();
            --j;
        }
        const float lt = l + __shfl_xor(l, 32);
        nsa_flush<false>(orow, lane >> 5, lt > 0.f ? g2 / lt : 0.f, O);
    }
#undef KT
#undef VS
    __builtin_amdgcn_s_setprio(0);
    __syncthreads();
}

constexpr int NS_Q = 0, NS_SC = 2048, NS_SEL = NS_SC + 4 * 2048 * 4, NS_RED = NS_SEL + 256;
__device__ __forceinline__ void ns_softmax(float* s, int lo, int hi, int lane, float mult) {
    float m = -1e30f;
    for (int j = lo + lane; j < hi; j += 64) m = fmaxf(m, s[j]);
    m = wave_max(m);
    float sum = 0.f;
    for (int j = lo + lane; j < hi; j += 64) { const float v = s[j]; const float e = v > -1e29f ? __expf(v - m) : 0.f; s[j] = e; sum += e; }
    sum = wave_sum(sum);
    const float f = sum > 0.f ? mult / sum : 0.f;
    for (int j = lo + lane; j < hi; j += 64) s[j] *= f;
}
__device__ __forceinline__ void ns_scores(const float* q_s, const float* kp, bool valid, int dist, int kvh, float* sc, int j) {
    float a0 = 0.f, a1 = 0.f, a2 = 0.f, a3 = 0.f;
    if (valid) {
#pragma unroll 16
        for (int d = 0; d < 128; d += 4) { const float4 kv = *(const float4*)(kp + d);
            a0 += q_s[d] * kv.x + q_s[d + 1] * kv.y + q_s[d + 2] * kv.z + q_s[d + 3] * kv.w;
            a1 += q_s[128 + d] * kv.x + q_s[128 + d + 1] * kv.y + q_s[128 + d + 2] * kv.z + q_s[128 + d + 3] * kv.w;
            a2 += q_s[256 + d] * kv.x + q_s[256 + d + 1] * kv.y + q_s[256 + d + 2] * kv.z + q_s[256 + d + 3] * kv.w;
            a3 += q_s[384 + d] * kv.x + q_s[384 + d + 1] * kv.y + q_s[384 + d + 2] * kv.z + q_s[384 + d + 3] * kv.w; }
    }
    const float scale = 0.08838834764831845f, fd = (float)dist;
    sc[0 * 2048 + j] = valid ? a0 * scale - exp2f(-(float)(kvh * 4 + 1)) * fd : -1e30f;
    sc[1 * 2048 + j] = valid ? a1 * scale - exp2f(-(float)(kvh * 4 + 2)) * fd : -1e30f;
    sc[2 * 2048 + j] = valid ? a2 * scale - exp2f(-(float)(kvh * 4 + 3)) * fd : -1e30f;
    sc[3 * 2048 + j] = valid ? a3 * scale - exp2f(-(float)(kvh * 4 + 4)) * fd : -1e30f;
}
__device__ __forceinline__ void ph4_nsa_sample(const Params& p, int u, unsigned char* lds) {
    int tid = threadIdx.x; asm volatile("" : "+v"(tid));
    const int wave = tid >> 6, lane = tid & 63, b = u >> 1, kvh = u & 1, row = NP + b, tpos = PAST;
    float* q_s = (float*)(lds + NS_Q); float* sc = (float*)(lds + NS_SC); int* sel_s = (int*)(lds + NS_SEL); float* red = (float*)(lds + NS_RED);
    const float* Pr = p.P + (size_t)row * INCP;
    q_s[tid] = Pr[C_Q + kvh * 512 + tid];
    __syncthreads();
    { int pos; bool valid; const float *kp, *vp; nsa_key<0, true>(p, b, tpos, kvh, tid, nullptr, pos, valid, kp, vp); ns_scores(q_s, kp, valid, tpos - pos, kvh, sc, tid); }
    __syncthreads();
    if (wave < 4) ns_softmax(sc + wave * 2048, 0, 512, lane, 1.f);
    __syncthreads();
    if (wave == 0) {
        const int cur = tpos >> 6, ncand = cur + 1;
        float val[5];
#pragma unroll
        for (int i = 0; i < 5; ++i) { const int blk = lane + 64 * i; float v = -INFINITY;
            if (blk < ncand) { const bool forced = blk == 0 || blk == cur || blk == cur - 1; float imp = 0.f;
                if (!forced) { for (int g = 0; g < 4; ++g) { if (2 * blk < 512) imp += sc[g * 2048 + 2 * blk]; if (2 * blk + 1 < 512) imp += sc[g * 2048 + 2 * blk + 1]; } }
                v = forced ? 1e4f : imp; }
            val[i] = v; }
        for (int r = 0; r < 16; ++r) {
            float bv = val[0]; int bi = lane;
#pragma unroll
            for (int i = 1; i < 5; ++i) if (val[i] > bv) { bv = val[i]; bi = lane + 64 * i; }
            for (int o = 32; o > 0; o >>= 1) { const float ov = __shfl_xor(bv, o); const int oi = __shfl_xor(bi, o); if (ov > bv || (ov == bv && oi < bi)) { bv = ov; bi = oi; } }
            if (lane == 0) sel_s[r] = bi;
#pragma unroll
            for (int i = 0; i < 5; ++i) if (lane + 64 * i == bi) val[i] = -INFINITY;
        }
    }
    __syncthreads();
#pragma unroll
    for (int i = 0; i < 3; ++i) { const int j = 512 + tid + 512 * i; int pos; bool valid; const float *kp, *vp;
        if (i < 2) nsa_key<1, true>(p, b, tpos, kvh, j - 512, sel_s, pos, valid, kp, vp); else nsa_key<2, true>(p, b, tpos, kvh, j - 1536, nullptr, pos, valid, kp, vp);
        ns_scores(q_s, kp, valid, tpos - pos, kvh, sc, j); }
    __syncthreads();
    { const int h = wave & 3, br = wave >> 2; const float gt = sigmoid_f(Pr[C_GTS + (kvh * 4 + h) * 3 + 1 + br]);
      ns_softmax(sc + h * 2048, br ? 1536 : 512, br ? 2048 : 1536, lane, gt);
      if (wave < 4) { const float g0 = sigmoid_f(Pr[C_GTS + (kvh * 4 + h) * 3]); for (int j = lane; j < 512; j += 64) sc[h * 2048 + j] *= g0; } }
    __syncthreads();
    { const int d4 = tid & 31, slice = tid >> 5;
      float4 a0 = make_float4(0.f, 0.f, 0.f, 0.f), a1 = a0, a2 = a0, a3 = a0;
#pragma unroll 16
      for (int i = 0; i < 128; ++i) { const int j = slice * 128 + i; int pos; bool valid; const float *kp, *vp;
          if (slice < 4) nsa_key<0, true>(p, b, tpos, kvh, j, nullptr, pos, valid, kp, vp);
          else if (slice < 12) nsa_key<1, true>(p, b, tpos, kvh, j - 512, sel_s, pos, valid, kp, vp);
          else nsa_key<2, true>(p, b, tpos, kvh, j - 1536, nullptr, pos, valid, kp, vp);
          const float4 v = *(const float4*)(vp + 4 * d4);
          const float w0 = sc[j], w1 = sc[2048 + j], w2 = sc[4096 + j], w3 = sc[6144 + j];
          a0.x += w0 * v.x; a0.y += w0 * v.y; a0.z += w0 * v.z; a0.w += w0 * v.w; a1.x += w1 * v.x; a1.y += w1 * v.y; a1.z += w1 * v.z; a1.w += w1 * v.w;
          a2.x += w2 * v.x; a2.y += w2 * v.y; a2.z += w2 * v.z; a2.w += w2 * v.w; a3.x += w3 * v.x; a3.y += w3 * v.y; a3.z += w3 * v.z; a3.w += w3 * v.w; }
      *(float4*)(red + (slice * 4 + 0) * 128 + 4 * d4) = a0; *(float4*)(red + (slice * 4 + 1) * 128 + 4 * d4) = a1;
      *(float4*)(red + (slice * 4 + 2) * 128 + 4 * d4) = a2; *(float4*)(red + (slice * 4 + 3) * 128 + 4 * d4) = a3; }
    __syncthreads();
    { const int h = tid >> 7, d = tid & 127; float o = 0.f;
#pragma unroll
      for (int s2 = 0; s2 < 16; ++s2) o += red[(s2 * 4 + h) * 128 + d];
      p.amix[(size_t)row * 2048 + (kvh * 4 + h) * 128 + d] = f2bf(o); }
    __syncthreads();
}
__device__ __forceinline__ void ph4_gdn(const Params& p, int u, float* smem) {
    float* qs = smem;
    float* ks = qs + 16 * 128;
    float* vs = ks + 16 * 128;
    float* ab = vs + 16 * 128;
    float* red = ab + 32;
    float* red2 = red + 512;
    const int tid = threadIdx.x, dv = tid & 127, grp = tid >> 7;
    const bool smp = u >= 32; const int v = smp ? u - 32 : u, b = v >> 3, h = v & 7;
    const int T = smp ? 1 : SEQ, row0 = smp ? NP + b : b * SEQ;
    float S[32];
#pragma unroll
    for (int i = 0; i < 32; ++i) S[i] = smp ? p.state_gdn[(((size_t)b * 8 + h) * 128 + grp * 32 + i) * 128 + dv] : 0.f;
    for (int t0 = 0; t0 < T; t0 += 16) {
        const int nst = (T - t0) < 16 ? (T - t0) : 16;
        __syncthreads();
        for (int i = tid; i < nst * 128; i += NTHR) { const int st = i >> 7, d = i & 127; const float* r = p.qkvn + (size_t)(row0 + t0 + st) * 3072 + h * 128 + d;
            qs[i] = r[0]; ks[i] = r[1024]; vs[i] = r[2048]; }
        if (tid < nst) { ab[tid * 2] = __expf(p.gg[(row0 + t0 + tid) * 8 + h]); ab[tid * 2 + 1] = p.gbeta[(row0 + t0 + tid) * 8 + h]; }
        __syncthreads();
        for (int st = 0; st < nst; ++st) {
            const float a = ab[st * 2], be = ab[st * 2 + 1];
            const float* kk = ks + st * 128 + grp * 32; const float* qq = qs + st * 128 + grp * 32;
            float part = 0.f;
#pragma unroll
            for (int i = 0; i < 32; ++i) part += kk[i] * S[i];
            red[grp * 128 + dv] = part;
            __syncthreads();
            const float kS = red[dv] + red[128 + dv] + red[256 + dv] + red[384 + dv];
            const float vn = be * (vs[st * 128 + dv] - a * kS);
            float op = 0.f;
#pragma unroll
            for (int i = 0; i < 32; ++i) { S[i] = a * S[i] + kk[i] * vn; op += qq[i] * S[i]; }
            red2[grp * 128 + dv] = op;
            __syncthreads();
            if (grp == 0) p.ograw[(size_t)(row0 + t0 + st) * 1024 + h * 128 + dv] = red2[dv] + red2[128 + dv] + red2[256 + dv] + red2[384 + dv];
        }
    }
    float* So = p.out + (smp ? O_GS : O_GP) + (((size_t)b * 8 + h) * 128) * 128;
#pragma unroll
    for (int i = 0; i < 32; ++i) So[(size_t)(grp * 32 + i) * 128 + dv] = S[i];
    __syncthreads();
}


constexpr int GA_Q = 0, GA_K = 17408, GA_T = GA_K, GA_VBT = 34816, GA_KBGT = 53248, GA_KDT = 71680, GA_QK = 90112, GA_AF = 99328, GA_WT = 99328, GA_UT = 117760, GA_SC = 136192;
__device__ __forceinline__ uint2 pack4(const f32x4& v) { uint2 w; w.x = pk2(v[0], v[1]); w.y = pk2(v[2], v[3]); return w; }
__device__ __forceinline__ void ph3_gdnA(const Params& p, int u, unsigned char* lds) {
    int tid = threadIdx.x; asm volatile("" : "+v"(tid));
    const int wave = tid >> 6, lane = tid & 63, r16 = lane & 15, quad = lane >> 4;
    const int n = u & 31, h = (u >> 5) & 7, b = u >> 8;
    const int row0 = b * SEQ + n * 64;
    float* sc_beta = (float*)(lds + GA_SC); float* sc_G = sc_beta + 64; float* sc_eG = sc_G + 64; float* sc_eGl = sc_eG + 64;
    if (tid < 64) {
        const float* Pr = p.P + (size_t)(row0 + tid) * INCP;
        const float be = sigmoid_f(Pr[C_BL + h]);
        float g = -__expf(p.a_log[h]) * softplus_f(Pr[C_AL + h] + p.dt_bias[h]);
        for (int o = 1; o < 64; o <<= 1) { const float tt = __shfl_up(g, o); if (lane >= o) g += tt; }
        const float Gl = __shfl(g, 63);
        sc_beta[tid] = be; sc_G[tid] = g; sc_eG[tid] = __expf(g); sc_eGl[tid] = __expf(Gl - g);
    }
    __syncthreads();
    {
        float cw[6][4];
#pragma unroll
        for (int e = 0; e < 6; ++e) { const int col = (e >> 1) * 1024 + h * 128 + lane + 64 * (e & 1);
#pragma unroll
            for (int i = 0; i < 4; ++i) cw[e][i] = p.conv_w[i * 3072 + col]; }
        float raw[11][6];
#pragma unroll
        for (int r = 0; r < 11; ++r) { const int tt = n * 64 + wave * 8 - 3 + r;
#pragma unroll
            for (int e = 0; e < 6; ++e) { const int col = C_QKV + (e >> 1) * 1024 + h * 128 + lane + 64 * (e & 1);
                raw[r][e] = tt >= 0 ? p.P[(size_t)(row0 + wave * 8 - 3 + r) * INCP + col] : 0.f; } }
#pragma unroll
        for (int ii = 0; ii < 8; ++ii) {
            const int c = wave * 8 + ii;
            float val[6];
#pragma unroll
            for (int e = 0; e < 6; ++e) { float acc = 0.f;
#pragma unroll
                for (int i = 0; i < 4; ++i) acc += raw[ii + i][e] * cw[e][i];
                val[e] = silu_f(acc); }
            const float rq = rsqrtf(wave_sum_sw(val[0] * val[0] + val[1] * val[1]) + 1e-6f) * 0.08838834764831845f;
            const float rk = rsqrtf(wave_sum_sw(val[2] * val[2] + val[3] * val[3]) + 1e-6f);
            const float be = sc_beta[c], eG = sc_eG[c], eGl = sc_eGl[c];
#pragma unroll
            for (int e2 = 0; e2 < 2; ++e2) { const int ch = lane + 64 * e2; const float kv = val[2 + e2] * rk;
                *(bf16_t*)(lds + GA_Q + c * 272 + ch * 2) = f2bf(val[e2] * rq);
                *(bf16_t*)(lds + GA_K + c * 272 + ch * 2) = f2bf(kv);
                *(bf16_t*)(lds + GA_KBGT + ch * 144 + c * 2) = f2bf(kv * be * eG);
                *(bf16_t*)(lds + GA_KDT + ch * 144 + c * 2) = f2bf(kv * eGl);
                *(bf16_t*)(lds + GA_VBT + ch * 144 + c * 2) = f2bf(val[4 + e2] * be); }
        }
    }
    __syncthreads();
    {
        const int sel = wave >> 2, rb = wave & 3;
        const unsigned char* Ab = lds + (sel ? GA_Q : GA_K) + (16 * rb + r16) * 272 + quad * 16;
        f32x4 acc[4];
#pragma unroll
        for (int cb = 0; cb < 4; ++cb) acc[cb] = (f32x4){0.f, 0.f, 0.f, 0.f};
#pragma unroll
        for (int ks = 0; ks < 4; ++ks) { const bf16x8 a = *(const bf16x8*)(Ab + ks * 64);
#pragma unroll
            for (int cb = 0; cb < 4; ++cb) { const bf16x8 bb = *(const bf16x8*)(lds + GA_K + (16 * cb + r16) * 272 + quad * 16 + ks * 64); acc[cb] = MFMA16(a, bb, acc[cb]); } }
        float* AF = (float*)(lds + GA_AF);
#pragma unroll
        for (int cb = 0; cb < 4; ++cb)
#pragma unroll
            for (int rg = 0; rg < 4; ++rg) { const int c = 16 * rb + 4 * quad + rg, m = 16 * cb + r16;
                const float dec = m <= c ? __expf(sc_G[c] - sc_G[m]) : 0.f;
                if (sel == 0) AF[c * 64 + m] = m < c ? sc_beta[c] * acc[cb][rg] * dec : 0.f;
                else *(bf16_t*)(lds + GA_QK + c * 144 + m * 2) = f2bf(acc[cb][rg] * dec); }
    }
    __syncthreads();
    if (wave == 0) {
        int zoff = 0; asm volatile("" : "+v"(zoff));
        const float* AF = (const float*)(lds + GA_AF) + zoff;
        float tc[64];
#pragma unroll
        for (int c = 0; c < 64; ++c) {
            f32x4 ar[16];
#pragma unroll
            for (int q = 0; q < (c + 3) / 4; ++q) ar[q] = *(const f32x4*)(AF + c * 64 + 4 * q);
            float acc = (c == lane) ? 1.f : 0.f;
#pragma unroll
            for (int m = 0; m < c; ++m) acc -= ar[m >> 2][m & 3] * tc[m];
            tc[c] = acc; }
#pragma unroll
        for (int c = 0; c < 64; ++c) *(bf16_t*)(lds + GA_T + c * 144 + lane * 2) = f2bf(tc[c]);
    }
    __syncthreads();
    {
        const int isW = wave >> 2;
        const unsigned char* Bs = lds + (isW ? GA_KBGT : GA_VBT); unsigned char* Ds = lds + (isW ? GA_WT : GA_UT);
#pragma unroll
        for (int cbi = 0; cbi < 2; ++cbi) { const int cb = (wave & 3) * 2 + cbi;
            bf16x8 bfr[2];
#pragma unroll
            for (int ks = 0; ks < 2; ++ks) bfr[ks] = *(const bf16x8*)(Bs + (16 * cb + r16) * 144 + ks * 64 + quad * 16);
#pragma unroll
            for (int rb = 0; rb < 4; ++rb) { f32x4 acc = (f32x4){0.f, 0.f, 0.f, 0.f};
#pragma unroll
                for (int ks = 0; ks < 2; ++ks) { const bf16x8 a = *(const bf16x8*)(lds + GA_T + (16 * rb + r16) * 144 + ks * 64 + quad * 16); acc = MFMA16(a, bfr[ks], acc); }
                *(uint2*)(Ds + (16 * cb + r16) * 144 + (16 * rb + 4 * quad) * 2) = pack4(acc); } }
    }
    __syncthreads();
    {
        bf16_t* gN = p.gN + (size_t)u * 16384; bf16_t* gBT = p.gBT + (size_t)u * 16384; bf16_t* gQp = p.gQp + (size_t)u * 8192; bf16_t* gOpT = p.gOpT + (size_t)u * 8192;
        {
            const bool isB = wave >= 4;
            const unsigned char* As = lds + (isB ? GA_KDT : GA_WT); const unsigned char* Bs = lds + (isB ? GA_UT : GA_KDT);
            bf16_t* dst = isB ? gBT : gN;
#pragma unroll
            for (int cbi = 0; cbi < 2; ++cbi) { const int cb = (wave & 3) * 2 + cbi;
                bf16x8 bfr[2];
#pragma unroll
                for (int ks = 0; ks < 2; ++ks) bfr[ks] = *(const bf16x8*)(Bs + (16 * cb + r16) * 144 + ks * 64 + quad * 16);
#pragma unroll
                for (int rb = 0; rb < 8; ++rb) { f32x4 acc = (f32x4){0.f, 0.f, 0.f, 0.f};
#pragma unroll
                    for (int ks = 0; ks < 2; ++ks) { const bf16x8 a = *(const bf16x8*)(As + (16 * rb + r16) * 144 + ks * 64 + quad * 16); acc = MFMA16(a, bfr[ks], acc); }
                    *(uint2*)(dst + (size_t)(16 * cb + r16) * 128 + 16 * rb + 4 * quad) = pack4(acc); } }
        }
        {
            bf16x8 afr[2];
#pragma unroll
            for (int ks = 0; ks < 2; ++ks) afr[ks] = *(const bf16x8*)(lds + GA_WT + (16 * wave + r16) * 144 + ks * 64 + quad * 16);
#pragma unroll
            for (int cb = 0; cb < 4; ++cb) { f32x4 acc = (f32x4){0.f, 0.f, 0.f, 0.f};
#pragma unroll
                for (int ks = 0; ks < 2; ++ks) { const bf16x8 bb = *(const bf16x8*)(lds + GA_QK + (16 * cb + r16) * 144 + ks * 64 + quad * 16); acc = MFMA16(afr[ks], bb, acc); }
                const int c = 16 * cb + r16, dk0 = 16 * wave + 4 * quad; const float eG = sc_eG[c];
                const uint2 qv = *(const uint2*)(lds + GA_Q + c * 272 + dk0 * 2);
                f32x4 o; o[0] = __uint_as_float(qv.x << 16) * eG - acc[0]; o[1] = __uint_as_float(qv.x & 0xffff0000u) * eG - acc[1]; o[2] = __uint_as_float(qv.y << 16) * eG - acc[2]; o[3] = __uint_as_float(qv.y & 0xffff0000u) * eG - acc[3];
                *(uint2*)(gQp + (size_t)c * 128 + dk0) = pack4(o); }
        }
        {
            bf16x8 bfr[2];
#pragma unroll
            for (int ks = 0; ks < 2; ++ks) bfr[ks] = *(const bf16x8*)(lds + GA_UT + (16 * wave + r16) * 144 + ks * 64 + quad * 16);
#pragma unroll
            for (int rb = 0; rb < 4; ++rb) { f32x4 acc = (f32x4){0.f, 0.f, 0.f, 0.f};
#pragma unroll
                for (int ks = 0; ks < 2; ++ks) { const bf16x8 a = *(const bf16x8*)(lds + GA_QK + (16 * rb + r16) * 144 + ks * 64 + quad * 16); acc = MFMA16(a, bfr[ks], acc); }
                *(uint2*)(gOpT + (size_t)(16 * wave + r16) * 64 + 16 * rb + 4 * quad) = pack4(acc); }
        }
        if (tid == 0) p.ggl[u] = sc_eG[63];
    }
    __syncthreads();
}
constexpr int GB_N0 = 0, GB_N1 = 34816;
struct GBSet { u32x4 nreg[4]; u32x2 breg[8]; };
__device__ __forceinline__ void gb_load(const Params& p, size_t ci, int tid, int dv, int quad, GBSet& s) {
    const bf16_t* gN = p.gN + ci * 16384; const bf16_t* gB = p.gBT + ci * 16384;
#pragma unroll
    for (int i = 0; i < 4; ++i) s.nreg[i] = *(const u32x4*)(gN + (size_t)(tid + 512 * i) * 8);
    if (tid < 256) {
#pragma unroll
        for (int rb = 0; rb < 8; ++rb) s.breg[rb] = *(const u32x2*)(gB + (size_t)dv * 128 + 16 * rb + 4 * quad); }
}
__device__ __forceinline__ void gb_step(const Params& p, int u, int n, float gl, unsigned char* lds, int tid, int r16, int quad, int dv, GBSet& s, f32x4 (&S)[8]) {
    const size_t ci = (size_t)u * 32 + n;
    const bool owner = tid < 256;
    bf16_t* gS = p.gST + ci * 16384 + (size_t)dv * 128 + 4 * quad;
    if (owner) {
#pragma unroll
        for (int rb = 0; rb < 8; ++rb) *(uint2*)(gS + 16 * rb) = pack4(S[rb]); }
    bf16x8 bfr[4];
#pragma unroll
    for (int ks = 0; ks < 4; ++ks) bfr[ks] = pack8(S[2 * ks][0], S[2 * ks][1], S[2 * ks][2], S[2 * ks][3], S[2 * ks + 1][0], S[2 * ks + 1][1], S[2 * ks + 1][2], S[2 * ks + 1][3]);
    unsigned char* buf = lds + ((n & 1) ? GB_N1 : GB_N0);
#pragma unroll
    for (int i = 0; i < 4; ++i) { const int idx = tid + 512 * i; *(u32x4*)(buf + (idx >> 4) * 272 + (idx & 15) * 16) = s.nreg[i]; }
    f32x4 Bv[8];
#pragma unroll
    for (int rb = 0; rb < 8; ++rb) { Bv[rb][0] = __uint_as_float(s.breg[rb].x << 16); Bv[rb][1] = __uint_as_float(s.breg[rb].x & 0xffff0000u); Bv[rb][2] = __uint_as_float(s.breg[rb].y << 16); Bv[rb][3] = __uint_as_float(s.breg[rb].y & 0xffff0000u); }
    __syncthreads();
    gb_load(p, (size_t)u * 32 + (n + 2 < 32 ? n + 2 : 31), tid, dv, quad, s);
    if (owner)
#pragma unroll
    for (int rb = 0; rb < 8; ++rb) { f32x4 acc = (f32x4){0.f, 0.f, 0.f, 0.f};
        u32x4 av[4];
#pragma unroll
        for (int ks = 0; ks < 4; ++ks) { const unsigned char* ap = buf + (16 * rb + r16) * 272 + (32 * ks + 4 * quad) * 2;
            const uint2 lo = *(const uint2*)ap, hi = *(const uint2*)(ap + 32); av[ks][0] = lo.x; av[ks][1] = lo.y; av[ks][2] = hi.x; av[ks][3] = hi.y; }
#pragma unroll
        for (int ks = 0; ks < 4; ++ks) acc = MFMA16(__builtin_bit_cast(bf16x8, av[ks]), bfr[ks], acc);
#pragma unroll
        for (int rg = 0; rg < 4; ++rg) S[rb][rg] = gl * S[rb][rg] + Bv[rb][rg] - acc[rg]; }
}
__device__ __forceinline__ void ph4_gdnB(const Params& p, int uu, unsigned char* lds) {
    const int u = uu >> 1, half = uu & 1;
    const int tid = threadIdx.x, wave = tid >> 6, lane = tid & 63, r16 = lane & 15, quad = lane >> 4, dv = 64 * half + 16 * (wave & 3) + r16;
    f32x4 S[8];
#pragma unroll
    for (int rb = 0; rb < 8; ++rb) S[rb] = (f32x4){0.f, 0.f, 0.f, 0.f};
    GBSet A, B;
    gb_load(p, (size_t)u * 32, tid, dv, quad, A);
    gb_load(p, (size_t)u * 32 + 1, tid, dv, quad, B);
    const float glv = p.ggl[(size_t)u * 32 + (lane & 31)];
#pragma unroll 1
    for (int n = 0; n < 32; n += 2) {
        gb_step(p, u, n, __shfl(glv, n), lds, tid, r16, quad, dv, A, S);
        gb_step(p, u, n + 1, __shfl(glv, n + 1), lds, tid, r16, quad, dv, B, S);
    }
    float* So = p.out + O_GP + (size_t)u * 16384;
    if (tid < 256) {
#pragma unroll
        for (int rb = 0; rb < 8; ++rb)
#pragma unroll
            for (int rg = 0; rg < 4; ++rg) So[(size_t)(16 * rb + 4 * quad + rg) * 128 + dv] = S[rb][rg]; }
    __syncthreads();
}
__device__ __forceinline__ void ph5_gdnC(const Params& p, int u, unsigned char* lds) {
    const int tid = threadIdx.x, wave = tid >> 6, lane = tid & 63, r16 = lane & 15, quad = lane >> 4, dv = 16 * wave + r16;
    const int n = u & 31, h = (u >> 5) & 7, b = u >> 8, row0 = b * SEQ + n * 64;
    const bf16_t* Qp = p.gQp + (size_t)u * 8192; const bf16_t* ST = p.gST + (size_t)u * 16384; const bf16_t* OpT = p.gOpT + (size_t)u * 8192;
    bf16x8 bfr[4];
#pragma unroll
    for (int ks = 0; ks < 4; ++ks) bfr[ks] = *(const bf16x8*)(ST + (size_t)dv * 128 + 32 * ks + 8 * quad);
    float zv[4][4];
#pragma unroll
    for (int rb = 0; rb < 4; ++rb)
#pragma unroll
        for (int rg = 0; rg < 4; ++rg) zv[rb][rg] = p.P[(size_t)(row0 + 16 * rb + 4 * quad + rg) * INCP + C_Z + h * 128 + dv];
    f32x4 o[4];
#pragma unroll
    for (int rb = 0; rb < 4; ++rb) { f32x4 acc = (f32x4){0.f, 0.f, 0.f, 0.f};
#pragma unroll
        for (int ks = 0; ks < 4; ++ks) { const bf16x8 a = *(const bf16x8*)(Qp + (size_t)(16 * rb + r16) * 128 + 32 * ks + 8 * quad); acc = MFMA16(a, bfr[ks], acc); }
        const uint2 op = *(const uint2*)(OpT + (size_t)dv * 64 + 16 * rb + 4 * quad);
        acc[0] += __uint_as_float(op.x << 16); acc[1] += __uint_as_float(op.x & 0xffff0000u); acc[2] += __uint_as_float(op.y << 16); acc[3] += __uint_as_float(op.y & 0xffff0000u);
        o[rb] = acc; }
    float* part = (float*)lds;
#pragma unroll
    for (int rb = 0; rb < 4; ++rb)
#pragma unroll
        for (int rg = 0; rg < 4; ++rg) { float v = o[rb][rg] * o[rb][rg]; v += __shfl_xor(v, 1); v += __shfl_xor(v, 2); v += __shfl_xor(v, 4); v += __shfl_xor(v, 8);
            if (r16 == 0) part[wave * 64 + 16 * rb + 4 * quad + rg] = v; }
    __syncthreads();
    const float gw = p.gdn_norm[dv];
#pragma unroll
    for (int rb = 0; rb < 4; ++rb)
#pragma unroll
        for (int rg = 0; rg < 4; ++rg) { const int c = 16 * rb + 4 * quad + rg;
            const float tot = part[c] + part[64 + c] + part[128 + c] + part[192 + c] + part[256 + c] + part[320 + c] + part[384 + c] + part[448 + c];
            const float rstd = rsqrtf(tot * (1.f / 128.f) + 1e-6f);
            p.amix[(size_t)(row0 + c) * 2048 + 1024 + h * 128 + dv] = f2bf(o[rb][rg] * rstd * gw * silu_f(zv[rb][rg])); }
    __syncthreads();
}

__device__ __forceinline__ void ph5_gdnout(const Params& p, int row) {
    const int wave = threadIdx.x >> 6, lane = threadIdx.x & 63, h = wave;
    const float* o = p.ograw + (size_t)row * 1024 + h * 128; const float* z = p.P + (size_t)row * INCP + C_Z + h * 128;
    const float a = o[2 * lane], b = o[2 * lane + 1];
    const float ss = wave_sum(a * a + b * b);
    const float r = rsqrtf(ss * (1.f / 128.f) + 1e-6f);
    const float y0 = a * r * p.gdn_norm[2 * lane] * silu_f(z[2 * lane]), y1 = b * r * p.gdn_norm[2 * lane + 1] * silu_f(z[2 * lane + 1]);
    *(unsigned*)(p.amix + (size_t)row * 2048 + 1024 + h * 128 + 2 * lane) = (unsigned)f2bf(y0) | ((unsigned)f2bf(y1) << 16);
}

__device__ __forceinline__ void ph9_peer(const Params& p, int row, float* smem) {
    float* qs = smem;
    float* hs = qs + 2048;
    float* ssc = hs + 2048;
    float* s_half = ssc + 2048;
    int* i_half = (int*)(s_half + 256);
    float* wgt = (float*)(i_half + 256);
    int* eid = (int*)(wgt + 128);
    float* red = (float*)(eid + 128);
    int tid = threadIdx.x; asm volatile("" : "+v"(tid));
    const int wave = tid >> 6, lane = tid & 63;
    for (int i = tid; i < 2048; i += NTHR) { qs[i] = p.qp[(size_t)row * 2048 + i]; hs[i] = p.h2f[(size_t)row * 2048 + i]; }
    __syncthreads();
    for (int i = 0; i < 4; ++i) { const int idx = tid + NTHR * i, hp = idx >> 7, k = idx & 127, half = hp & 1;
        const float* kr = p.peer_keys + ((size_t)half * 128 + k) * 128; const float* qq = qs + (hp >> 1) * 256 + half * 128;
        float acc = 0.f; for (int d = 0; d < 128; d += 4) { const float4 kv = *(const float4*)(kr + d); acc += qq[d] * kv.x + qq[d + 1] * kv.y + qq[d + 2] * kv.z + qq[d + 3] * kv.w; }
        ssc[idx] = acc; }
    __syncthreads();
    for (int li = 0; li < 2; ++li) { const int hp = wave * 2 + li;
        float v0 = ssc[hp * 128 + lane], v1 = ssc[hp * 128 + 64 + lane];
        for (int r = 0; r < 16; ++r) {
            float bv = v0; int bi = lane; if (v1 > bv) { bv = v1; bi = lane + 64; }
            for (int o = 32; o > 0; o >>= 1) { const float ov = __shfl_xor(bv, o); const int oi = __shfl_xor(bi, o); if (ov > bv || (ov == bv && oi < bi)) { bv = ov; bi = oi; } }
            if (lane == 0) { s_half[hp * 16 + r] = bv; i_half[hp * 16 + r] = bi; }
            if (bi == lane) v0 = -INFINITY; if (bi == lane + 64) v1 = -INFINITY;
        } }
    __syncthreads();
    { const int h = wave; float cv[4];
#pragma unroll
      for (int c = 0; c < 4; ++c) { const int f = lane + 64 * c; cv[c] = s_half[(h * 2) * 16 + (f >> 4)] + s_half[(h * 2 + 1) * 16 + (f & 15)]; }
      float bs_mine = 0.f; int e_mine = 0;
      for (int r = 0; r < 16; ++r) {
          float bv = cv[0]; int bi = lane;
#pragma unroll
          for (int c = 1; c < 4; ++c) if (cv[c] > bv) { bv = cv[c]; bi = lane + 64 * c; }
          for (int o = 32; o > 0; o >>= 1) { const float ov = __shfl_xor(bv, o); const int oi = __shfl_xor(bi, o); if (ov > bv || (ov == bv && oi < bi)) { bv = ov; bi = oi; } }
          if (lane == r) { bs_mine = bv; e_mine = i_half[(h * 2) * 16 + (bi >> 4)] * 128 + i_half[(h * 2 + 1) * 16 + (bi & 15)]; }
#pragma unroll
          for (int c = 0; c < 4; ++c) if (lane + 64 * c == bi) cv[c] = -INFINITY;
      }
      float mx = lane < 16 ? bs_mine : -INFINITY; mx = wave_max(mx);
      const float ex = lane < 16 ? __expf(bs_mine - mx) : 0.f; const float den = wave_sum(ex);
      const float gate = ex / den;
      for (int r = 0; r < 16; ++r) { const int e = __shfl(e_mine, r); const float* ur = p.peer_u + (size_t)e * 2048;
          float acc = 0.f;
#pragma unroll
          for (int i = 0; i < 8; ++i) { const int c = i * 256 + lane * 4; const float4 uv = *(const float4*)(ur + c); acc += hs[c] * uv.x + hs[c + 1] * uv.y + hs[c + 2] * uv.z + hs[c + 3] * uv.w; }
          acc = wave_sum(acc);
          const float g = __shfl(gate, r);
          if (lane == 0) { wgt[h * 16 + r] = g * gelu_tanh(acc); eid[h * 16 + r] = e; } }
    }
    __syncthreads();
    float4 o = make_float4(0.f, 0.f, 0.f, 0.f);
    for (int j = 0; j < 128; ++j) { const float w = wgt[j]; const float4 vv = *(const float4*)(p.peer_v + (size_t)eid[j] * 2048 + tid * 4); o.x += w * vv.x; o.y += w * vv.y; o.z += w * vv.z; o.w += w * vv.w; }
    const int mrow = row < NP ? row / SEQ : 4 + (row - NP);
    const float4 g2 = *(const float4*)(p.mod + (size_t)mrow * 12288 + 10240 + tid * 4);
    const float4 xv = *(const float4*)(p.x1 + (size_t)row * 2048 + tid * 4);
    float4 x2; x2.x = xv.x + g2.x * o.x; x2.y = xv.y + g2.y * o.y; x2.z = xv.z + g2.z * o.z; x2.w = xv.w + g2.w * o.w;
    float ss = wave_sum(x2.x * x2.x + x2.y * x2.y + x2.z * x2.z + x2.w * x2.w);
    if (lane == 0) red[wave] = ss;
    __syncthreads();
    ss = red[0] + red[1] + red[2] + red[3] + red[4] + red[5] + red[6] + red[7];
    const float rstd = rsqrtf(ss * (1.f / 2048.f) + 1e-6f);
    const float4 fw = *(const float4*)(p.final_norm + tid * 4);
    float4 y; y.x = x2.x * rstd * fw.x; y.y = x2.y * rstd * fw.y; y.z = x2.z * rstd * fw.z; y.w = x2.w * rstd * fw.w;
    float* dst = row < NP ? p.out + O_YP + (size_t)row * 2048 : p.out + O_YS + (size_t)(row - NP) * 2048;
    *(float4*)(dst + tid * 4) = y;
    __syncthreads();
}


constexpr int PK_SH = 0, PK_IH = 16384, PK_EID = 32768, PK_GATE = 40960, PK_KH = 49152, PK_KL = 83968;
__device__ __forceinline__ void split8(const float4& a, const float4& b, bf16x8& hi, bf16x8& lo) {
    hi = pack8(a.x, a.y, a.z, a.w, b.x, b.y, b.z, b.w);
    const u32x4 hb = __builtin_bit_cast(u32x4, hi);
    lo = pack8(a.x - __uint_as_float(hb[0] << 16), a.y - __uint_as_float(hb[0] & 0xffff0000u), a.z - __uint_as_float(hb[1] << 16), a.w - __uint_as_float(hb[1] & 0xffff0000u),
               b.x - __uint_as_float(hb[2] << 16), b.y - __uint_as_float(hb[2] & 0xffff0000u), b.z - __uint_as_float(hb[3] << 16), b.w - __uint_as_float(hb[3] & 0xffff0000u));
}
__device__ __forceinline__ float dot8(const u32x4& a, const u32x4& b, float acc) {
#pragma unroll
    for (int k = 0; k < 4; ++k) { const unsigned ak = a[k], bk = b[k];
        acc = __builtin_amdgcn_fdot2_f32_bf16(__builtin_bit_cast(bf2_t, ak), __builtin_bit_cast(bf2_t, bk), acc, false); }
    return acc;
}

#ifndef PEER_DBG
#define PEER_DBG 0
#endif
__device__ __forceinline__ void peer_topk_naive(const Params& p, int row, int tk, unsigned char* lds) {
    float* qs = (float*)(lds + 65536);
    float* ssc = qs + 2048;
    float* s_half = ssc + 2048;
    int* i_half = (int*)(s_half + 256);
    int* eidL = (int*)(lds + PK_EID); float* gateL = (float*)(lds + PK_GATE);
    const int tid = threadIdx.x, wave = tid >> 6, lane = tid & 63;
    for (int i = tid; i < 2048; i += NTHR) qs[i] = p.qp[(size_t)row * 2048 + i];
    __syncthreads();
    for (int i = 0; i < 4; ++i) { const int idx = tid + NTHR * i, hp = idx >> 7, k = idx & 127, half = hp & 1;
        const float* kr = p.peer_keys + ((size_t)half * 128 + k) * 128; const float* qq = qs + (hp >> 1) * 256 + half * 128;
        float acc = 0.f; for (int d = 0; d < 128; d += 4) { const float4 kv = *(const float4*)(kr + d); acc += qq[d] * kv.x + qq[d + 1] * kv.y + qq[d + 2] * kv.z + qq[d + 3] * kv.w; }
        ssc[idx] = acc; }
    __syncthreads();
    for (int li = 0; li < 2; ++li) { const int hp = wave * 2 + li;
        float v0 = ssc[hp * 128 + lane], v1 = ssc[hp * 128 + 64 + lane];
        for (int r = 0; r < 16; ++r) {
            float bv = v0; int bi = lane; if (v1 > bv) { bv = v1; bi = lane + 64; }
            for (int o = 32; o > 0; o >>= 1) { const float ov = __shfl_xor(bv, o); const int oi = __shfl_xor(bi, o); if (ov > bv || (ov == bv && oi < bi)) { bv = ov; bi = oi; } }
            if (lane == 0) { s_half[hp * 16 + r] = bv; i_half[hp * 16 + r] = bi; }
            if (bi == lane) v0 = -INFINITY; if (bi == lane + 64) v1 = -INFINITY;
        } }
    __syncthreads();
    { const int h = wave; float cv[4];
#pragma unroll
      for (int c = 0; c < 4; ++c) { const int f = lane + 64 * c; cv[c] = s_half[(h * 2) * 16 + (f >> 4)] + s_half[(h * 2 + 1) * 16 + (f & 15)]; }
      float bs_mine = 0.f; int e_mine = 0;
      for (int r = 0; r < 16; ++r) {
          float bv = cv[0]; int bi = lane;
#pragma unroll
          for (int c = 1; c < 4; ++c) if (cv[c] > bv) { bv = cv[c]; bi = lane + 64 * c; }
          for (int o = 32; o > 0; o >>= 1) { const float ov = __shfl_xor(bv, o); const int oi = __shfl_xor(bi, o); if (ov > bv || (ov == bv && oi < bi)) { bv = ov; bi = oi; } }
          if (lane == r) { bs_mine = bv; e_mine = i_half[(h * 2) * 16 + (bi >> 4)] * 128 + i_half[(h * 2 + 1) * 16 + (bi & 15)]; }
#pragma unroll
          for (int c = 0; c < 4; ++c) if (lane + 64 * c == bi) cv[c] = -INFINITY;
      }
      float mx = lane < 16 ? bs_mine : -INFINITY; mx = wave_max(mx);
      const float ex = lane < 16 ? __expf(bs_mine - mx) : 0.f; const float den = wave_sum(ex);
      if (lane < 16) { eidL[tk * 128 + h * 16 + lane] = e_mine; gateL[tk * 128 + h * 16 + lane] = ex / den; }
    }
    __syncthreads();
}
template <bool LATE>
__device__ __forceinline__ void ph9_peer_fast(const Params& p, int u, unsigned char* lds) {
    int tid = threadIdx.x; asm volatile("" : "+v"(tid));
    const int wave = tid >> 6, lane = tid & 63, r16 = lane & 15, quad = lane >> 4;
    float* sh = (float*)(lds + PK_SH); int* ih = (int*)(lds + PK_IH); int* eidL = (int*)(lds + PK_EID); float* gateL = (float*)(lds + PK_GATE);
    const int tok0 = u * 16;
#if PEER_DBG == 1
    for (int tk = 0; tk < 16; ++tk) peer_topk_naive(p, tok0 + tk < NTOK ? tok0 + tk : NTOK - 1, tk, lds);
#else
    {
        const int row = tok0 + r16 < NTOK ? tok0 + r16 : NTOK - 1, head = wave;
        const int lbase = (wave * 16 + r16) * 32;
#pragma unroll 1
        for (int half = 0; half < 2; ++half) {
            bf16x8 qh[4], ql[4];
            const float* qrow = p.qp + (size_t)row * 2048 + head * 256 + half * 128 + 8 * quad;
#pragma unroll
            for (int ks = 0; ks < 4; ++ks) split8(*(const float4*)(qrow + 32 * ks), *(const float4*)(qrow + 32 * ks + 4), qh[ks], ql[ks]);
            __syncthreads();
#pragma unroll
            for (int i = 0; i < 4; ++i) { const int id = tid + 512 * i, kr = id >> 4, part = id & 15; const size_t go = (size_t)(half * 128 + kr) * 128 + part * 8;
                *(u32x4*)(lds + PK_KH + kr * 272 + part * 16) = *(const u32x4*)(p.kh + go); *(u32x4*)(lds + PK_KL + kr * 272 + part * 16) = *(const u32x4*)(p.kl + go); }
            __syncthreads();
            f32x4 acc[8];
#pragma unroll
            for (int kb = 0; kb < 8; ++kb) { acc[kb] = (f32x4){0.f, 0.f, 0.f, 0.f};
                const int ko = (16 * kb + r16) * 272 + quad * 16;
                bf16x8 ahv[4], alv[4];
#pragma unroll
                for (int ks = 0; ks < 4; ++ks) { ahv[ks] = *(const bf16x8*)(lds + PK_KH + ko + 64 * ks); alv[ks] = *(const bf16x8*)(lds + PK_KL + ko + 64 * ks); }
#pragma unroll
                for (int ks = 0; ks < 4; ++ks) { acc[kb] = MFMA16(ahv[ks], qh[ks], acc[kb]); acc[kb] = MFMA16(ahv[ks], ql[ks], acc[kb]); acc[kb] = MFMA16(alv[ks], qh[ks], acc[kb]); } }
#pragma unroll 1
            for (int r = 0; r < 16; ++r) {
                float bv = acc[0][0]; int bi = 4 * quad;
#pragma unroll
                for (int kb = 0; kb < 8; ++kb)
#pragma unroll
                    for (int rg = 0; rg < 4; ++rg) if (acc[kb][rg] > bv) { bv = acc[kb][rg]; bi = 16 * kb + 4 * quad + rg; }
#pragma unroll
                for (int o = 16; o <= 32; o <<= 1) { const float ov = __shfl_xor(bv, o); const int oi = __shfl_xor(bi, o); if (ov > bv || (ov == bv && oi < bi)) { bv = ov; bi = oi; } }
                if (quad == 0) { sh[lbase + half * 16 + r] = bv; ih[lbase + half * 16 + r] = bi; }
#pragma unroll
                for (int kb = 0; kb < 8; ++kb)
#pragma unroll
                    for (int rg = 0; rg < 4; ++rg) if (bi == 16 * kb + 4 * quad + rg) acc[kb][rg] = -INFINITY;
            }
        }
        __syncthreads();
        float s0v[4], cur[4]; int ptr[4];
#pragma unroll
        for (int ii = 0; ii < 4; ++ii) { s0v[ii] = sh[lbase + 4 * quad + ii]; ptr[ii] = 0; cur[ii] = s0v[ii] + sh[lbase + 16]; }
        float bs[16]; int be[16];
#pragma unroll
        for (int r = 0; r < 16; ++r) {
            float bv = cur[0]; int bi = 4 * quad, bj = ptr[0];
#pragma unroll
            for (int ii = 1; ii < 4; ++ii) if (cur[ii] > bv) { bv = cur[ii]; bi = 4 * quad + ii; bj = ptr[ii]; }
#pragma unroll
            for (int o = 16; o <= 32; o <<= 1) { const float ov = __shfl_xor(bv, o); const int oi = __shfl_xor(bi, o), oj = __shfl_xor(bj, o); if (ov > bv || (ov == bv && oi < bi)) { bv = ov; bi = oi; bj = oj; } }
            bs[r] = bv; be[r] = ih[lbase + bi] * 128 + ih[lbase + 16 + bj];
#pragma unroll
            for (int ii = 0; ii < 4; ++ii) if (bi == 4 * quad + ii) { ptr[ii] += 1; cur[ii] = ptr[ii] < 16 ? s0v[ii] + sh[lbase + 16 + (ptr[ii] & 15)] : -INFINITY; }
        }
        float den = 0.f; const float bmax = bs[0];
#pragma unroll
        for (int r = 0; r < 16; ++r) { bs[r] = __expf(bs[r] - bmax); den += bs[r]; }
        const float dinv = 1.f / den;
        if (quad == 0) {
#pragma unroll
            for (int r = 0; r < 16; ++r) { eidL[r16 * 128 + head * 16 + r] = be[r]; gateL[r16 * 128 + head * 16 + r] = bs[r] * dinv; } }
        if (quad == 0 && tok0 + r16 < NTOK) {
#pragma unroll
            for (int r = 0; r < 16; ++r) { int* pe = p.pk_eid + (size_t)(tok0 + r16) * 128 + head * 16 + r; float* pg = p.pk_gate + (size_t)(tok0 + r16) * 128 + head * 16 + r;
                if (LATE) { __hip_atomic_store(pe, be[r], __ATOMIC_RELAXED, __HIP_MEMORY_SCOPE_AGENT); __hip_atomic_store(pg, bs[r] * dinv, __ATOMIC_RELAXED, __HIP_MEMORY_SCOPE_AGENT); }
                else { *pe = be[r]; *pg = bs[r] * dinv; } } }
    }
#endif
    __syncthreads();
}

__device__ __forceinline__ float dot16_fp8(const u32x4& q, const float* h, float acc) {
    f32x2 a2 = (f32x2){acc, 0.f};
#pragma unroll
    for (int k = 0; k < 4; ++k) { const int w = (int)q[k]; const f32x2 lo = __builtin_amdgcn_cvt_pk_f32_fp8(w, false), hi = __builtin_amdgcn_cvt_pk_f32_fp8(w, true);
        a2 = __builtin_elementwise_fma(lo, (f32x2){h[4 * k], h[4 * k + 1]}, a2); a2 = __builtin_elementwise_fma(hi, (f32x2){h[4 * k + 2], h[4 * k + 3]}, a2); }
    return a2[0] + a2[1];
}
__device__ __forceinline__ void axpy16_fp8(const u32x4& q, float w, float* o) {
    const f32x2 w2 = (f32x2){w, w};
#pragma unroll
    for (int k = 0; k < 4; ++k) { const int x = (int)q[k]; const f32x2 lo = __builtin_amdgcn_cvt_pk_f32_fp8(x, false), hi = __builtin_amdgcn_cvt_pk_f32_fp8(x, true);
        const f32x2 a = __builtin_elementwise_fma(w2, lo, (f32x2){o[4 * k], o[4 * k + 1]}), b = __builtin_elementwise_fma(w2, hi, (f32x2){o[4 * k + 2], o[4 * k + 3]});
        o[4 * k] = a[0]; o[4 * k + 1] = a[1]; o[4 * k + 2] = b[0]; o[4 * k + 3] = b[1]; }
}
__device__ __forceinline__ void ph10_token(const Params& p, int row, int lane) {
    asm volatile("" : "+v"(lane));
    float hv[32];
    { const float* hr = p.h2f + (size_t)row * 2048 + lane * 16;
#pragma unroll
      for (int c = 0; c < 2; ++c)
#pragma unroll
          for (int k = 0; k < 4; ++k) { const float4 t = *(const float4*)(hr + c * 1024 + 4 * k); hv[c * 16 + 4 * k] = t.x; hv[c * 16 + 4 * k + 1] = t.y; hv[c * 16 + 4 * k + 2] = t.z; hv[c * 16 + 4 * k + 3] = t.w; } }
    const int e_lo = p.pk_eid[(size_t)row * 128 + lane], e_hi = p.pk_eid[(size_t)row * 128 + 64 + lane];
    const float g_lo = p.pk_gate[(size_t)row * 128 + lane], g_hi = p.pk_gate[(size_t)row * 128 + 64 + lane];
    float w_lo = 0.f, w_hi = 0.f;
#pragma unroll 1
    for (int j0 = 0; j0 < 128; j0 += 8) {
        u32x4 uv[8][2]; float su[8];
#pragma unroll
        for (int jj = 0; jj < 8; ++jj) { const int j = j0 + jj; const int e = __shfl(j < 64 ? e_lo : e_hi, j & 63); const unsigned char* ur = p.u8 + (size_t)e * 2048 + lane * 16;
            uv[jj][0] = *(const u32x4*)ur; uv[jj][1] = *(const u32x4*)(ur + 1024); su[jj] = p.us[e]; }
#pragma unroll
        for (int jj = 0; jj < 8; ++jj) { const int j = j0 + jj; float d = dot16_fp8(uv[jj][0], hv, 0.f); d = dot16_fp8(uv[jj][1], hv + 16, d);
            d = wave_sum_sw(d) * su[jj];
            const float w = __shfl(j < 64 ? g_lo : g_hi, j & 63) * gelu_tanh(d);
            if (lane == (j & 63)) { if (j < 64) w_lo = w; else w_hi = w; }
            __builtin_amdgcn_sched_barrier(0); }
    }
    float out[32];
#pragma unroll
    for (int k = 0; k < 32; ++k) out[k] = 0.f;
#pragma unroll 1
    for (int j0 = 0; j0 < 128; j0 += 4) {
        u32x4 vv[4][2]; float sv[4];
#pragma unroll
        for (int jj = 0; jj < 4; ++jj) { const int j = j0 + jj; const int e = __shfl(j < 64 ? e_lo : e_hi, j & 63); const unsigned char* vr = p.v8 + (size_t)e * 2048 + lane * 16;
            vv[jj][0] = *(const u32x4*)vr; vv[jj][1] = *(const u32x4*)(vr + 1024); sv[jj] = p.vs[e]; }
#pragma unroll
        for (int jj = 0; jj < 4; ++jj) { const int j = j0 + jj; const float w = __shfl(j < 64 ? w_lo : w_hi, j & 63) * sv[jj];
            axpy16_fp8(vv[jj][0], w, out); axpy16_fp8(vv[jj][1], w, out + 16); __builtin_amdgcn_sched_barrier(0); }
    }
    asm volatile("" : "+s"(row));
    const int mrow = row < NP ? row / SEQ : 4 + (row - NP);
    const float* g2 = p.mod + (size_t)mrow * 12288 + 10240 + lane * 16; const float* x1 = p.x1 + (size_t)row * 2048 + lane * 16;
    float ss = 0.f;
#pragma unroll
    for (int c = 0; c < 2; ++c)
#pragma unroll
        for (int k = 0; k < 16; k += 4) { const float4 xv = *(const float4*)(x1 + c * 1024 + k), gv = *(const float4*)(g2 + c * 1024 + k); float* o = out + c * 16 + k;
            o[0] = xv.x + gv.x * o[0]; o[1] = xv.y + gv.y * o[1]; o[2] = xv.z + gv.z * o[2]; o[3] = xv.w + gv.w * o[3];
            ss += o[0] * o[0] + o[1] * o[1] + o[2] * o[2] + o[3] * o[3]; }
    ss = wave_sum_sw(ss);
    const float rstd = rsqrtf(ss * (1.f / 2048.f) + 1e-6f);
    float* dst = (row < NP ? p.out + O_YP + (size_t)row * 2048 : p.out + O_YS + (size_t)(row - NP) * 2048) + lane * 16;
#pragma unroll
    for (int c = 0; c < 2; ++c)
#pragma unroll
        for (int k = 0; k < 16; k += 4) { const float4 fw = *(const float4*)(p.final_norm + lane * 16 + c * 1024 + k); const float* o = out + c * 16 + k;
            float4 y; y.x = o[0] * rstd * fw.x; y.y = o[1] * rstd * fw.y; y.z = o[2] * rstd * fw.z; y.w = o[3] * rstd * fw.w;
            *(float4*)(dst + c * 1024 + k) = y; }
}
__device__ __forceinline__ void ph10_gather(const Params& p, unsigned qword) {
    const int lane = threadIdx.x & 63;
    for (;;) {
        unsigned coff = qword; asm volatile("" : "+v"(coff));
        unsigned t = 0; if (lane == 0) t = atomicAdd(p.bar + coff, 1u);
        t = (unsigned)__builtin_amdgcn_readfirstlane((int)t);
        if (t >= (unsigned)NTOK) break;
        ph10_token(p, (int)t, lane);
    }
}


template <int CTRL> __device__ __forceinline__ float dpp_add(float v) { return v + __int_as_float(__builtin_amdgcn_update_dpp(0, __float_as_int(v), CTRL, 0xf, 0xf, true)); }
template <int PAT> __device__ __forceinline__ float swz_add(float v) { return v + __int_as_float(__builtin_amdgcn_ds_swizzle(__float_as_int(v), PAT)); }
struct SlabIds { int e_lo, e_hi; };
constexpr int QW_FLAG = 3900;
template <int TBL>
__device__ __forceinline__ SlabIds slab_ids(const Params& p, int t, int lane) {
    SlabIds s;
    if (TBL == 0 && t >= NP && gridDim.x >= 16) {
        for (unsigned sp = 0; sp < (1u << 22); ++sp) { if (__builtin_amdgcn_readfirstlane((int)__hip_atomic_load(p.bar + QW_FLAG, __ATOMIC_RELAXED, __HIP_MEMORY_SCOPE_AGENT)) != 0) break; __builtin_amdgcn_s_sleep(8); }
        s.e_lo = __hip_atomic_load(p.pk_eid + (size_t)t * 128 + lane, __ATOMIC_RELAXED, __HIP_MEMORY_SCOPE_AGENT); s.e_hi = __hip_atomic_load(p.pk_eid + (size_t)t * 128 + 64 + lane, __ATOMIC_RELAXED, __HIP_MEMORY_SCOPE_AGENT);
    } else { s.e_lo = p.pk_eid[(size_t)t * 128 + lane]; s.e_hi = p.pk_eid[(size_t)t * 128 + 64 + lane]; }
    return s;
}
template <int TBL> struct SlabRows { u32x4 rv[16]; u32x4 hq[2]; float w0, w1; };
template <int TBL>
__device__ __forceinline__ void slab_issue(const Params& p, int t, int slab, int lane, const SlabIds& id, SlabRows<TBL>& r) {
    if (TBL == 0) {
        const int gq = lane >> 3, c8 = lane & 7, kq = lane >> 4;
        const unsigned char* tab = p.u8 + (size_t)slab * (16384 * 128) + c8 * 16;
#pragma unroll
        for (int k = 0; k < 16; ++k) { const int e = __shfl(k < 8 ? id.e_lo : id.e_hi, (8 * k + gq) & 63); r.rv[k] = *(const u32x4*)(tab + (size_t)e * 128); }
        const unsigned char* hp = p.h2q + (size_t)t * 2048 + slab * 128 + kq * 32;
        r.hq[0] = *(const u32x4*)hp; r.hq[1] = *(const u32x4*)(hp + 16);
    } else {
        const int gq = lane >> 3, c8 = lane & 7;
        const unsigned char* tab = p.v8 + (size_t)slab * (16384 * 128) + c8 * 16;
#pragma unroll
        for (int k = 0; k < 16; ++k) { const int e = __shfl(k < 8 ? id.e_lo : id.e_hi, (8 * k + gq) & 63); r.rv[k] = *(const u32x4*)(tab + (size_t)e * 128); }
        { const unsigned char* wp = p.wq + (size_t)t * 128 + (lane >> 4) * 8;
          const i32x2 a0 = *(const i32x2*)wp, a1 = *(const i32x2*)(wp + 32), a2 = *(const i32x2*)(wp + 64), a3 = *(const i32x2*)(wp + 96);
          r.hq[0] = (u32x4){(unsigned)a0[0], (unsigned)a0[1], (unsigned)a1[0], (unsigned)a1[1]}; r.hq[1] = (u32x4){(unsigned)a2[0], (unsigned)a2[1], (unsigned)a3[0], (unsigned)a3[1]}; r.w0 = p.wsc[t]; r.w1 = 0.f; }
    }
}
__device__ __forceinline__ long pk64(unsigned lo, unsigned hi) { return (long)(((unsigned long long)hi << 32) | (unsigned long long)lo); }
template <int TBL>
__device__ __forceinline__ void slab_compute(const Params& p, int t, int slab, int lane, const SlabRows<TBL>& r, unsigned char* lds_w) {
    if (TBL == 0) {
        const int r16 = lane & 15, kq = lane >> 4, gq = lane >> 3, c8 = lane & 7;
        unsigned char* stg = lds_w;
        const long b0 = pk64(r.hq[0][0], r.hq[0][1]), b1 = pk64(r.hq[0][2], r.hq[0][3]), b2 = pk64(r.hq[1][0], r.hq[1][1]), b3 = pk64(r.hq[1][2], r.hq[1][3]);
        f32x4 sel = (f32x4){0.f, 0.f, 0.f, 0.f};
#pragma unroll
        for (int hf = 0; hf < 2; ++hf) {
#pragma unroll
            for (int k = 0; k < 8; ++k) *(u32x4*)(stg + (8 * k + gq) * 144 + c8 * 16) = r.rv[8 * hf + k];
            asm volatile("s_waitcnt lgkmcnt(0)" ::: "memory");
#pragma unroll
            for (int g2 = 0; g2 < 4; ++g2) { const int g = 4 * hf + g2;
                const u32x4 a0 = *(const u32x4*)(stg + (16 * g2 + r16) * 144 + kq * 32), a1 = *(const u32x4*)(stg + (16 * g2 + r16) * 144 + kq * 32 + 16);
                f32x4 acc = (f32x4){0.f, 0.f, 0.f, 0.f};
                acc = __builtin_amdgcn_mfma_f32_16x16x32_fp8_fp8(pk64(a0[0], a0[1]), b0, acc, 0, 0, 0);
                acc = __builtin_amdgcn_mfma_f32_16x16x32_fp8_fp8(pk64(a0[2], a0[3]), b1, acc, 0, 0, 0);
                acc = __builtin_amdgcn_mfma_f32_16x16x32_fp8_fp8(pk64(a1[0], a1[1]), b2, acc, 0, 0, 0);
                acc = __builtin_amdgcn_mfma_f32_16x16x32_fp8_fp8(pk64(a1[2], a1[3]), b3, acc, 0, 0, 0);
                if (r16 == g) sel = acc; }
            asm volatile("s_waitcnt lgkmcnt(0)" ::: "memory");
        }
        if (r16 < 8) *(f32x4*)(p.pd + ((size_t)slab * NTOK + t) * 128 + 16 * r16 + 4 * kq) = sel;
    } else {
        const int i16 = lane & 15, kq = lane >> 4, gq = lane >> 3, c8 = lane & 7;
        unsigned char* stg = lds_w;
        f32x4 acc[8];
#pragma unroll
        for (int cb = 0; cb < 8; ++cb) acc[cb] = (f32x4){0.f, 0.f, 0.f, 0.f};
#pragma unroll
        for (int hf = 0; hf < 2; ++hf) {
#pragma unroll
            for (int k = 0; k < 8; ++k) *(u32x4*)(stg + (8 * k + gq) * 144 + c8 * 16) = r.rv[8 * hf + k];
            asm volatile("s_waitcnt lgkmcnt(0)" ::: "memory");
#pragma unroll
            for (int s2 = 0; s2 < 2; ++s2) { const int s = 2 * hf + s2;
                const long a = pk64(r.hq[s >> 1][2 * (s & 1)], r.hq[s >> 1][2 * (s & 1) + 1]);
                const unsigned char* tb = stg + (32 * s2 + 8 * kq + (i16 >> 1)) * 144 + 8 * (i16 & 1);
#pragma unroll
                for (int cb = 0; cb < 8; ++cb) { const i32x2 bq = __builtin_amdgcn_ds_read_tr8_b64_v2i32((LAS i32x2*)(tb + 16 * cb));
                    acc[cb] = __builtin_amdgcn_mfma_f32_16x16x32_fp8_fp8(a, pk64((unsigned)bq[0], (unsigned)bq[1]), acc[cb], 0, 0, 0); } }
            asm volatile("s_waitcnt lgkmcnt(0)" ::: "memory");
        }
        if (lane < 16) { float* dst = p.po + (size_t)t * 2048 + slab * 128 + lane;
#pragma unroll
            for (int cb = 0; cb < 8; ++cb) dst[16 * cb] = acc[cb][0] * r.w0; }
    }
}
template <int TBL>
__device__ __forceinline__ void peer_slab_phase(const Params& p, int bx, int G, unsigned char* lds, bool skip_last) {
    int lane = threadIdx.x & 63; asm volatile("" : "+v"(lane));
    const int wave = threadIdx.x >> 6;
    const int x = bx & 7, nblk = ((G - x + 7) >> 3) - ((skip_last && x == ((G - 1) & 7)) ? 1 : 0), w = (bx >> 3) * 8 + wave, nw = nblk * 8;
    const int cw = w < NTOK ? (NTOK - w + nw - 1) / nw : 0, n = 2 * cw;
#define ITEM_T(i) (w + ((i) % cw) * nw)
#define ITEM_S(i) (x + 8 * ((i) / cw))
    if (n == 0) return;
    SlabRows<TBL> A, B; SlabIds ia, ib;
    ia = slab_ids<TBL>(p, ITEM_T(0), lane);
    ib = slab_ids<TBL>(p, ITEM_T(n > 1 ? 1 : 0), lane);
    slab_issue<TBL>(p, ITEM_T(0), ITEM_S(0), lane, ia, A);
#pragma unroll 1
    for (int i = 0; i < n; i += 2) {
        const int i1 = i + 1 < n ? i + 1 : n - 1, i2 = i + 2 < n ? i + 2 : n - 1, i3 = i + 3 < n ? i + 3 : n - 1;
        ia = slab_ids<TBL>(p, ITEM_T(i2), lane);
        slab_issue<TBL>(p, ITEM_T(i1), ITEM_S(i1), lane, ib, B);
        slab_compute<TBL>(p, ITEM_T(i), ITEM_S(i), lane, A, lds + wave * 9216);
        ib = slab_ids<TBL>(p, ITEM_T(i3), lane);
        slab_issue<TBL>(p, ITEM_T(i2), ITEM_S(i2), lane, ia, A);
        if (i + 1 < n) slab_compute<TBL>(p, ITEM_T(i1), ITEM_S(i1), lane, B, lds + wave * 9216);
    }
#undef ITEM_T
#undef ITEM_S
}
__device__ __forceinline__ void peer_w_phase(const Params& p, int bx, int G) {
    const int lane = threadIdx.x & 63, gw = bx * 8 + (threadIdx.x >> 6);
#pragma unroll 1
    for (int t = gw; t < NTOK; t += G * 8) {
        float wv[2];
#pragma unroll
        for (int hh = 0; hh < 2; ++hh) { const int pi = lane + 64 * hh; float d = 0.f;
#pragma unroll
            for (int s = 0; s < 16; ++s) d += p.pd[((size_t)s * NTOK + t) * 128 + pi];
            const int e = p.pk_eid[(size_t)t * 128 + pi];
            wv[hh] = p.pk_gate[(size_t)t * 128 + pi] * gelu_tanh(d * p.us[e]) * p.vs[e]; }
        const float am = wave_max(fmaxf(fabsf(wv[0]), fabsf(wv[1])));
        const float sc = am > 0.f ? am * (1.f / 440.f) : 1.f, inv = 1.f / sc;
        const int pk = __builtin_amdgcn_cvt_pk_fp8_f32(wv[0] * inv, wv[1] * inv, 0, false);
        p.wq[(size_t)t * 128 + lane] = (unsigned char)(pk & 0xff); p.wq[(size_t)t * 128 + 64 + lane] = (unsigned char)((pk >> 8) & 0xff);
        if (lane == 0) p.wsc[t] = sc;
    }
}
__device__ __forceinline__ void peer_final_phase(const Params& p, int bx, int G) {
    const int lane = threadIdx.x & 63, gw = bx * 8 + (threadIdx.x >> 6);
#pragma unroll 1
    for (int row = gw; row < NTOK; row += G * 8) {
        const int mrow = row < NP ? row / SEQ : 4 + (row - NP);
        const float* g2 = p.mod + (size_t)mrow * 12288 + 10240 + lane * 16; const float* x1 = p.x1 + (size_t)row * 2048 + lane * 16; const float* po = p.po + (size_t)row * 2048 + lane * 16;
        float out[32]; float ss = 0.f;
#pragma unroll
        for (int c = 0; c < 2; ++c)
#pragma unroll
            for (int k = 0; k < 16; k += 4) { const float4 xv = *(const float4*)(x1 + c * 1024 + k), gv = *(const float4*)(g2 + c * 1024 + k), ov = *(const float4*)(po + c * 1024 + k); float* o = out + c * 16 + k;
                o[0] = xv.x + gv.x * ov.x; o[1] = xv.y + gv.y * ov.y; o[2] = xv.z + gv.z * ov.z; o[3] = xv.w + gv.w * ov.w;
                ss += o[0] * o[0] + o[1] * o[1] + o[2] * o[2] + o[3] * o[3]; }
        ss = wave_sum_sw(ss);
        const float rstd = rsqrtf(ss * (1.f / 2048.f) + 1e-6f);
        float* dst = (row < NP ? p.out + O_YP + (size_t)row * 2048 : p.out + O_YS + (size_t)(row - NP) * 2048) + lane * 16;
#pragma unroll
        for (int c = 0; c < 2; ++c)
#pragma unroll
            for (int k = 0; k < 16; k += 4) { const float4 fw = *(const float4*)(p.final_norm + lane * 16 + c * 1024 + k); const float* o = out + c * 16 + k;
                float4 y; y.x = o[0] * rstd * fw.x; y.y = o[1] * rstd * fw.y; y.z = o[2] * rstd * fw.z; y.w = o[3] * rstd * fw.w;
                *(float4*)(dst + c * 1024 + k) = y; }
    }
}


constexpr int NF_T = 1024, NF_W = 64, NFILL = NF_W + 2 * NF_T + 2 * 2048, QW_HEAD = 3700, QW_DONE = 3800;
__device__ __forceinline__ void filler_unit(const Params& p, int f, unsigned char* lds) {
    if (f < NF_W) {
        const int b = f >> 3, j0 = (f & 7) * 64;
#pragma unroll
        for (int i = 0; i < 16; ++i) { const int idx = threadIdx.x + NTHR * i, j = j0 + (idx >> 7), c = (idx & 127) * 4;
            if (j < 511) *(float4*)(p.out + O_WKS + ((size_t)b * 512 + j) * 512 + c) = *(const float4*)(p.state_win + ((size_t)b * 512 + j + 1) * 512 + c); }
        return; }
    f -= NF_W;
    if (f < NF_T) ph0_transpose(p.w_out, p.wt_out, 2048, 32, f, (float*)lds);
    else if (f < 2 * NF_T) ph0_transpose(p.peer_wq, p.wt_q, 2048, 32, f - NF_T, (float*)lds);
    else if (f < 2 * NF_T + 2048) ph0_fp8(p.peer_u, p.u8, p.us, f - 2 * NF_T);
    else ph0_fp8(p.peer_v, p.v8, p.vs, f - 2 * NF_T - 2048);
}
template <bool DRAIN>
__device__ __forceinline__ void filler_bg(const Params& p, unsigned char* lds, int phase, int G) {
    volatile int* w = (volatile int*)(lds + LDS_BYTES - 64);
    __syncthreads();
    if (!DRAIN && threadIdx.x == 0) __hip_atomic_fetch_add(p.bar + QW_DONE + phase, 1u, __ATOMIC_RELAXED, __HIP_MEMORY_SCOPE_AGENT);
    for (;;) {
        if (threadIdx.x == 0) {
            int f = NFILL;
            const bool others_busy = DRAIN || __hip_atomic_load(p.bar + QW_DONE + phase, __ATOMIC_RELAXED, __HIP_MEMORY_SCOPE_AGENT) < (unsigned)G;
            if (others_busy) f = (int)__hip_atomic_fetch_add(p.bar + QW_HEAD, 1u, __ATOMIC_RELAXED, __HIP_MEMORY_SCOPE_AGENT);
            w[0] = f;
        }
        __syncthreads();
        const int f = w[0];
        __syncthreads();
        if (f >= NFILL) break;
        filler_unit(p, f, lds);
    }
}
#ifndef PROBE_DBL
#define PROBE_DBL 0
#endif
#ifndef PROBE_SUB
#define PROBE_SUB 0
#endif
#define PHASE_FN(k) __device__ __forceinline__ void phase##k(const Params& p, unsigned char* lds, const int bx, const int G, const int rep)
PHASE_FN(0) {
    float* smem = (float*)lds;
    constexpr int NA = 192, NT_IN = 32 * (INCP / 64), NC = 2 * 128 + 2 * 4, NK = 8, NTOT = NA + NT_IN + NC + NK;
    volatile int* qw = (volatile int*)(lds + LDS_BYTES - 64);
    const unsigned qhead = QW_HEAD + 32 + (unsigned)rep;
    for (;;) {
        __syncthreads();
        if (threadIdx.x == 0) qw[0] = (int)__hip_atomic_fetch_add(p.bar + qhead, 1u, __ATOMIC_RELAXED, __HIP_MEMORY_SCOPE_AGENT);
        __syncthreads();
        int u = qw[0];
        if (u >= NTOT) break;
        if (u < NA) { ph0_adaln(p, u, smem); continue; }
        u -= NA;
        if (u < NT_IN) { ph0_transpose(p.w_in, p.wt_in, INC, INCP / 64, u, smem); continue; }
        u -= NT_IN;
        if (u < NC) {
            if (u < 256) { const int s = u >> 7; ph0_transpose(p.cmp_w1 + (size_t)s * 4096 * 128, p.w1t + (size_t)s * 128 * 4096, 128, 2, u & 127, smem, 4096); }
            else { const int s = (u - 256) >> 2; ph0_transpose(p.cmp_w2 + (size_t)s * 128 * 128, p.w2t + (size_t)s * 128 * 128, 128, 2, (u - 256) & 3, smem, 128); }
            continue; }
        ph0_keys(p, u - NC);
    }
}
PHASE_FN(1) { for (int u = bx; u < MPAD / 8; u += G) norm_row<0>(p, u * 8 + (threadIdx.x >> 6)); }
PHASE_FN(2) {
    constexpr int MT = NP / 256, NG1 = MT * (INCP / 256);
    float* C = p.P; float* out = p.out; bf16_t* Qb = p.Qb; bf16_t* KVb = p.KVb;
    auto epiP = [C](int r, int c, float v) { __builtin_nontemporal_store(v, C + (size_t)r * INCP + c); };
    auto epiA = [Qb](int r, int c, float v) { Qb[(size_t)r * 1024 + c] = f2bf(v); };
    auto epiB = [out](int r, int c, float v) { out[O_CKP + (size_t)r * 512 + (c - C_KVC)] = v; };
    auto epiC = [out, KVb](int r, int c, float v) { out[O_SKP + (size_t)r * 512 + (c - C_KVS)] = v; KVb[(size_t)r * 1024 + (c - C_KVS)] = f2bf(v); };
    auto epiD = [out, KVb](int r, int c, float v) { KVb[(size_t)r * 1024 + (c - C_KVS)] = f2bf(v); const int t = r & (SEQ - 1);
        if (t >= SEQ - 512) out[O_WKP + ((size_t)(r >> 11) * 512 + (t - (SEQ - 512))) * 512 + (c - C_KVW)] = v; };
    volatile int* qw = (volatile int*)(lds + LDS_BYTES - 64);
    const unsigned qhead = QW_HEAD + 64 + (unsigned)rep * 64;
    for (;;) {
        __syncthreads();
        if (threadIdx.x == 0) qw[0] = (int)__hip_atomic_fetch_add(p.bar + qhead, 1u, __ATOMIC_RELAXED, __HIP_MEMORY_SCOPE_AGENT);
        __syncthreads();
        const int q = qw[0];
        if (q >= 128 + NG1 + INCP / 64) break;
        if (q < 128) cmp_tile<true>(p, q >> 1, q & 1, lds);
        else if (q < 128 + NG1) { const int g = q - 128, pn = g / MT, pm = g % MT;
            if (pn < 4) gemm_tile(p.h1, p.wt_in, 2048, pm * 256, pn * 256, (bf16_t*)lds, epiA);
            else if (pn < 6) gemm_tile(p.h1, p.wt_in, 2048, pm * 256, pn * 256, (bf16_t*)lds, epiB);
            else if (pn < 8) gemm_tile(p.h1, p.wt_in, 2048, pm * 256, pn * 256, (bf16_t*)lds, epiC);
            else if (pn < 10) gemm_tile(p.h1, p.wt_in, 2048, pm * 256, pn * 256, (bf16_t*)lds, epiD);
            else gemm_tile(p.h1, p.wt_in, 2048, pm * 256, pn * 256, (bf16_t*)lds, epiP); }
        else gemm_rows8<4>(p.h1 + (size_t)NP * 2048, p.wt_in, q - 128 - NG1, lds, epiP);
    }
    if (rep == 0) filler_bg<false>(p, lds, 2, G);
}
PHASE_FN(3) {
    float* smem = (float*)lds;
    constexpr int NQ3 = 8 + 1024 + NSB + NSB + NB * 3;
    volatile int* qw = (volatile int*)(lds + LDS_BYTES - 64);
    const unsigned qhead = QW_HEAD + 40 + (unsigned)rep;
    for (;;) {
        __syncthreads();
        if (threadIdx.x == 0) qw[0] = (int)__hip_atomic_fetch_add(p.bar + qhead, 1u, __ATOMIC_RELAXED, __HIP_MEMORY_SCOPE_AGENT);
        __syncthreads();
        int u = qw[0];
        if (u >= NQ3) break;
        if (u < 8) { cmp_tile<false>(p, u >> 1, u & 1, lds); continue; }
        u -= 8;
        if (u < 1024) { ph3_gdnA(p, u, lds); if (PROBE_SUB & 1) ph3_gdnA(p, u, lds); continue; }
        u -= 1024;
        if (u < NSB) { ph3_gdnprep(p, NP + u, smem); continue; }
        ph3_scatter(p, u - NSB);
    }
    if (rep == 0) filler_bg<false>(p, lds, 3, G);
}
PHASE_FN(4) {
    float* smem = (float*)lds;
    if (G >= 128) {
        if (bx < 64) { ph4_gdnB(p, bx, lds); if (PROBE_SUB & 8) ph4_gdnB(p, bx, lds); ph4_gdn(p, 32 + bx, smem); }
        else if (bx < 80) { ph4_nsa_sample(p, bx - 64, lds); if (PROBE_SUB & 32) ph4_nsa_sample(p, bx - 64, lds); }
        else { const int NB = G - 80, k = bx - 80;
            for (int pass = 0; pass * NB < 256; ++pass) { const int u = pass * NB + ((pass & 1) ? ((NB & 7) ? NB - 1 - k : NB - 8 - (k & ~7) + (k & 7)) : k);        if (u < 256) { ph4_nsa_fast(p, u, lds); if (PROBE_SUB & 16) ph4_nsa_fast(p, u, lds); } }
        }
    } else {
        for (int u = bx; u < 64; u += G) ph4_gdnB(p, u, lds);
        for (int u = 32 + bx; u < 96; u += G) ph4_gdn(p, u, smem);
        for (int u = bx; u < 256; u += G) ph4_nsa_fast(p, u, lds);
        for (int u = bx; u < 2 * NSB; u += G) ph4_nsa_sample(p, u, lds);
    }
    if (rep == 0) filler_bg<false>(p, lds, 4, G);
}
PHASE_FN(5) { for (int u = bx; u < 1024; u += G) ph5_gdnC(p, u, lds); for (int u = bx; u < NSB; u += G) ph5_gdnout(p, NP + u); if (rep == 0) filler_bg<true>(p, lds, 5, G); }
PHASE_FN(6) {
    float* C = p.acc2;
    auto epi = [C](int r, int c, float v) { C[(size_t)r * 2048 + c] = v; };
    constexpr int MT = NP / 256;
    for (int u = bx; u < MT * 8; u += G) { const int pn = u / MT, pm = u % MT; gemm_tile(p.amix, p.wt_out, 2048, pm * 256, pn * 256, (bf16_t*)lds, epi); }
    for (int c = bx; c < 128; c += G) gemm_rows8<1>(p.amix + (size_t)NP * 2048, p.wt_out, c, lds, epi);
}
PHASE_FN(7) { for (int u = bx; u < MPAD / 8; u += G) norm_row<1>(p, u * 8 + (threadIdx.x >> 6)); }
PHASE_FN(8) {
    float* C = p.qp;
    auto epi = [C](int r, int c, float v) { C[(size_t)r * 2048 + c] = v; };
    constexpr int MT = NP / 256;
    for (int u = bx; u < MT * 8; u += G) { const int pn = u / MT, pm = u % MT; gemm_tile(p.h2, p.wt_q, 2048, pm * 256, pn * 256, (bf16_t*)lds, epi); }
    for (int c = bx; c < 128; c += G) gemm_rows8<1>(p.h2 + (size_t)NP * 2048, p.wt_q, c, lds, epi);
}
PHASE_FN(9) { for (int u = bx; u < NP / 16 + ((G < 16) ? 1 : 0); u += G) ph9_peer_fast<false>(p, u, lds); }
PHASE_FN(10) {
    if (G >= 16 && bx == G - 1) {
        ph9_peer_fast<true>(p, NP / 16, lds);
        asm volatile("s_waitcnt vmcnt(0)" ::: "memory");
        __syncthreads();
        if (threadIdx.x == 0) __hip_atomic_store(p.bar + QW_FLAG, 1u, __ATOMIC_RELAXED, __HIP_MEMORY_SCOPE_AGENT);
    } else peer_slab_phase<0>(p, bx, G, lds, G >= 16);
}
PHASE_FN(11) { peer_w_phase(p, bx, G); }
PHASE_FN(12) { peer_slab_phase<1>(p, bx, G, lds, false); }
PHASE_FN(13) { peer_final_phase(p, bx, G); }

__global__ void __launch_bounds__(NTHR, 2) fwd(Params p) {
    extern __shared__ __attribute__((aligned(16))) unsigned char lds[];
    LAS unsigned* xbw = (LAS unsigned*)(lds + LDS_BYTES - 16);
    const int tid = threadIdx.x, G = gridDim.x, bx = blockIdx.x;
    if (tid < 4) xbw[tid] = 0u;
    __syncthreads();
    XcdBarrier bar; bar.bar = p.bar; bar.x = 0; bar.st = nullptr;
    const int lo = p.ph_lo, hi = p.ph_hi;
    if (hi - lo > 1) bar = xcd_barrier_post(p.bar, (volatile LAS unsigned*)xbw);
#define IN(k) (lo <= (k) && (k) < hi)
#ifndef PROBE_BAR
#define PROBE_BAR 0
#endif
#define SEAM(k) do { if (IN(k) && IN((k) + 1)) { xcd_barrier(bar); if (PROBE_BAR) xcd_barrier(bar); } } while (0)
#define RUN(k) do { if (IN(k)) { phase##k(p, lds, bx, G, 0); if ((PROBE_DBL >> (k)) & 1) { __syncthreads(); phase##k(p, lds, bx, G, 1); } } } while (0)
    RUN(0); SEAM(0);
    RUN(1); SEAM(1);
    RUN(2); SEAM(2);
    RUN(3); SEAM(3);
    RUN(4); SEAM(4);
    RUN(5); SEAM(5);
    RUN(6); SEAM(6);
    RUN(7); SEAM(7);
    RUN(8); SEAM(8);
    RUN(9); SEAM(9);
    RUN(10); SEAM(10);
    RUN(11); SEAM(11);
    RUN(12); SEAM(12);
    RUN(13);
}

extern "C" void kernel_launch(void* const* d_in, const int* in_sizes, int n_in, void* d_out, int out_size, void* d_ws, size_t ws_size, hipStream_t stream) {
    static int grid = 0;
    if (grid == 0) {
        int dev = 0, cus = 0;
        if (hipGetDevice(&dev) != hipSuccess || hipDeviceGetAttribute(&cus, hipDeviceAttributeMultiprocessorCount, dev) != hipSuccess) { fprintf(stderr, "kernel_launch: device query failed\n"); grid = -1; return; }
        if (hipFuncSetAttribute((const void*)fwd, hipFuncAttributeMaxDynamicSharedMemorySize, LDS_BYTES) != hipSuccess) { fprintf(stderr, "kernel_launch: hipFuncSetAttribute failed\n"); grid = -1; return; }
        int per_cu = 0;
        if (hipOccupancyMaxActiveBlocksPerMultiprocessor(&per_cu, (const void*)fwd, NTHR, LDS_BYTES) != hipSuccess || per_cu < 1) fprintf(stderr, "kernel_launch: occupancy query says %d\n", per_cu);
        (void)hipGetLastError();
        grid = cus;
    }
    if (grid < 0) return;
    Params p{};
    p.x_prompt = (const float*)d_in[0]; p.x_sample = (const float*)d_in[1]; p.cache_cmp = (const float*)d_in[2]; p.cache_sel = (const float*)d_in[3];
    p.state_win = (const float*)d_in[4]; p.state_conv = (const float*)d_in[5]; p.state_gdn = (const float*)d_in[6]; p.page_table = (const int*)d_in[7];
    p.c_prompt = (const float*)d_in[8]; p.c_sample = (const float*)d_in[9]; p.w_ada = (const float*)d_in[10]; p.b_ada = (const float*)d_in[11];
    p.norm_mix = (const float*)d_in[12]; p.norm_ffn = (const float*)d_in[13]; p.w_in = (const float*)d_in[14]; p.cmp_pe = (const float*)d_in[15];
    p.cmp_w1 = (const float*)d_in[16]; p.cmp_b1 = (const float*)d_in[17]; p.cmp_w2 = (const float*)d_in[18]; p.conv_w = (const float*)d_in[19];
    p.a_log = (const float*)d_in[20]; p.dt_bias = (const float*)d_in[21]; p.gdn_norm = (const float*)d_in[22]; p.w_out = (const float*)d_in[23];
    p.peer_wq = (const float*)d_in[24]; p.peer_keys = (const float*)d_in[25]; p.peer_u = (const float*)d_in[26]; p.peer_v = (const float*)d_in[27];
    p.final_norm = (const float*)d_in[28];
    p.out = (float*)d_out;
    unsigned char* ws = (unsigned char*)d_ws; size_t off = 0;
    auto take = [&](size_t bytes) { unsigned char* r = ws + off; off += (bytes + 255) & ~(size_t)255; return r; };
    p.bar = (unsigned*)take(16384);
    p.mod = (float*)take((size_t)12 * 12288 * 4);
    p.h1 = (bf16_t*)take((size_t)MPAD * 2048 * 2);
    p.wt_in = (bf16_t*)take((size_t)INCP * 2048 * 2);
    p.wt_out = (bf16_t*)take((size_t)2048 * 2048 * 2);
    p.wt_q = (bf16_t*)take((size_t)2048 * 2048 * 2);
    p.P = (float*)take((size_t)MPAD * INCP * 4);
    p.ckv_p = (float*)take((size_t)4 * 64 * 4 * 128 * 4);
    p.ckv_s = (float*)take((size_t)8 * 512 * 4 * 128 * 4);
    p.qkvn = (float*)take((size_t)NTOK * 3072 * 4);
    p.gbeta = (float*)take((size_t)NTOK * 8 * 4);
    p.gg = (float*)take((size_t)NTOK * 8 * 4);
    p.ograw = (float*)take((size_t)NTOK * 1024 * 4);
    p.amix = (bf16_t*)take((size_t)MPAD * 2048 * 2);
    p.acc2 = (float*)take((size_t)MPAD * 2048 * 4);
    p.x1 = (float*)take((size_t)NTOK * 2048 * 4);
    p.h2f = (float*)take((size_t)NTOK * 2048 * 4);
    p.h2 = (bf16_t*)take((size_t)MPAD * 2048 * 2);
    p.qp = (float*)take((size_t)MPAD * 2048 * 4);
    p.Qb = (bf16_t*)take((size_t)MPAD * 1024 * 2);
    p.gN = (bf16_t*)take((size_t)1024 * 16384 * 2); p.gBT = (bf16_t*)take((size_t)1024 * 16384 * 2); p.gQp = (bf16_t*)take((size_t)1024 * 8192 * 2);
    p.u8 = (unsigned char*)take((size_t)16384 * 2048); p.v8 = (unsigned char*)take((size_t)16384 * 2048); p.us = (float*)take(65536); p.vs = (float*)take(65536);
    p.pk_eid = (int*)take((size_t)NTOK * 128 * 4); p.pk_gate = (float*)take((size_t)NTOK * 128 * 4);
    p.pd = (float*)take((size_t)16 * NTOK * 128 * 4); p.wv = (float*)take((size_t)NTOK * 128 * 4); p.h2q = (unsigned char*)take((size_t)NTOK * 2048); p.po = (float*)take((size_t)NTOK * 2048 * 4); p.wq = (unsigned char*)take((size_t)NTOK * 128); p.wsc = (float*)take((size_t)NTOK * 4); p.kh = (bf16_t*)take(65536); p.kl = (bf16_t*)take(65536); p.w1t = (bf16_t*)take((size_t)2 * 128 * 4096 * 2); p.w2t = (bf16_t*)take((size_t)2 * 128 * 128 * 2);
    p.gOpT = (bf16_t*)take((size_t)1024 * 8192 * 2); p.gST = (bf16_t*)take((size_t)1024 * 16384 * 2); p.ggl = (float*)take(4096);
    p.KVb = (bf16_t*)take((size_t)MPAD * 1024 * 2);
    if (off > ws_size) { fprintf(stderr, "kernel_launch: workspace too small (%zu > %zu)\n", off, ws_size); return; }
    (void)hipMemsetAsync(p.bar, 0, 16384, stream);
    if (N_LAUNCHES == 1) { p.ph_lo = 0; p.ph_hi = NPH; hipLaunchKernelGGL(fwd, dim3(grid), dim3(NTHR), LDS_BYTES, stream, p); }
    else for (int li = 0; li < NPH; ++li) { p.ph_lo = li; p.ph_hi = li + 1; hipLaunchKernelGGL(fwd, dim3(grid), dim3(NTHR), LDS_BYTES, stream, p); }
    const hipError_t le = hipPeekAtLastError();
    if (le != hipSuccess) fprintf(stderr, "kernel_launch: launch failed: %s\n", hipGetErrorName(le));
}
```
